# Optimizing an MI355X kernel written in HIP

```python
import jax, jax.numpy as jnp
from jax import lax
import numpy as np

D_MODEL = 1024
BATCH = 16
SEQ = 2048
DEPTH = 1

N_HEADS = 8
HEAD_DIM = 64
ATTN_WIDTH = N_HEADS * HEAD_DIM
IDX_HEADS = 8
IDX_DIM = 64
IDX_SCALE = (IDX_HEADS ** -0.5) * (IDX_DIM ** -0.5)
TOPK_MAX = 256
Q_BLOCK = 128
POOL_WINDOWS = (2, 4, 8, 16)
POOL_GROUPS = len(POOL_WINDOWS)
POOL_WIDTH = 512
POOL_GROUP_WIDTH = POOL_WIDTH // POOL_GROUPS
N_BRANCHES = 2
D_FF = -(-8 * D_MODEL // (3 * 256)) * 256
RMS_EPS = 1e-6
NEG_BIG = -1e30

IN_COLS = (ATTN_WIDTH, HEAD_DIM, HEAD_DIM, IDX_HEADS * IDX_DIM, IDX_DIM, IDX_HEADS,
           POOL_WIDTH, N_BRANCHES * D_MODEL)
D_IN = int(sum(IN_COLS))
IN_SPLITS = [int(c) for c in np.cumsum(IN_COLS)[:-1]]

kernel_name = "hybrid_dsa_pool_gated_block"


def rms_norm(x, gain):
    xf = x.astype(jnp.float32)
    y = xf * lax.rsqrt(jnp.mean(xf * xf, axis=-1, keepdims=True) + RMS_EPS)
    return (y * gain.astype(jnp.float32)).astype(x.dtype)


def alibi_slopes(n_heads):
    return 2.0 ** (-8.0 * jnp.arange(1, n_heads + 1, dtype=jnp.float32) / n_heads)


def dsa_attention(q, k, v, q_idx, k_idx, w_idx):
    B, S = q.shape[0], q.shape[1]
    n_keep = min(TOPK_MAX, S // 4)
    nb = S // Q_BLOCK
    slopes = alibi_slopes(N_HEADS)
    key_pos = jnp.arange(S, dtype=jnp.int32)
    scale = HEAD_DIM ** -0.5

    def to_blocks(a):
        return a.reshape((B, nb, Q_BLOCK) + a.shape[2:]).swapaxes(0, 1)

    def one_block(args):
        qb, qib, wb, tb = args
        s = jnp.einsum('bqhd,bsd->bqhs', qib, k_idx)
        s = jnp.einsum('bqhs,bqh->bqs', jax.nn.relu(s), wb).astype(jnp.float32)
        causal = key_pos[None, :] <= tb[:, None]
        s = jnp.where(causal[None], s, -jnp.inf)
        _, idx = lax.top_k(s, n_keep)
        k_sel = jax.vmap(lambda kb, ib: kb[ib])(k, idx)
        v_sel = jax.vmap(lambda vb, ib: vb[ib])(v, idx)
        logits = jnp.einsum('bqhd,bqkd->bhqk', qb, k_sel).astype(jnp.float32) * scale
        dist = tb[None, :, None] - idx
        logits = logits - slopes[None, :, None, None] * dist[:, None].astype(jnp.float32)
        logits = jnp.where((dist >= 0)[:, None], logits, NEG_BIG)
        p = jax.nn.softmax(logits, axis=-1).astype(v.dtype)
        return jnp.einsum('bhqk,bqkd->bqhd', p, v_sel)

    tpos = jnp.arange(S, dtype=jnp.int32).reshape(nb, Q_BLOCK)
    out = lax.map(one_block, (to_blocks(q), to_blocks(q_idx), to_blocks(w_idx), tpos))
    return out.swapaxes(0, 1).reshape(B, S, ATTN_WIDTH)


def multiscale_pool(u, w_group, scale):
    B, S, P = u.shape
    uf = u.astype(jnp.float32)
    c0 = jnp.concatenate([jnp.zeros((B, 1, P), jnp.float32), jnp.cumsum(uf, axis=1)], axis=1)
    t = jnp.arange(S)
    outs = []
    for g, w in enumerate(POOL_WINDOWS):
        sl = slice(g * POOL_GROUP_WIDTH, (g + 1) * POOL_GROUP_WIDTH)
        cg = c0[..., sl]
        start = jnp.concatenate([jnp.zeros((B, w - 1, POOL_GROUP_WIDTH), jnp.float32),
                                 cg[:, :S - w + 1]], axis=1)
        count = jnp.minimum(t + 1, w).astype(jnp.float32)[None, :, None]
        mean = (cg[:, 1:] - start) / count
        outs.append((mean - uf[..., sl]).astype(u.dtype) @ w_group[g])
    return jnp.concatenate(outs, axis=-1) * scale


def setup_inputs(seed: int = 0) -> dict:
    key = jax.random.key(seed)
    ks = jax.random.split(key, 16)
    f32 = jnp.float32

    def w(k, shape, fan_in):
        return jax.random.normal(k, shape, f32) * (fan_in ** -0.5)

    def gain(k, shape):
        return 1.0 + 0.02 * jax.random.normal(k, shape, f32)

    L = DEPTH
    return {
        "x": jax.random.normal(ks[0], (BATCH, SEQ, D_MODEL), f32),
        "norm_mix": gain(ks[1], (L, D_MODEL)),
        "w_in": w(ks[2], (L, D_MODEL, D_IN), D_MODEL),
        "q_norm": gain(ks[3], (L, HEAD_DIM)),
        "k_norm": gain(ks[4], (L, HEAD_DIM)),
        "w_pool_group": w(ks[5], (L, POOL_GROUPS, POOL_GROUP_WIDTH, POOL_GROUP_WIDTH), POOL_GROUP_WIDTH),
        "pool_scale": gain(ks[6], (L, POOL_WIDTH)),
        "w_branch_attn": w(ks[7], (L, ATTN_WIDTH, D_MODEL), ATTN_WIDTH),
        "w_branch_pool": w(ks[8], (L, POOL_WIDTH, D_MODEL), POOL_WIDTH),
        "w_out": w(ks[9], (L, D_MODEL, D_MODEL), D_MODEL),
        "norm_ffn": gain(ks[10], (L, D_MODEL)),
        "w_ffn_gate": w(ks[11], (L, D_MODEL, D_FF), D_MODEL),
        "w_ffn_up": w(ks[12], (L, D_MODEL, D_FF), D_MODEL),
        "w_ffn_down": w(ks[13], (L, D_FF, D_MODEL), D_FF),
    }


def reference(x, norm_mix, w_in, q_norm, k_norm, w_pool_group, pool_scale, w_branch_attn,
              w_branch_pool, w_out, norm_ffn, w_ffn_gate, w_ffn_up, w_ffn_down):
    B, S = x.shape[0], x.shape[1]
    for l in range(DEPTH):
        h = rms_norm(x, norm_mix[l])
        proj = h @ w_in[l]
        q, k, v, qi, ki, wi, u, gates = jnp.split(proj, IN_SPLITS, axis=-1)
        q = rms_norm(q.reshape(B, S, N_HEADS, HEAD_DIM), q_norm[l])
        k = rms_norm(k, k_norm[l])
        qi = qi.reshape(B, S, IDX_HEADS, IDX_DIM)
        wi = wi * IDX_SCALE
        a = dsa_attention(q, k, v, qi, ki, wi)
        p = multiscale_pool(u, w_pool_group[l], pool_scale[l])
        g_attn, g_pool = jnp.split(jax.nn.sigmoid(gates), N_BRANCHES, axis=-1)
        merged = g_attn * (a @ w_branch_attn[l]) + g_pool * (p @ w_branch_pool[l])
        x = x + merged @ w_out[l]
        h2 = rms_norm(x, norm_ffn[l])
        x = x + (jax.nn.silu(h2 @ w_ffn_gate[l]) * (h2 @ w_ffn_up[l])) @ w_ffn_down[l]
    return x
```

```cpp
#include <hip/hip_runtime.h>
#include <cstdio>
#include <cstdint>

#ifndef MK_PER_PHASE
#define MK_PER_PHASE 0
#endif
#ifndef MK_FP8
#define MK_FP8 1
#endif

__device__ __forceinline__ int mk_lane() { int l; asm volatile("v_mbcnt_lo_u32_b32 %0, -1, 0\n\tv_mbcnt_hi_u32_b32 %0, -1, %0" : "=v"(l)); return l; }
namespace pg8 {
#define PG8_LAS __attribute__((address_space(3)))
typedef unsigned short bf16_t;
typedef short bf16x8 __attribute__((ext_vector_type(8)));
typedef float f32x4 __attribute__((ext_vector_type(4)));
typedef unsigned u32x4 __attribute__((ext_vector_type(4)));
constexpr int BM = 256, BK = 64, HALF = 128, HTB = HALF * BK * 2  , STAGE_BYTES = 8 * HTB, NXCD = 8, WGM = 8;

__host__ __device__ __forceinline__ int lds_byte(int r, int c) { const int st = (r >> 4) * 2 + (c >> 5), rr = r & 15, cc = c & 31, ob = rr * 64 + cc * 2; return st * 1024 + (ob ^ (((ob >> 9) & 1) << 5)); }
__host__ __device__ __forceinline__ void stage_rc(int b, int& R, int& C) { const int st = b / 1024, sb = b % 1024, swz = sb ^ (((sb >> 9) & 1) << 5); R = (st >> 1) * 16 + swz / 64; C = (st & 1) * 32 + (swz % 64) / 2; }
__host__ __device__ __forceinline__ int perm32(int rho) { const int n = rho >> 4, i = rho & 15; return 8 * (i >> 2) + 4 * n + (i & 3); }

struct Unit { int pm, pn; };
struct Gemm { const bf16_t* A; const bf16_t* Bt; int M, N, K; int lda = 0; };

struct StaticOrder {
    int nM, nN, nwg, G, c;
    __host__ __device__ void init(int M, int N, int G_, int c_) { nM = M / BM; nN = N / BM; nwg = nM * nN; G = G_; c = c_; }
    __host__ __device__ bool next(int i, Unit& u) const {
        const long L = (long)i * G + c; if (L >= nwg) return false;
        int wgid = (int)L; { const int q = nwg / NXCD, r = nwg % NXCD, xcd = wgid % NXCD, off = wgid / NXCD; wgid = (xcd < r ? xcd * (q + 1) : r * (q + 1) + (xcd - r) * q) + off; }
        const int nig = WGM * nN, gid = wgid / nig, fm = gid * WGM, gsz = (nM - fm) < WGM ? (nM - fm) : WGM;
        u.pm = fm + ((wgid % nig) % gsz); u.pn = (wgid % nig) / gsz; return true;
    }
    __device__ __forceinline__ void a_ready(const Unit&) const {}
    __device__ __forceinline__ void done(const Unit&) const {}
};


template <bool FP8> __host__ __device__ __forceinline__ int lds_xor(int rr) { return FP8 ? (((rr >> 1) & 1) | (rr & 4)) : rr; }
template <bool FP8> __host__ __device__ __forceinline__ int lds_byte2(int r, int ch) { const int rr = r & 7; return (r >> 3) * 1024 + rr * 128 + ((ch ^ lds_xor<FP8>(rr)) << 4); }
template <bool FP8> __host__ __device__ __forceinline__ void stage_rc2(int b, int& R, int& CB) { const int st = b >> 10, i = (b & 1023) >> 4, rr = i >> 3, chp = i & 7; R = st * 8 + rr; CB = (chp ^ lds_xor<FP8>(rr)) << 4; }

struct ListOrder : StaticOrder {
    int mode;
    __host__ __device__ bool next(int i, Unit& u) const {
        long L;
        if (G != 256) { L = (long)i * G + c; }
        else if (mode == 0) { if (i >= 3 || (i == 2 && c >= 128)) return false; L = 256 * i + c; }
        else { if (c < 128) { if (i >= 4) return false; L = c + 128 * i; } else { if (i >= 6) return false; L = 512 + (c - 128) + 128 * i; } }
        if (L >= nwg) return false;
        int wgid = (int)L; { const int q = nwg / NXCD, r = nwg % NXCD, xcd = wgid % NXCD, off = wgid / NXCD; wgid = (xcd < r ? xcd * (q + 1) : r * (q + 1) + (xcd - r) * q) + off; }
        const int nig = WGM * nN, gid = wgid / nig, fm = gid * WGM, gsz = (nM - fm) < WGM ? (nM - fm) : WGM;
        u.pm = fm + ((wgid % nig) % gsz); u.pn = (wgid % nig) / gsz; return true;
    }
};


typedef float f32x2 __attribute__((ext_vector_type(2)));
typedef __bf16 bf16x2_t __attribute__((ext_vector_type(2)));
__device__ __forceinline__ unsigned cvt_pk_bf16(float lo, float hi) { f32x2 v = {lo, hi}; bf16x2_t b = __builtin_convertvector(v, bf16x2_t); return __builtin_bit_cast(unsigned, b); }
__device__ __forceinline__ u32x4 pack8(f32x4 a, f32x4 b) { u32x4 w; w.x = cvt_pk_bf16(a[0], a[1]); w.y = cvt_pk_bf16(a[2], a[3]); w.z = cvt_pk_bf16(b[0], b[1]); w.w = cvt_pk_bf16(b[2], b[3]); return w; }
typedef _Float16 f16x2_t __attribute__((ext_vector_type(2)));
__device__ __forceinline__ unsigned cvt_pk_f16(float lo, float hi) { f32x2 v = {lo, hi}; f16x2_t h = __builtin_convertvector(v, f16x2_t); return __builtin_bit_cast(unsigned, h); }
__device__ __forceinline__ u32x4 pack8h(f32x4 a, f32x4 b) { u32x4 w; w.x = cvt_pk_f16(a[0], a[1]); w.y = cvt_pk_f16(a[2], a[3]); w.z = cvt_pk_f16(b[0], b[1]); w.w = cvt_pk_f16(b[2], b[3]); return w; }
__device__ __forceinline__ void unpack8(u32x4 w, f32x4& a, f32x4& b) {
    a[0] = __uint_as_float(w.x << 16); a[1] = __uint_as_float(w.x & 0xffff0000u); a[2] = __uint_as_float(w.y << 16); a[3] = __uint_as_float(w.y & 0xffff0000u);
    b[0] = __uint_as_float(w.z << 16); b[1] = __uint_as_float(w.z & 0xffff0000u); b[2] = __uint_as_float(w.w << 16); b[3] = __uint_as_float(w.w & 0xffff0000u); }
__device__ __forceinline__ float h2f(unsigned h) { return (float)__builtin_bit_cast(_Float16, (unsigned short)h); }
__device__ __forceinline__ void unpack8h(u32x4 w, f32x4& a, f32x4& b) {
    a[0] = h2f(w.x & 0xffffu); a[1] = h2f(w.x >> 16); a[2] = h2f(w.y & 0xffffu); a[3] = h2f(w.y >> 16);
    b[0] = h2f(w.z & 0xffffu); b[1] = h2f(w.z >> 16); b[2] = h2f(w.w & 0xffffu); b[3] = h2f(w.w >> 16); }
__device__ __forceinline__ unsigned pk4_fp8(float a, float b, float c, float d) { unsigned r = __builtin_amdgcn_cvt_pk_fp8_f32(a, b, 0u, false); return (unsigned)__builtin_amdgcn_cvt_pk_fp8_f32(c, d, r, true); }
__device__ __forceinline__ unsigned long long pack8_fp8(f32x4 a, f32x4 b) { return (unsigned long long)pk4_fp8(a[0], a[1], a[2], a[3]) | ((unsigned long long)pk4_fp8(b[0], b[1], b[2], b[3]) << 32); }
constexpr float K_WSC = 64.0f, K_WSCI = 1.0f / 64.0f;
__device__ __forceinline__ float sum_fq(float s) {
    auto r16 = __builtin_amdgcn_permlane16_swap(__float_as_uint(s), __float_as_uint(s), false, false); s = __uint_as_float(r16[0]) + __uint_as_float(r16[1]);
    auto r32 = __builtin_amdgcn_permlane32_swap(__float_as_uint(s), __float_as_uint(s), false, false); return __uint_as_float(r32[0]) + __uint_as_float(r32[1]); }
__device__ __forceinline__ float fexp(float x) { return __builtin_amdgcn_exp2f(x * 1.4426950408889634f); }
__device__ __forceinline__ float frcp(float x) { return __builtin_amdgcn_rcpf(x); }

constexpr float K_EPS = 1e-6f, K_C2 = 0.125f * 1.4426950408889634f, K_IDXS = 0.04419417382415922f;

struct Epi1 {
    static constexpr bool PERM = true, AFTER_DRAIN = false, MID = false;
    const float* rstd; const float* qn; const float* kn;
    bf16_t *Q, *K, *V, *QI, *KI, *U, *R, *SP; float* WI; int pn_off; float wsc; mutable int cpm = -1; mutable float crs[2][4] = {};
    __device__ __forceinline__ void mid(f32x4 (&)[2][2][4][2], const Unit&, int, int, int, int) const {}
    template <bool NORM, bool F16 = false>
    __device__ __forceinline__ void head_tile(const f32x4 (&acc)[2][2][4][2], const float (&rsr)[2][4], int row0, int fq, bf16_t* dst, int pitch, int colbase, const float* gain, float scale) const {
        f32x4 g[2][2];
#pragma unroll
        for (int bj = 0; bj < 2; ++bj)
#pragma unroll
            for (int n = 0; n < 2; ++n) g[bj][n] = NORM ? *(const f32x4*)(gain + 32 * bj + 8 * fq + 4 * n) : (f32x4){1.f, 1.f, 1.f, 1.f};
#pragma unroll
        for (int ai = 0; ai < 2; ++ai)
#pragma unroll
            for (int m = 0; m < 4; ++m) {
                const int row = row0 + ai * HALF + m * 16; const float rs = rsr[ai][m];
                f32x4 v[2][2]; float ss = 0.f;
#pragma unroll
                for (int bj = 0; bj < 2; ++bj)
#pragma unroll
                    for (int n = 0; n < 2; ++n) { v[bj][n] = acc[ai][bj][m][n] * rs; const f32x4 q = v[bj][n] * v[bj][n]; ss += (q[0] + q[1]) + (q[2] + q[3]); }
                float mul = scale;
                if (NORM) { ss = sum_fq(ss); mul = __builtin_amdgcn_rsqf(ss * (1.0f / 64.0f) + K_EPS) * scale; }
#pragma unroll
                for (int bj = 0; bj < 2; ++bj) {
                    const f32x4 o0 = v[bj][0] * g[bj][0] * mul, o1 = v[bj][1] * g[bj][1] * mul;
                    *(u32x4*)(dst + (size_t)row * pitch + colbase + 32 * bj + 8 * fq) = F16 ? pack8h(o0, o1) : pack8(o0, o1);
                }
            }
    }
    __device__ __forceinline__ void operator()(const f32x4 (&acc)[2][2][4][2], const Unit& u, int wr, int wc, int fr, int fq) const {
        asm volatile("" : "+v"(fr), "+v"(fq));
        const int row0 = u.pm * BM + wr * 64 + fr; const int pn = u.pn + pn_off;
        float rsr[2][4];
        if (u.pm != cpm) {
#pragma unroll
            for (int ai = 0; ai < 2; ++ai)
#pragma unroll
                for (int m = 0; m < 4; ++m) crs[ai][m] = rstd[row0 + ai * HALF + m * 16];
            cpm = u.pm;
        }
#pragma unroll
        for (int ai = 0; ai < 2; ++ai)
#pragma unroll
            for (int m = 0; m < 4; ++m) rsr[ai][m] = crs[ai][m];
        if (pn >= 7) {
            const int cb = (pn - 7) * 128 + wc * 32 + 8 * fq;
#pragma unroll
            for (int ai = 0; ai < 2; ++ai)
#pragma unroll
                for (int m = 0; m < 4; ++m) {
                    const int row = row0 + ai * HALF + m * 16; const float rs = rsr[ai][m] * wsc;
                    f32x4 r[2], s[2];
#pragma unroll
                    for (int n = 0; n < 2; ++n)
#pragma unroll
                        for (int i = 0; i < 4; ++i) {
                            const float ea = fminf(fexp(-acc[ai][0][m][n][i] * rs), 1e30f), ep = fminf(fexp(-acc[ai][1][m][n][i] * rs), 1e30f);
                            const float sp = frcp(1.f + ep); s[n][i] = sp; r[n][i] = (1.f + ep) * frcp(1.f + ea);
                        }
                    *(u32x4*)(R + (size_t)row * 2048 + cb) = pack8(r[0], r[1]);
                    *(u32x4*)(SP + (size_t)row * 2048 + cb) = pack8(s[0], s[1]);
                }
        } else if (pn >= 5) {
#pragma unroll
            for (int ai = 0; ai < 2; ++ai)
#pragma unroll
                for (int m = 0; m < 4; ++m) {
                    const int row = row0 + ai * HALF + m * 16; const float rs = rsr[ai][m] * wsc;
#pragma unroll
                    for (int bj = 0; bj < 2; ++bj)
                        *(u32x4*)(U + (size_t)row * 512 + (pn - 5) * 256 + bj * HALF + wc * 32 + 8 * fq) = pack8(acc[ai][bj][m][0] * rs, acc[ai][bj][m][1] * rs);
                }
        } else if (pn == 2) {
            if (wc == 0) head_tile<true>(acc, rsr, row0, fq, K, 64, 0, kn, 1.0f);
            else if (wc == 1) head_tile<false>(acc, rsr, row0, fq, V, 64, 0, nullptr, 1.0f);
            else if (wc == 2) head_tile<false, true>(acc, rsr, row0, fq, KI, 64, 0, nullptr, 1.0f);
            else {
                if (fq == 0) {
#pragma unroll
                    for (int ai = 0; ai < 2; ++ai)
#pragma unroll
                        for (int m = 0; m < 4; ++m) {
                            const int row = row0 + ai * HALF + m * 16; const float rs = rsr[ai][m] * K_IDXS;
                            *(f32x4*)(WI + (size_t)row * 8) = acc[ai][0][m][0] * rs; *(f32x4*)(WI + (size_t)row * 8 + 4) = acc[ai][0][m][1] * rs;
                        }
                }
            }
        } else if (pn < 2) head_tile<true>(acc, rsr, row0, fq, Q, 512, (pn * 4 + wc) * 64, qn, K_C2);
        else head_tile<false, true>(acc, rsr, row0, fq, QI, 512, ((pn - 3) * 4 + wc) * 64, nullptr, 1.0f);
    }
};

struct Epi3 {
    static constexpr bool PERM = true, AFTER_DRAIN = false, MID = true;
    const bf16_t* R; const bf16_t* SP; unsigned char* MG;
    __device__ __forceinline__ void scale_by(f32x4 (&acc)[2][2][4][2], const bf16_t* Sc, const Unit& u, int wr, int wc, int fr, int fq) const {
        asm volatile("" : "+v"(fr), "+v"(fq));
        const int row0 = u.pm * BM + wr * 64 + fr, col0 = u.pn * BM + wc * 32 + 8 * fq;
#pragma unroll
        for (int ai = 0; ai < 2; ++ai) {
            u32x4 w[4][2];
#pragma unroll
            for (int m = 0; m < 4; ++m)
#pragma unroll
                for (int bj = 0; bj < 2; ++bj) w[m][bj] = *(const u32x4*)(Sc + (size_t)(row0 + ai * HALF + m * 16) * 2048 + col0 + bj * HALF);
#pragma unroll
            for (int m = 0; m < 4; ++m)
#pragma unroll
                for (int bj = 0; bj < 2; ++bj) { f32x4 a, b; unpack8(w[m][bj], a, b); acc[ai][bj][m][0] *= a; acc[ai][bj][m][1] *= b; }
        }
    }
    __device__ __forceinline__ void mid(f32x4 (&acc)[2][2][4][2], const Unit& u, int wr, int wc, int fr, int fq) const { scale_by(acc, R, u, wr, wc, fr, fq); }
    __device__ __forceinline__ void operator()(const f32x4 (&acc)[2][2][4][2], const Unit& u, int wr, int wc, int fr, int fq) const {
        asm volatile("" : "+v"(fr), "+v"(fq));
        const int row0 = u.pm * BM + wr * 64 + fr, col0 = u.pn * BM + wc * 32 + 8 * fq;
#pragma unroll
        for (int ai = 0; ai < 2; ++ai) {
            u32x4 w[4][2];
#pragma unroll
            for (int m = 0; m < 4; ++m)
#pragma unroll
                for (int bj = 0; bj < 2; ++bj) w[m][bj] = *(const u32x4*)(SP + (size_t)(row0 + ai * HALF + m * 16) * 2048 + col0 + bj * HALF);
#pragma unroll
            for (int m = 0; m < 4; ++m)
#pragma unroll
                for (int bj = 0; bj < 2; ++bj) {
                    const size_t off = (size_t)(row0 + ai * HALF + m * 16) * 1024 + col0 + bj * HALF;
                    f32x4 a, b; unpack8(w[m][bj], a, b);
                    *(unsigned long long*)(MG + off) = pack8_fp8(acc[ai][bj][m][0] * a * (8.0f * K_WSCI), acc[ai][bj][m][1] * b * (8.0f * K_WSCI));
                }
        }
    }
};

struct Epi4 {
    static constexpr bool PERM = true, AFTER_DRAIN = false, MID = false;
    const bf16_t* XB; bf16_t* H2; unsigned char* H2F8; float* SSQ;
    __device__ __forceinline__ void mid(f32x4 (&)[2][2][4][2], const Unit&, int, int, int, int) const {}
    __device__ __forceinline__ void operator()(const f32x4 (&acc)[2][2][4][2], const Unit& u, int wr, int wc, int fr, int fq) const {
        asm volatile("" : "+v"(fr), "+v"(fq));
        const int row0 = u.pm * BM + wr * 64 + fr, col0 = u.pn * BM + wc * 32 + 8 * fq;
#pragma unroll
        for (int ai = 0; ai < 2; ++ai) {
            u32x4 xw[4][2];
#pragma unroll
            for (int m = 0; m < 4; ++m)
#pragma unroll
                for (int bj = 0; bj < 2; ++bj) xw[m][bj] = *(const u32x4*)(XB + (size_t)(row0 + ai * HALF + m * 16) * 1024 + col0 + bj * HALF);
#pragma unroll
            for (int m = 0; m < 4; ++m) {
                const int row = row0 + ai * HALF + m * 16; float ss = 0.f;
#pragma unroll
                for (int bj = 0; bj < 2; ++bj) {
                    const size_t off = (size_t)row * 1024 + col0 + bj * HALF;
                    f32x4 a, b; unpack8h(xw[m][bj], a, b);
                    a += acc[ai][bj][m][0] * (K_WSCI * 0.125f); b += acc[ai][bj][m][1] * (K_WSCI * 0.125f);
                    const f32x4 q = a * a + b * b; ss += (q[0] + q[1]) + (q[2] + q[3]);
                    *(u32x4*)(H2 + off) = pack8(a, b);
                    *(unsigned long long*)(H2F8 + off) = pack8_fp8(a, b);
                }
                ss = sum_fq(ss);
                if (fq == 0) SSQ[(size_t)row * 16 + u.pn * 4 + wc] = ss;
            }
        }
    }
};

struct Epi5 {
    static constexpr bool PERM = true, AFTER_DRAIN = false, MID = false;
    const float* SSQ; unsigned char* ACT;
    mutable int cpm = -1; mutable float crs[2][4] = {};
    __device__ __forceinline__ void mid(f32x4 (&)[2][2][4][2], const Unit&, int, int, int, int) const {}
    __device__ __forceinline__ void operator()(const f32x4 (&acc)[2][2][4][2], const Unit& u, int wr, int wc, int fr, int fq) const {
        asm volatile("" : "+v"(fr), "+v"(fq));
        const int row0 = u.pm * BM + wr * 64 + fr, col0 = u.pn * 128 + wc * 32 + 8 * fq;
        float rsv[2][4];
        if (u.pm != cpm) { f32x4 part[2][4];
#pragma unroll
          for (int ai = 0; ai < 2; ++ai)
#pragma unroll
              for (int m = 0; m < 4; ++m) part[ai][m] = *(const f32x4*)(SSQ + (size_t)(row0 + ai * HALF + m * 16) * 16 + 4 * fq);
#pragma unroll
          for (int ai = 0; ai < 2; ++ai)
#pragma unroll
              for (int m = 0; m < 4; ++m) { float s = (part[ai][m][0] + part[ai][m][1]) + (part[ai][m][2] + part[ai][m][3]); s = sum_fq(s);
                  crs[ai][m] = __builtin_amdgcn_rsqf(s * (1.0f / 1024.0f) + K_EPS) * (MK_FP8 ? K_WSCI : 1.0f); }
          cpm = u.pm; }
#pragma unroll
        for (int ai = 0; ai < 2; ++ai)
#pragma unroll
            for (int m = 0; m < 4; ++m) rsv[ai][m] = crs[ai][m];
#pragma unroll
        for (int ai = 0; ai < 2; ++ai)
#pragma unroll
            for (int m = 0; m < 4; ++m) {
                const int row = row0 + ai * HALF + m * 16; const float rs = rsv[ai][m];
                const float k1 = -rs * 1.4426950408889634f, rs2 = rs * rs;
                f32x4 o[2];
#pragma unroll
                for (int n = 0; n < 2; ++n) {
                    const f32x4 ag = acc[ai][0][m][n], au = acc[ai][1][m][n];
                    const f32x4 t = ag * k1; f32x4 e;
#pragma unroll
                    for (int i = 0; i < 4; ++i) e[i] = __builtin_amdgcn_exp2f(t[i]);
                    const f32x4 d = e + 1.0f; f32x4 r;
#pragma unroll
                    for (int i = 0; i < 4; ++i) r[i] = __builtin_amdgcn_rcpf(d[i]);
                    o[n] = (ag * au) * (r * rs2);
                }
                if (MK_FP8) *(unsigned long long*)(ACT + (size_t)row * 4096 + col0) = pack8_fp8(o[0], o[1]); else *(u32x4*)((bf16_t*)ACT + (size_t)row * 2816 + col0) = pack8(o[0], o[1]);
            }
    }
};

struct Epi6 {
    static constexpr bool PERM = false, AFTER_DRAIN = false, MID = false;
    const bf16_t* H2; float* OUT;
    __device__ __forceinline__ void mid(f32x4 (&)[2][2][4][2], const Unit&, int, int, int, int) const {}
    __device__ __forceinline__ void operator()(const f32x4 (&acc)[2][2][4][2], const Unit& u, int wr, int wc, int fr, int fq) const {
        asm volatile("" : "+v"(fr), "+v"(fq));
        const int row0 = u.pm * BM + wr * 64 + fr, col0 = u.pn * BM + wc * 32 + 4 * fq;
#pragma unroll
        for (int ai = 0; ai < 2; ++ai) {
            unsigned long long hw[4][2][2];
#pragma unroll
            for (int m = 0; m < 4; ++m)
#pragma unroll
                for (int bj = 0; bj < 2; ++bj)
#pragma unroll
                    for (int n = 0; n < 2; ++n) hw[m][bj][n] = *(const unsigned long long*)(H2 + (size_t)(row0 + ai * HALF + m * 16) * 1024 + col0 + bj * HALF + n * 16);
#pragma unroll
            for (int m = 0; m < 4; ++m)
#pragma unroll
                for (int bj = 0; bj < 2; ++bj)
#pragma unroll
                    for (int n = 0; n < 2; ++n) {
                        const size_t off = (size_t)(row0 + ai * HALF + m * 16) * 1024 + col0 + bj * HALF + n * 16;
                        const unsigned long long w = hw[m][bj][n];
                        f32x4 r; r[0] = __uint_as_float((unsigned)w << 16); r[1] = __uint_as_float((unsigned)w & 0xffff0000u); r[2] = __uint_as_float((unsigned)(w >> 32) << 16); r[3] = __uint_as_float((unsigned)(w >> 32) & 0xffff0000u);
                        *(f32x4*)(OUT + off) = r + acc[ai][bj][m][n] * (MK_FP8 ? K_WSCI : 1.0f);
                    }
        }
    }
};

typedef int v8i_t __attribute__((ext_vector_type(8)));
typedef _Float16 f16x8_t __attribute__((ext_vector_type(8)));
typedef int v4i_t __attribute__((ext_vector_type(4)));
template <class Epi, class Sched, bool ALIGN_EPI = false, bool SP2 = false, int DT = 0>
__device__ __forceinline__ void gemm_phase(PG8_LAS unsigned char* lds, const Gemm g, const Sched& S, const Epi& E, const int wave_s) {
    const int wid = wave_s, lane = mk_lane(), tid = wid * 64 + lane, wr = wid >> 2, wc = wid & 3, fr = lane & 15, fq = lane >> 4;
    constexpr int ES = (DT == 2) ? 1 : 2, KST = (DT == 2) ? 16 : 1024;
    const int K = g.K, nt = K * ES / 128;
    const int rowA = g.lda ? g.lda : K * ES;
    unsigned voffA[2], voffB[2];
#pragma unroll
    for (int i = 0; i < 2; ++i) { int R, CB; stage_rc2<DT == 2>(tid * 16 + i * 8192, R, CB); const int Rb = Epi::PERM ? ((R & ~31) + perm32(R & 31)) : R;
        voffA[i] = (unsigned)(R * rowA + CB); voffB[i] = (unsigned)(Rb * K * ES + CB); }
    const size_t kstep = (size_t)(BK * 2);
    const size_t hstep = (size_t)HALF * K * ES;
    const size_t tstep = 2 * hstep;
    const size_t hstepA = (size_t)HALF * rowA, tstepA = 2 * hstepA;
    const unsigned ldsw = (unsigned)wid * 1024u;
    const int aoff = lds_byte2<DT == 2>(wr * 64 + fr, (DT == 2) ? 2 * fq : fq), boff = lds_byte2<DT == 2>(wc * 32 + fr, (DT == 2) ? 2 * fq : fq);
    const int aoff1 = aoff ^ ((DT == 2) ? 16 : 64), boff1 = boff ^ ((DT == 2) ? 16 : 64);
#define PG8_SA(b, h) (((b) * 2 + (h)) * HTB)
#define PG8_SB(b, h) ((4 + (b) * 2 + (h)) * HTB)
#define PG8_STAGE(bufoff, gbase, voff) do { _Pragma("unroll") for (int _i = 0; _i < 2; ++_i) \
        __builtin_amdgcn_global_load_lds((const unsigned*)((const char*)(gbase) + (voff)[_i]), (PG8_LAS unsigned*)(lds + (bufoff) + ldsw + _i * 8192), 16, 0, 0); } while (0)
#define PG8_LD8(dstv, ptr0, ptr1) do { const v4i_t lo_ = *(const PG8_LAS v4i_t*)(ptr0); const v4i_t hi_ = *(const PG8_LAS v4i_t*)(ptr1); dstv = __builtin_shufflevector(lo_, hi_, 0, 1, 2, 3, 4, 5, 6, 7); } while (0)
#define PG8_LDA(dst, b, h) do { if constexpr (DT == 2) { _Pragma("unroll") for (int m = 0; m < 4; ++m) PG8_LD8(dst##8[m], lds + PG8_SA(b, h) + aoff + m * 2048, lds + PG8_SA(b, h) + aoff1 + m * 2048); } else { \
        _Pragma("unroll") for (int m = 0; m < 4; ++m) _Pragma("unroll") for (int k = 0; k < 2; ++k) dst[m][k] = *(const PG8_LAS bf16x8*)(lds + PG8_SA(b, h) + (k ? aoff1 : aoff) + m * 2048); } } while (0)
#define PG8_LDB(dst, b, h) do { if constexpr (DT == 2) { _Pragma("unroll") for (int n = 0; n < 2; ++n) PG8_LD8(dst##8[n], lds + PG8_SB(b, h) + boff + n * 2048, lds + PG8_SB(b, h) + boff1 + n * 2048); } else { \
        _Pragma("unroll") for (int n = 0; n < 2; ++n) _Pragma("unroll") for (int k = 0; k < 2; ++k) dst[n][k] = *(const PG8_LAS bf16x8*)(lds + PG8_SB(b, h) + (k ? boff1 : boff) + n * 2048); } } while (0)
#define PG8_MMA(ai, bj, At, Bt) do { __builtin_amdgcn_s_setprio(1); _Pragma("unroll") for (int m = 0; m < 4; ++m) _Pragma("unroll") for (int n = 0; n < 2; ++n) { \
        if constexpr (DT == 2) { if (m == 0 && n == 0) asm volatile("s_nop 1\n\tv_mfma_f32_16x16x128_f8f6f4 %0, %1, %2, %0" : "+v"(acc[ai][bj][m][n]) : "v"(Bt##8[n]), "v"(At##8[m]));   \
            else asm volatile("v_mfma_f32_16x16x128_f8f6f4 %0, %1, %2, %0" : "+v"(acc[ai][bj][m][n]) : "v"(Bt##8[n]), "v"(At##8[m])); } \
        else if constexpr (DT == 1) { _Pragma("unroll") for (int k = 0; k < 2; ++k) acc[ai][bj][m][n] = __builtin_amdgcn_mfma_f32_16x16x32_f16(__builtin_bit_cast(f16x8_t, Bt[n][k]), __builtin_bit_cast(f16x8_t, At[m][k]), acc[ai][bj][m][n], 0, 0, 0); } \
        else { _Pragma("unroll") for (int k = 0; k < 2; ++k) acc[ai][bj][m][n] = __builtin_amdgcn_mfma_f32_16x16x32_bf16(Bt[n][k], At[m][k], acc[ai][bj][m][n], 0, 0, 0); } } \
        __builtin_amdgcn_s_setprio(0); } while (0)
#define PG8_WAIT_V(n) asm volatile("s_waitcnt vmcnt(" #n ")" ::: "memory")
#define PG8_WAIT_L(n) asm volatile("s_waitcnt lgkmcnt(" #n ")" ::: "memory")
#define PG8_BAR __builtin_amdgcn_s_barrier()
#define PG8_SCHED __builtin_amdgcn_sched_barrier(0)
    Unit cur, nxt; int ui = 0;
    if (!S.next(0, cur)) return;
    f32x4 acc[2][2][4][2];
#pragma unroll
    for (int a = 0; a < 2; ++a)
#pragma unroll
        for (int b = 0; b < 2; ++b)
#pragma unroll
            for (int m = 0; m < 4; ++m)
#pragma unroll
                for (int n = 0; n < 2; ++n) acc[a][b][m][n] = (f32x4){0.f, 0.f, 0.f, 0.f};
    bf16x8 At[4][2], B0[2][2], B1[2][2]; v8i_t At8[4], B08[2], B18[2];
    const char* cA = (const char*)g.A + (size_t)cur.pm * tstepA; const char* cB = (const char*)g.Bt + (size_t)cur.pn * tstep;
    S.a_ready(cur);
    if constexpr (SP2) {
        PG8_STAGE(PG8_SB(0, 0), cB, voffB); PG8_STAGE(PG8_SB(0, 1), cB + hstep, voffB); PG8_STAGE(PG8_SA(0, 0), cA, voffA); PG8_STAGE(PG8_SA(0, 1), cA + hstepA, voffA);
        if (wr == 1) PG8_BAR;
        PG8_WAIT_V(2); PG8_BAR;
        PG8_STAGE(PG8_SB(1, 0), cB + kstep, voffB); PG8_STAGE(PG8_SA(1, 0), cA + kstep, voffA); PG8_STAGE(PG8_SB(1, 1), cB + hstep + kstep, voffB);
        PG8_WAIT_V(6); PG8_BAR;
    } else {
        PG8_STAGE(PG8_SB(0, 0), cB, voffB); PG8_STAGE(PG8_SA(0, 0), cA, voffA); PG8_STAGE(PG8_SB(0, 1), cB + hstep, voffB); PG8_STAGE(PG8_SA(0, 1), cA + hstepA, voffA);
        if (wr == 1) PG8_BAR;
        PG8_WAIT_V(4); PG8_BAR;
        PG8_STAGE(PG8_SB(1, 0), cB + kstep, voffB); PG8_STAGE(PG8_SA(1, 0), cA + kstep, voffA); PG8_STAGE(PG8_SB(1, 1), cB + hstep + kstep, voffB);
        PG8_WAIT_V(6); PG8_BAR;
    }
    for (;;) {
        const bool has_next = S.next(ui + 1, nxt);
        const char* nA = has_next ? (const char*)g.A + (size_t)nxt.pm * tstepA : cA; const char* nB = has_next ? (const char*)g.Bt + (size_t)nxt.pn * tstep : cB;
#pragma unroll 1
        for (int t = 0; t < nt; t += 2) {
            if constexpr (Epi::MID) { if (t == (nt >> 1)) { if constexpr (DT == 2) asm volatile("s_nop 15\n\ts_nop 15" ::: "memory"); __builtin_amdgcn_sched_barrier(0); E.mid(acc, cur, wr, wc, fr, fq); if constexpr (DT == 2) { __builtin_amdgcn_sched_barrier(0); asm volatile("s_nop 4" ::: "memory"); } } }
            asm volatile("" : "+v"(voffA[0]), "+v"(voffA[1]), "+v"(voffB[0]), "+v"(voffB[1]));
            const bool last = (t == nt - 2);
            const char* a1 = cA + (size_t)(t + 1) * kstep;
            const char* a2 = last ? nA : cA + (size_t)(t + 2) * kstep; const char* b2 = last ? nB : cB + (size_t)(t + 2) * kstep;
            const char* a3 = a2 + kstep; const char* b3 = b2 + kstep;
            if (last && has_next) S.a_ready(nxt);
            if constexpr (SP2) {
            PG8_LDB(B0, 0, 0); PG8_LDB(B1, 0, 1); PG8_SCHED; PG8_LDA(At, 0, 0); PG8_STAGE(PG8_SA(1, 1), a1 + hstepA, voffA);
            PG8_WAIT_V(8); PG8_WAIT_L(0); PG8_BAR; PG8_MMA(0, 0, At, B0); PG8_MMA(0, 1, At, B1); PG8_BAR; PG8_SCHED;
            PG8_LDA(At, 0, 1); PG8_STAGE(PG8_SB(0, 0), b2, voffB); PG8_STAGE(PG8_SB(0, 1), b2 + hstep, voffB); PG8_STAGE(PG8_SA(0, 0), a2, voffA);
            PG8_WAIT_V(8); PG8_WAIT_L(0); PG8_BAR; PG8_MMA(1, 0, At, B0); PG8_MMA(1, 1, At, B1); PG8_BAR; PG8_SCHED;
            PG8_LDB(B0, 1, 0); PG8_LDB(B1, 1, 1); PG8_SCHED; PG8_LDA(At, 1, 0); PG8_STAGE(PG8_SA(0, 1), a2 + hstepA, voffA);
            PG8_WAIT_V(8); PG8_WAIT_L(0); PG8_BAR; PG8_MMA(0, 0, At, B0); PG8_MMA(0, 1, At, B1); PG8_BAR; PG8_SCHED;
            PG8_LDA(At, 1, 1); PG8_STAGE(PG8_SB(1, 0), b3, voffB); PG8_STAGE(PG8_SB(1, 1), b3 + hstep, voffB); PG8_STAGE(PG8_SA(1, 0), a3, voffA);
            PG8_WAIT_V(8); PG8_WAIT_L(0); PG8_BAR; PG8_MMA(1, 0, At, B0); PG8_MMA(1, 1, At, B1); PG8_BAR; PG8_SCHED;
            } else {
            PG8_LDB(B0, 0, 0); PG8_SCHED; PG8_LDA(At, 0, 0); PG8_STAGE(PG8_SA(1, 1), a1 + hstepA, voffA);
            PG8_WAIT_L(8); PG8_BAR; PG8_WAIT_L(0); PG8_MMA(0, 0, At, B0); PG8_BAR; PG8_SCHED;
            PG8_LDB(B1, 0, 1); PG8_STAGE(PG8_SB(0, 0), b2, voffB);
            PG8_BAR; PG8_WAIT_L(0); PG8_MMA(0, 1, At, B1); PG8_BAR;
            PG8_LDA(At, 0, 1); PG8_STAGE(PG8_SA(0, 0), a2, voffA);
            PG8_BAR; PG8_WAIT_L(0); PG8_MMA(1, 0, At, B0); PG8_BAR; PG8_SCHED;
            PG8_STAGE(PG8_SB(0, 1), b2 + hstep, voffB);
            PG8_WAIT_V(6); PG8_BAR; PG8_MMA(1, 1, At, B1); PG8_BAR;
            PG8_LDB(B0, 1, 0); PG8_SCHED; PG8_LDA(At, 1, 0); PG8_STAGE(PG8_SA(0, 1), a2 + hstepA, voffA);
            PG8_WAIT_L(8); PG8_BAR; PG8_WAIT_L(0); PG8_MMA(0, 0, At, B0); PG8_BAR; PG8_SCHED;
            PG8_LDB(B1, 1, 1); PG8_STAGE(PG8_SB(1, 0), b3, voffB);
            PG8_BAR; PG8_WAIT_L(0); PG8_MMA(0, 1, At, B1); PG8_BAR;
            PG8_LDA(At, 1, 1); PG8_STAGE(PG8_SA(1, 0), a3, voffA);
            PG8_BAR; PG8_WAIT_L(0); PG8_MMA(1, 0, At, B0); PG8_BAR; PG8_SCHED;
            PG8_STAGE(PG8_SB(1, 1), b3 + hstep, voffB);
            PG8_WAIT_V(6); PG8_BAR; PG8_MMA(1, 1, At, B1); PG8_BAR;
            }
        }
        if constexpr (DT == 2) { asm volatile("s_nop 15\n\ts_nop 15" ::: "memory"); __builtin_amdgcn_sched_barrier(0); }
        if constexpr (ALIGN_EPI) { if (wr == 0) PG8_BAR; }
        if constexpr (!Epi::AFTER_DRAIN) { E(acc, cur, wr, wc, fr, fq); S.done(cur); }
        if (!has_next) break;
#pragma unroll
        for (int a = 0; a < 2; ++a)
#pragma unroll
            for (int b = 0; b < 2; ++b)
#pragma unroll
                for (int m = 0; m < 4; ++m)
#pragma unroll
                    for (int n = 0; n < 2; ++n) acc[a][b][m][n] = (f32x4){0.f, 0.f, 0.f, 0.f};
        cur = nxt; cA = nA; cB = nB; ++ui;
        if constexpr (ALIGN_EPI) { if (wr == 1) PG8_BAR; }
    }
    PG8_WAIT_V(0);
    if constexpr (!ALIGN_EPI) { if (wr == 0) PG8_BAR; }
    PG8_BAR;
    if constexpr (Epi::AFTER_DRAIN) { E.fused(acc, cur, wr, wc, fr, fq, lds, wid, lane); S.done(cur); }
#undef PG8_SA
#undef PG8_SB
#undef PG8_STAGE
#undef PG8_LD8
#undef PG8_LDA
#undef PG8_LDB
#undef PG8_MMA
#undef PG8_WAIT_V
#undef PG8_WAIT_L
#undef PG8_BAR
#undef PG8_SCHED
}
}

namespace att {
typedef unsigned short bf16_t;
typedef short bf16x8 __attribute__((ext_vector_type(8)));
typedef short s16x4 __attribute__((ext_vector_type(4)));
typedef _Float16 f16x8 __attribute__((ext_vector_type(8)));
typedef short v4i16_t __attribute__((ext_vector_type(4)));
typedef float f32x16 __attribute__((ext_vector_type(16)));
typedef float f32x32 __attribute__((ext_vector_type(32)));
typedef float f32x4 __attribute__((ext_vector_type(4)));
typedef float f32x2_t __attribute__((ext_vector_type(2)));
typedef __bf16 bf16x2_t __attribute__((ext_vector_type(2)));
typedef unsigned u32x4 __attribute__((ext_vector_type(4)));
#define ALAS __attribute__((address_space(3)))
typedef ALAS unsigned char* lptr;
constexpr int SEQ = 2048;
constexpr int LK = 0, LV = 32768, VSLOT = 8320, VDH = 4160, LBM = 66048, LWS = 74240, LOST = 76288, LBYTES = 109056;
constexpr float LOG2E = 1.4426950408889634f;
constexpr float THR = 8.0f;

__device__ __forceinline__ int crow(int r, int hi) { return (r & 3) + 8 * (r >> 2) + 4 * hi; }
__device__ __forceinline__ unsigned cvtpk_s(float lo, float hi) { f32x2_t v = {lo, hi}; bf16x2_t b = __builtin_convertvector(v, bf16x2_t); return __builtin_bit_cast(unsigned, b); }
__device__ __forceinline__ s16x4 vtr(lptr p) { return __builtin_bit_cast(s16x4, __builtin_amdgcn_ds_read_tr16_b64_v4i16((ALAS v4i16_t*)p)); }
__device__ __forceinline__ float bf_round(float f) { unsigned u = __float_as_uint(f); u = (u + 0x7fffu + ((u >> 16) & 1u)) & 0xffff0000u; return __uint_as_float(u); }
__device__ __forceinline__ unsigned fkey(float f) { const unsigned u = __float_as_uint(f); return u ^ ((unsigned)((int)u >> 31) | 0x80000000u); }
__device__ __forceinline__ int half_sum(int v) {
    v += __builtin_amdgcn_update_dpp(0, v, 0xB1, 0xF, 0xF, true);
    v += __builtin_amdgcn_update_dpp(0, v, 0x4E, 0xF, 0xF, true);
    v += __builtin_amdgcn_update_dpp(0, v, 0x141, 0xF, 0xF, true);
    v += __builtin_amdgcn_update_dpp(0, v, 0x140, 0xF, 0xF, true);
    auto rr = __builtin_amdgcn_permlane16_swap((unsigned)v, (unsigned)v, false, false);
    return (int)rr[0] + (int)rr[1];
}
__device__ __forceinline__ float relu1(float x) { const int i = __float_as_int(x); return __int_as_float(i > 0 ? i : 0); }
__device__ __forceinline__ void cnt4(int& c0, int& c1, float k0, float k1, float k2, float k3, float cand) {
    asm volatile("v_cmp_le_f32_e32 vcc, %6, %2\n\tv_addc_co_u32_e32 %0, vcc, 0, %0, vcc\n\tv_cmp_le_f32_e32 vcc, %6, %3\n\tv_addc_co_u32_e32 %1, vcc, 0, %1, vcc\n\t"
                 "v_cmp_le_f32_e32 vcc, %6, %4\n\tv_addc_co_u32_e32 %0, vcc, 0, %0, vcc\n\tv_cmp_le_f32_e32 vcc, %6, %5\n\tv_addc_co_u32_e32 %1, vcc, 0, %1, vcc"
                 : "+v"(c0), "+v"(c1) : "v"(k0), "v"(k1), "v"(k2), "v"(k3), "v"(cand) : "vcc");
}
__device__ __forceinline__ float dppf(float v, int ctl) { return ctl == 0 ? __uint_as_float(__builtin_amdgcn_update_dpp(0u, __float_as_uint(v), 0xB1, 0xF, 0xF, true)) : ctl == 1 ? __uint_as_float(__builtin_amdgcn_update_dpp(0u, __float_as_uint(v), 0x4E, 0xF, 0xF, true))
                                                        : ctl == 2 ? __uint_as_float(__builtin_amdgcn_update_dpp(0u, __float_as_uint(v), 0x141, 0xF, 0xF, true)) : __uint_as_float(__builtin_amdgcn_update_dpp(0u, __float_as_uint(v), 0x140, 0xF, 0xF, true)); }
__device__ __forceinline__ float half_max(float v) { v = __builtin_fmaxf(v, dppf(v, 0)); v = __builtin_fmaxf(v, dppf(v, 1)); v = __builtin_fmaxf(v, dppf(v, 2)); v = __builtin_fmaxf(v, dppf(v, 3));
    auto rr = __builtin_amdgcn_permlane16_swap(__float_as_uint(v), __float_as_uint(v), false, false); return __builtin_fmaxf(__uint_as_float(rr[0]), __uint_as_float(rr[1])); }
__device__ __forceinline__ float half_min(float v) { v = __builtin_fminf(v, dppf(v, 0)); v = __builtin_fminf(v, dppf(v, 1)); v = __builtin_fminf(v, dppf(v, 2)); v = __builtin_fminf(v, dppf(v, 3));
    auto rr = __builtin_amdgcn_permlane16_swap(__float_as_uint(v), __float_as_uint(v), false, false); return __builtin_fminf(__uint_as_float(rr[0]), __uint_as_float(rr[1])); }
#define MX3(a, b, c) __builtin_fmaxf(__builtin_fmaxf((a), (b)), (c))
__device__ __forceinline__ float rowmax(const f32x16& p0, const f32x16& p1) {
    float a = MX3(p0[0], p0[1], p1[0]), b = MX3(p0[2], p0[3], p1[1]); a = MX3(a, p1[2], p1[3]);
#pragma unroll
    for (int r = 4; r < 16; r += 4) { a = MX3(a, p0[r], p0[r + 1]); b = MX3(b, p0[r + 2], p0[r + 3]); a = MX3(a, p1[r], p1[r + 1]); b = MX3(b, p1[r + 2], p1[r + 3]); }
    float m = __builtin_fmaxf(a, b); auto rr = __builtin_amdgcn_permlane32_swap(__float_as_uint(m), __float_as_uint(m), false, false);
    return __builtin_fmaxf(__uint_as_float(rr[0]), __uint_as_float(rr[1])); }

struct Tensors { const bf16_t* Q; const bf16_t* K; const bf16_t* V; const bf16_t* QI; const bf16_t* KI; const float* WI; unsigned char* AP; float qk2; };

__device__ __forceinline__ u32x4 tile_ld(const bf16_t* base, long row0, int tid) { const unsigned voff = (unsigned)((tid >> 3) * 128 + (tid & 7) * 16); return *(const u32x4*)((const char*)(base + row0 * 64) + voff); }
__device__ __forceinline__ void kimg_st(lptr lds, int slot, int tid, u32x4 v) { const int row = tid >> 3, ch = tid & 7; *(ALAS u32x4*)(lds + LK + slot * 8192 + row * 128 + ((ch ^ ((row >> 1) & 7)) << 4)) = v; }
__device__ __forceinline__ void kimg_dma(lptr lds, int slot, int wid, int lane, const bf16_t* base, long row0) {
    const int row = 8 * wid + (lane >> 3), ch = (lane & 7) ^ ((row >> 1) & 7);
    __builtin_amdgcn_global_load_lds((const unsigned*)((const char*)(base + row0 * 64) + row * 128 + ch * 16), (ALAS unsigned*)(lds + LK + slot * 8192 + wid * 1024), 16, 0, 0);
}
__device__ __forceinline__ int kfrag_off(int r32, int hi, int d0) { return r32 * 128 + (((2 * d0 + hi) ^ ((r32 >> 1) & 7)) << 4); }
__device__ __forceinline__ void vimg_st(lptr lds, int slot, int tid, u32x4 v) { *(ALAS u32x4*)(lds + LV + slot * VSLOT + ((tid & 7) >> 2) * VDH + (tid >> 3) * 64 + (tid & 3) * 16) = v; }

struct UnitPF { bf16x8 qi[4]; f32x4 wv[4]; };
__device__ __forceinline__ void unit_prefetch(UnitPF& pf, int b, int qb, const Tensors& T, const int wave_s, lptr lds, const bool dma) {
    int tid = threadIdx.x; asm volatile("" : "+v"(tid));
    const int lane = tid & 63, r32 = lane & 31, hi = lane >> 5; const int wid = __builtin_amdgcn_readfirstlane(threadIdx.x >> 6);
    const int t0 = qb * 32, NT = (qb >> 1) + 1; const long rowbase = (long)b * SEQ; const long tq_row = rowbase + t0 + 4 * wid + (r32 >> 3);
#pragma unroll
    for (int d0 = 0; d0 < 4; ++d0) pf.qi[d0] = *(const bf16x8*)(T.QI + tq_row * 512 + (r32 & 7) * 64 + d0 * 16 + hi * 8);
#pragma unroll
    for (int g = 0; g < 4; ++g) pf.wv[g] = *(const f32x4*)(T.WI + (rowbase + t0 + 4 * wid + g) * 8 + 4 * hi);
    if (dma) {
#pragma unroll
        for (int t = 0; t < 4; ++t) if (t < NT) kimg_dma(lds, t, wid, lane, T.KI, rowbase + 64 * t);
    }
}
__device__ __forceinline__ void attn_unit(int b, int qb, const Tensors& T, lptr lds, UnitPF& pf, bool has_next, int nb, int nqb, const int wave_s) {
    int tid_ = threadIdx.x; asm volatile("" : "+v"(tid_));
    const int tid = tid_, lane = tid & 63, r32 = lane & 31, hi = lane >> 5; const int wid = __builtin_amdgcn_readfirstlane(threadIdx.x >> 6);
    const int t0 = qb * 32, NT = (qb >> 1) + 1;
    const long rowbase = (long)b * SEQ;
    const int g_row = r32 >> 3, h_row = r32 & 7;
    const long tq_row = rowbase + t0 + 4 * wid + g_row;

    f32x32 keyv[2][2];
#define KEY(j, n, pr) keyv[n][pr][j]
#ifndef REP_IDX
#define REP_IDX 1
#endif
#ifndef REP_SEL
#define REP_SEL 1
#endif
#ifndef REP_ATT
#define REP_ATT 1
#endif
#pragma unroll 1
    for (int rep_i = 0; rep_i < REP_IDX; ++rep_i) {
        bf16x8 qi[4]; f32x4 wv[4];
#pragma unroll
        for (int d0 = 0; d0 < 4; ++d0) { qi[d0] = pf.qi[d0]; wv[d0] = pf.wv[d0]; }
        const int lanev = r32 - hi;
        __syncthreads();
        int kfo0 = kfrag_off(r32, hi, 0); asm volatile("" : "+v"(kfo0));
        bf16x8 F[8];
#pragma unroll
        for (int q = 0; q < 8; ++q) F[q] = *(const ALAS bf16x8*)(lds + LK + (kfo0 ^ ((q >> 1) << 5)) + (q & 1) * 4096);
#pragma unroll
        for (int n = 0; n < 2; ++n) { keyv[n][0] = (f32x32)(__builtin_nanf("")); keyv[n][1] = (f32x32)(__builtin_nanf("")); }
#pragma unroll 1
        for (int jb = 0; jb < NT; jb += 2) {
#pragma unroll
            for (int u = 0; u < 2; ++u) {
                const int j = jb + u;
                if (u == 0 || j < NT) {
                    if (u == 0) {
                        if (j + 4 < NT) kimg_dma(lds, (j + 4) % 6, wid, lane, T.KI, rowbase + 64 * (j + 4));
                        if (j + 5 < NT) kimg_dma(lds, (j + 5) % 6, wid, lane, T.KI, rowbase + 64 * (j + 5));
                    }
                    f32x16 acc0 = {}, acc1 = {};
#pragma unroll
                    for (int d0 = 0; d0 < 4; ++d0) {
                        acc0 = __builtin_amdgcn_mfma_f32_32x32x16_f16(__builtin_bit_cast(f16x8, qi[d0]), __builtin_bit_cast(f16x8, F[2 * d0]), acc0, 0, 0, 0);
                        acc1 = __builtin_amdgcn_mfma_f32_32x32x16_f16(__builtin_bit_cast(f16x8, qi[d0]), __builtin_bit_cast(f16x8, F[2 * d0 + 1]), acc1, 0, 0, 0);
                    }
                    __builtin_amdgcn_sched_barrier(0);
                    if (j + 1 < NT) {
                        const int so = ((j + 1) % 6) * 8192;
#pragma unroll
                        for (int q = 0; q < 8; ++q) F[q] = *(const ALAS bf16x8*)(lds + LK + so + (kfo0 ^ ((q >> 1) << 5)) + (q & 1) * 4096);
                    }
                    __builtin_amdgcn_sched_barrier(0);
#pragma unroll
                    for (int n = 0; n < 2; ++n) {
                        const f32x16& acc = n ? acc1 : acc0;
                        float part[4];
#pragma unroll
                        for (int g = 0; g < 4; ++g) {
                            float s = wv[g][0] * relu1(acc[4 * g]);
                            s = __builtin_fmaf(wv[g][1], relu1(acc[4 * g + 1]), s);
                            s = __builtin_fmaf(wv[g][2], relu1(acc[4 * g + 2]), s);
                            s = __builtin_fmaf(wv[g][3], relu1(acc[4 * g + 3]), s);
                            part[g] = s;
                        }
#pragma unroll
                        for (int pr = 0; pr < 2; ++pr) {
                            auto rr = __builtin_amdgcn_permlane32_swap(__float_as_uint(part[2 * pr]), __float_as_uint(part[2 * pr + 1]), false, false);
                            const float v = __uint_as_float(rr[0]) + __uint_as_float(rr[1]);
                            const int urel = t0 + 4 * wid + 2 * pr - 64 * j - 32 * n;
                            KEY(j, n, pr) = (lanev <= urel) ? v : __builtin_nanf("");
                        }
                    }
                    if (u == 1) __syncthreads();
                }
            }
        }
        __syncthreads();
    }
    int tidL = tid; asm volatile("" : "+v"(tidL));
    const int lane3 = tidL & 63, r32c = lane3 & 31, hic = lane3 >> 5;
    const long tq_row3 = rowbase + t0 + 4 * wid + (r32c >> 3);
    bf16x8 qr[4];
#pragma unroll
    for (int d0 = 0; d0 < 4; ++d0) qr[d0] = *(const bf16x8*)(T.Q + tq_row3 * 512 + (r32c & 7) * 64 + d0 * 16 + hic * 8);
    u32x4 sk = tile_ld(T.K, rowbase + 64 * (NT - 1), tidL), sv = tile_ld(T.V, rowbase + 64 * (NT - 1), tidL);
    u32x4 sk2 = tile_ld(T.K, rowbase + 64 * (NT > 1 ? NT - 2 : 0), tidL), sv2 = tile_ld(T.V, rowbase + 64 * (NT > 1 ? NT - 2 : 0), tidL);
    u32x4 skA = tile_ld(T.K, rowbase + 64 * (NT > 2 ? NT - 3 : 0), tidL), svA = tile_ld(T.V, rowbase + 64 * (NT > 2 ? NT - 3 : 0), tidL);
    u32x4 skB = tile_ld(T.K, rowbase + 64 * (NT > 3 ? NT - 4 : 0), tidL), svB = tile_ld(T.V, rowbase + 64 * (NT > 3 ? NT - 4 : 0), tidL);
    ALAS unsigned* bm = (ALAS unsigned*)(lds + LBM) + wid * 256;
#pragma unroll 1
    for (int rep_s = 0; rep_s < REP_SEL; ++rep_s) {
        float Tk[2], lo[2], hi2[2], fl[2], fh[2]; bool done[2], conv[2], strad[2]; int nq[2], side[2];
#pragma unroll
        for (int pr = 0; pr < 2; ++pr) {
            nq[pr] = t0 + 4 * wid + 2 * pr + hi + 1;
            Tk[pr] = -__builtin_inff(); done[pr] = (nq[pr] <= 256); conv[pr] = done[pr]; lo[pr] = 0.f; hi2[pr] = 0.f; strad[pr] = false;
            fl[pr] = __builtin_amdgcn_logf((float)nq[pr]) - 8.0028150f; fh[pr] = -9.0028150f; side[pr] = 0;
        }
        if (!__all(done[0] && done[1])) {
#pragma unroll
            for (int pr = 0; pr < 2; ++pr) {
                float vmax = -__builtin_inff(), vmin = __builtin_inff();
#pragma unroll
                for (int jg = 0; jg < 8; ++jg) if (4 * jg < NT) {
#pragma unroll
                    for (int q = 0; q < 4; ++q)
#pragma unroll
                        for (int n = 0; n < 2; ++n) { vmax = __builtin_fmaxf(vmax, KEY(4 * jg + q, n, pr)); vmin = __builtin_fminf(vmin, KEY(4 * jg + q, n, pr)); }
                }
                lo[pr] = half_min(vmin); float h = half_max(vmax);
                { const int hb = __float_as_int(h); h = (h == 0.f) ? 1.4e-45f : __int_as_float(hb + (hb >= 0 ? 1 : -1)); }
                hi2[pr] = h;
                strad[pr] = (lo[pr] < 0.f) & (h > 0.f);
            }
#pragma unroll 1
            for (int it = 0; it < 96; ++it) {
                float mid[2];
#pragma unroll
                for (int pr = 0; pr < 2; ++pr) {
                    float m = lo[pr] + (hi2[pr] - lo[pr]) * (fl[pr] * __builtin_amdgcn_rcpf(fl[pr] - fh[pr]));
                    const float mb = 0.5f * lo[pr] + 0.5f * hi2[pr];
                    const bool in1 = (m > lo[pr]) & (m < hi2[pr]);
                    m = ((it >= 14) | !in1) ? mb : m;
                    if (it == 0) m = strad[pr] ? ((hi2[pr] > 1.4e-45f) ? 1.4e-45f : 0.f) : m;
                    if (it == 1) m = (strad[pr] & (hi2[pr] == 1.4e-45f) & (lo[pr] < 0.f)) ? 0.f : m;
                    const bool in2 = (m > lo[pr]) & (m < hi2[pr]);
                    conv[pr] = conv[pr] | !in2 | done[pr];
                    mid[pr] = m;
                }
                if (__all(conv[0] & conv[1])) break;
                int c0a = 0, c0b = 0, c1a = 0, c1b = 0;
#pragma unroll
                for (int jg = 0; jg < 8; ++jg) if (4 * jg < NT) {
                    cnt4(c0a, c0b, KEY(4 * jg, 0, 0), KEY(4 * jg, 1, 0), KEY(4 * jg + 1, 0, 0), KEY(4 * jg + 1, 1, 0), mid[0]);
                    cnt4(c1a, c1b, KEY(4 * jg, 0, 1), KEY(4 * jg, 1, 1), KEY(4 * jg + 1, 0, 1), KEY(4 * jg + 1, 1, 1), mid[1]);
                    cnt4(c0a, c0b, KEY(4 * jg + 2, 0, 0), KEY(4 * jg + 2, 1, 0), KEY(4 * jg + 3, 0, 0), KEY(4 * jg + 3, 1, 0), mid[0]);
                    cnt4(c1a, c1b, KEY(4 * jg + 2, 0, 1), KEY(4 * jg + 2, 1, 1), KEY(4 * jg + 3, 0, 1), KEY(4 * jg + 3, 1, 1), mid[1]);
                }
                int c[2]; c[0] = half_sum(c0a + c0b); c[1] = half_sum(c1a + c1b);
#pragma unroll
                for (int pr = 0; pr < 2; ++pr) {
                    const bool ge = (c[pr] >= 256), ul = !conv[pr] & ge, uh = !conv[pr] & !ge;
                    const float fc = __builtin_amdgcn_logf((float)c[pr] + (ge ? 0.f : 0.5f)) - 8.0028150f;
                    const float fhn = ul ? ((side[pr] > 0) ? 0.5f * fh[pr] : fh[pr]) : (uh ? fc : fh[pr]), fln = uh ? ((side[pr] < 0) ? 0.5f * fl[pr] : fl[pr]) : (ul ? fc : fl[pr]);
                    fh[pr] = fhn; fl[pr] = fln; side[pr] = ul ? 1 : (uh ? -1 : side[pr]);
                    lo[pr] = ul ? mid[pr] : lo[pr]; hi2[pr] = uh ? mid[pr] : hi2[pr]; done[pr] = done[pr] | (ul & (c[pr] == 256));
                }
            }
#pragma unroll
            for (int pr = 0; pr < 2; ++pr) { Tk[pr] = lo[pr]; if (nq[pr] <= 256) { Tk[pr] = -__builtin_inff(); done[pr] = true; } }
        }
#pragma unroll
        for (int pr = 0; pr < 2; ++pr) {
        if (__all(done[pr])) {
#pragma unroll
            for (int jh = 0; jh < 2; ++jh) if (16 * jh < NT) {
                unsigned wx = 0u;
#pragma unroll
                for (int j = 16 * jh; j < 16 * jh + 16; ++j) if (j < NT) {
#pragma unroll
                    for (int n = 0; n < 2; ++n) {
                        const unsigned long long pb = __ballot(KEY(j, n, pr) >= Tk[pr]);
                        asm volatile("s_nop 1\n\tv_writelane_b32 %0, %1, %3\n\tv_writelane_b32 %0, %2, %4" : "+v"(wx) : "s"((unsigned)pb), "s"((unsigned)(pb >> 32)), "i"(2 * (j & 15) + n), "i"(32 + 2 * (j & 15) + n));
                    }
                }
                bm[(32 * jh + r32) * 4 + 2 * pr + hi] = wx;
            }
        } else {
        int gt = 0;
#pragma unroll
        for (int j = 0; j < 32; ++j) if (j < NT) { gt += (KEY(j, 0, pr) > Tk[pr]) ? 1 : 0; gt += (KEY(j, 1, pr) > Tk[pr]) ? 1 : 0; }
        gt = half_sum(gt);
        const int need = 256 - gt; int seen = 0;
#pragma unroll
        for (int j = 0; j < 32; ++j) if (j < NT) {
#pragma unroll
            for (int n = 0; n < 2; ++n) {
                const float k = KEY(j, n, pr); const bool eq = (k == Tk[pr]);
                const unsigned long long bal = __ballot(eq);
                const unsigned mine = hi ? (unsigned)(bal >> 32) : (unsigned)bal;
                const int before = __popc(mine & ((1u << r32) - 1u));
                const bool pick = (k > Tk[pr]) || (eq && (seen + before < need));
                const unsigned long long pb = __ballot(pick);
                if (r32 == 0) bm[(2 * j + n) * 4 + 2 * pr + hi] = hi ? (unsigned)(pb >> 32) : (unsigned)pb;
                seen += __popc(mine);
            }
        }
        }
        }
    }
    const int laneA = mk_lane() & 63, r32a = laneA & 31, hia = laneA >> 5, tidA = wid * 64 + laneA;
    const int h_c = r32a & 7, g_c = r32a >> 3;
    bf16x8 qx;
    {
        const float c1 = bf_round(LOG2E), c2 = bf_round(LOG2E - c1), c3 = bf_round((LOG2E - c1) - c2), sc = __builtin_amdgcn_exp2f(-(float)(h_c + 1));
        const unsigned a1 = __float_as_uint(c1 * sc) >> 16, a2 = __float_as_uint(c2 * sc) >> 16, a3 = __float_as_uint(c3 * sc) >> 16, one = 0x3F80u;
        u32x4 w;
        w.x = hia ? ((g_c == 0 ? one : 0u) | ((g_c == 1 ? one : 0u) << 16)) : (a1 | (a2 << 16));
        w.y = hia ? ((g_c == 2 ? one : 0u) | ((g_c == 3 ? one : 0u) << 16)) : (a3 | (a1 << 16));
        w.z = hia ? 0u : (a2 | (a3 << 16)); w.w = 0u;
        qx = __builtin_bit_cast(bf16x8, w);
    }
    unsigned spk[2];
#pragma unroll
    for (int n = 0; n < 2; ++n) { const unsigned s = __float_as_uint((float)(32 * n + r32a)) >> 16; spk[n] = s | (s << 16); }
    const unsigned hmc = 0u - (unsigned)hia; unsigned spkz[2];
#pragma unroll
    for (int n = 0; n < 2; ++n) spkz[n] = (spk[n] & ~hmc) | (0x3F803F80u & hmc);
    const unsigned kww = 0x3F80u & hmc;
    const unsigned nhm = ~hmc, Klo = hmc & 0x0000C680u, Khi = hmc & 0xC6800000u;
    unsigned spkh0[2];
#pragma unroll
    for (int n = 0; n < 2; ++n) spkh0[n] = spk[n] & 0xffff0000u & nhm;
    ALAS float* wsf = (ALAS float*)(lds + LWS) + wid * 64;
    const ALAS u32x4* bmw = (const ALAS u32x4*)((ALAS unsigned*)(lds + LBM) + wid * 256);
    float mhat = 0.f; f32x16 o[2]; o[0] = f32x16{}; o[1] = f32x16{};
    const bool fastok = (T.qk2 < 100.f); bool need = true;
    f32x16 ol = f32x16{};
    const bf16x8 ones8 = __builtin_bit_cast(bf16x8, (u32x4){0x3F803F80u, 0x3F803F80u, 0x3F803F80u, 0x3F803F80u});
#pragma unroll 1
    for (int rep_a = 0; rep_a < REP_ATT; ++rep_a) {
        mhat = 0.f; ol = f32x16{}; o[0] = f32x16{}; o[1] = f32x16{}; need = true;
        kimg_st(lds, 0, tidA, sk); vimg_st(lds, 0, tidA, sv);
        if (NT > 1) { kimg_st(lds, 1, tidA, sk2); vimg_st(lds, 1, tidA, sv2); }
        __syncthreads();
#pragma unroll 1
        for (int jb = 0; jb < NT; jb += 2) {
#pragma unroll
          for (int u = 0; u < 2; ++u) {
            const int jj = jb + u;
            if (u == 0 || jj < NT) {
            const int j = NT - 1 - jj, slot = jj & 3;
            if (u == 0) {
                if (jj + 2 < NT) { kimg_st(lds, (jj + 2) & 3, tidA, skA); vimg_st(lds, (jj + 2) & 3, tidA, svA); }
                if (jj + 3 < NT) { kimg_st(lds, (jj + 3) & 3, tidA, skB); vimg_st(lds, (jj + 3) & 3, tidA, svB); }
                int tl = tidA; asm volatile("" : "+v"(tl));
                if (jj + 4 < NT) { skA = tile_ld(T.K, rowbase + 64 * (j - 4), tl); svA = tile_ld(T.V, rowbase + 64 * (j - 4), tl); }
                if (jj + 5 < NT) { skB = tile_ld(T.K, rowbase + 64 * (j - 5), tl); svB = tile_ld(T.V, rowbase + 64 * (j - 5), tl); }
            }
            const unsigned pp = __float_as_uint((float)(-64 * jj)) >> 16, ppk = pp | (pp << 16);
            const unsigned ppk0 = ppk & nhm, pp0 = pp & nhm;
            bf16x8 kx[2];
#pragma unroll
            for (int n = 0; n < 2; ++n) {
                const u32x4 W = bmw[2 * j + n];
                const unsigned m0 = (unsigned)__builtin_amdgcn_sbfe((int)W.x, (unsigned)r32a, 1u), m1 = (unsigned)__builtin_amdgcn_sbfe((int)W.y, (unsigned)r32a, 1u);
                const unsigned m2 = (unsigned)__builtin_amdgcn_sbfe((int)W.z, (unsigned)r32a, 1u), m3 = (unsigned)__builtin_amdgcn_sbfe((int)W.w, (unsigned)r32a, 1u);
                u32x4 w;
                w.x = (~m1 & Khi) | ((~m0 & Klo) | ppk0); w.y = (~m3 & Khi) | ((~m2 & Klo) | (pp0 | spkh0[n])); w.z = spkz[n]; w.w = kww;
                kx[n] = __builtin_bit_cast(bf16x8, w);
            }
            f32x16 p0 = f32x16{}, p1 = f32x16{};
#pragma unroll
            for (int d0 = 0; d0 < 4; ++d0) {
                const bf16x8 k0 = *(const ALAS bf16x8*)(lds + LK + slot * 8192 + kfrag_off(r32a, hia, d0));
                const bf16x8 k1 = *(const ALAS bf16x8*)(lds + LK + slot * 8192 + kfrag_off(r32a, hia, d0) + 4096);
                p0 = __builtin_amdgcn_mfma_f32_32x32x16_bf16(k0, qr[d0], p0, 0, 0, 0);
                p1 = __builtin_amdgcn_mfma_f32_32x32x16_bf16(k1, qr[d0], p1, 0, 0, 0);
            }
            p0 = __builtin_amdgcn_mfma_f32_32x32x16_bf16(kx[0], qx, p0, 0, 0, 0);
            p1 = __builtin_amdgcn_mfma_f32_32x32x16_bf16(kx[1], qx, p1, 0, 0, 0);
            if (need) {
            const float rm = rowmax(p0, p1);
            const bool first = (jj == 0);
            const float dl = first ? __builtin_fmaxf(rm, -2048.f) : (rm > THR ? rm : 0.f);
            if (first || __any(dl != 0.f)) {
                const float f = first ? 1.f : __builtin_amdgcn_exp2f(-dl);
                mhat += dl;
#pragma unroll
                for (int r = 0; r < 16; ++r) { p0[r] -= dl; p1[r] -= dl; }
                { const unsigned x0 = __float_as_uint(-mhat), t1 = x0 & 0xffff0000u; const float r1 = __uint_as_float(x0) - __uint_as_float(t1); const unsigned t2 = __float_as_uint(r1) & 0xffff0000u;
                  const float r2 = r1 - __uint_as_float(t2); const unsigned t3 = __float_as_uint(r2) & 0xffff0000u;
                  u32x4 w = __builtin_bit_cast(u32x4, qx); w.z = hia ? ((t1 >> 16) | t2) : w.z; w.w = hia ? (t3 >> 16) : w.w; qx = __builtin_bit_cast(bf16x8, w); }
                if (hia == 0) wsf[r32a] = f;
                asm volatile("s_waitcnt lgkmcnt(0)" ::: "memory");
#pragma unroll
                for (int r = 0; r < 16; ++r) { const float fr_ = wsf[crow(r, hia)]; o[0][r] *= fr_; o[1][r] *= fr_; ol[r] *= fr_; }
            }
            need = !fastok || __any(mhat <= -2047.f);
            }
            const lptr vb = lds + LV + slot * VSLOT + ((laneA >> 4) & 1) * 32 + (laneA & 3) * 8 + (4 * hia + ((laneA & 15) >> 2)) * 64;
#pragma unroll
            for (int half = 0; half < 2; ++half) {
                f32x16& ph = half ? p1 : p0;
#pragma unroll
                for (int r = 0; r < 16; ++r) ph[r] = __builtin_amdgcn_exp2f(ph[r]);
                u32x4 pw[2];
#pragma unroll
                for (int q = 0; q < 4; ++q) { pw[0][q] = cvtpk_s(ph[2 * q], ph[2 * q + 1]); pw[1][q] = cvtpk_s(ph[8 + 2 * q], ph[8 + 2 * q + 1]); }
#pragma unroll
                for (int kk = 0; kk < 2; ++kk) {
                    const int ks = 2 * half + kk;
#pragma unroll
                    for (int d0 = 0; d0 < 2; ++d0) {
                        const s16x4 lo = vtr(vb + d0 * VDH + ks * 1024), hh = vtr(vb + d0 * VDH + ks * 1024 + 512);
                        const bf16x8 vf = (bf16x8){lo[0], lo[1], lo[2], lo[3], hh[0], hh[1], hh[2], hh[3]};
                        o[d0] = __builtin_amdgcn_mfma_f32_32x32x16_bf16(__builtin_bit_cast(bf16x8, pw[kk]), vf, o[d0], 0, 0, 0);
                    }
                    ol = __builtin_amdgcn_mfma_f32_32x32x16_bf16(__builtin_bit_cast(bf16x8, pw[kk]), ones8, ol, 0, 0, 0);
                }
                if (half == 0) __builtin_amdgcn_sched_barrier(0);
            }
            if (u == 1) __syncthreads();
            }
          }
        }
        __syncthreads();
    }
    unit_prefetch(pf, has_next ? nb : b, has_next ? nqb : qb, T, wave_s, lds, has_next);
    ALAS unsigned char* stg = lds + LOST + wid * 4096;
#pragma unroll
    for (int r = 0; r < 16; ++r) {
        const int orow = crow(r, hia); const float rl = __builtin_amdgcn_rcpf(ol[r]);
#pragma unroll
        for (int d0 = 0; d0 < 2; ++d0) { const float ov = o[d0][r] * rl; stg[orow * 64 + d0 * 32 + r32a] = (unsigned char)(__builtin_amdgcn_cvt_pk_fp8_f32(ov, ov, 0u, false) & 0xffu); }
    }
    asm volatile("s_waitcnt lgkmcnt(0)" ::: "memory");
    int laneE = laneA; asm volatile("" : "+v"(laneE));
#pragma unroll
    for (int i = 0; i < 2; ++i) {
        const int row = i * 16 + (laneE >> 2), ch = laneE & 3;
        const u32x4 v = *(const ALAS u32x4*)(stg + row * 64 + ch * 16);
        *(u32x4*)(T.AP + (rowbase + t0 + 4 * wid + (row >> 3)) * 1024 + (row & 7) * 64 + ch * 16) = v;
    }
    __syncthreads();
}
#undef KEY
#undef MX3
}

constexpr int NWAVES = 8;
constexpr int D = 1024, NB = 16, SEQ = 2048, TOK = NB * SEQ, FF = 2816, DIN = 3784, N1 = 3840, N5 = 5632;
constexpr int OQ = 0, OKK = 512, OV = 576, OQI = 640, OKI = 1152, OWI = 1216, OU = 1224, OG = 1736;
constexpr float EPS = 1e-6f;
constexpr size_t MiB = 1u << 20;
constexpr size_t WS_CTL = 0, CTL_ZERO_BYTES = 64 * 1024;
constexpr size_t WS_W1T = 2 * MiB, WS_W3T = 10 * MiB, WS_W4T = 12 * MiB, WS_W5T = 14 * MiB, WS_W6T = 26 * MiB, WS_WP = 32 * MiB;
constexpr size_t WS_RSTD = 34 * MiB, WS_WI = 35 * MiB, WS_SSQ = 36 * MiB, WS_K = 38 * MiB, WS_V = 42 * MiB, WS_KI = 46 * MiB;
constexpr size_t WS_R = 52 * MiB, WS_SP = 116 * MiB, WS_AP = 180 * MiB, WS_XB = 244 * MiB, WS_Q = 308 * MiB, WS_QI = 340 * MiB, WS_U = 372 * MiB, WS_H2 = 436 * MiB, WS_END = 500 * MiB;
constexpr size_t WS_MG = WS_U;
constexpr size_t WS_ACT = WS_R;
constexpr size_t WS_XF8 = WS_AP;
constexpr size_t WS_W1T8 = WS_W1T + 4 * MiB;
constexpr size_t WS_H2F8 = WS_AP;
static_assert(WS_ACT + (size_t)TOK * 4096 <= WS_AP, "act overlay");
constexpr int CW_BAR = 1024;
constexpr int RING_BYTES = 131072, LDSCTL_OFF = RING_BYTES, MISC_OFF = LDSCTL_OFF + 320, LDS_BYTES = 147456;
static_assert(att::LBYTES <= RING_BYTES, "attention scratch inside the ring region");

#define LAS __attribute__((address_space(3)))
#define GAS __attribute__((address_space(1)))
typedef unsigned short bf16;
typedef unsigned v4u __attribute__((ext_vector_type(4)));
typedef float f32x4 __attribute__((ext_vector_type(4)));
#define LDS_WAIT() asm volatile("s_waitcnt lgkmcnt(0)" ::: "memory")
__device__ __forceinline__ unsigned pk2(float lo, float hi) { return pg8::cvt_pk_bf16(lo, hi); }
__device__ __forceinline__ float wave_sum(float v) {
#pragma unroll
    for (int o = 1; o < 64; o <<= 1) v += __shfl_xor(v, o);
    return v;
}

#define XB_TMO      128
#define XB_XCNT(j)  (256  + 64 * (j))
#define XB_XSUB(j)  (1280 + 64 * (j))
#define XB_XGEN(j)  (2304 + 64 * (j))
#define XB_TOP      3328
#define XB_TOPGEN   3392
#define XCD_BAR_WORDS 3456
#define XB_GM(g)    (3520 + 64 * (g))
#define XB_SPIN_CAP (1u << 18)

__device__ __forceinline__ unsigned xb_ld(unsigned* p)              { return __hip_atomic_load(p, __ATOMIC_RELAXED, __HIP_MEMORY_SCOPE_AGENT); }
__device__ __forceinline__ unsigned xb_add(unsigned* p, unsigned v) { return __hip_atomic_fetch_add(p, v, __ATOMIC_RELAXED, __HIP_MEMORY_SCOPE_AGENT); }
__device__ __forceinline__ unsigned xb_xcc_id() { return (unsigned)__builtin_amdgcn_s_getreg((3 << 11) | 20) & 0xFu; }
#define XB_SPIN(cond, bar) do { unsigned _sp = 0; while (cond) { __builtin_amdgcn_s_sleep(1); \
    if ((++_sp & 255u) == 0u) { if (xb_ld(&(bar)[XB_TMO])) break; if (_sp > XB_SPIN_CAP) { atomicAdd(&(bar)[XB_TMO], 1u); break; } } } } while (0)

struct XcdBarrier {
    unsigned* bar; unsigned x;
    int lead;
    volatile LAS unsigned* st;
};

__device__ __forceinline__ XcdBarrier xcd_barrier_post(unsigned* bar, volatile LAS unsigned* st, const int wave_s) {
    XcdBarrier b; b.bar = bar; b.x = xb_xcc_id(); b.st = st; b.lead = (wave_s == 0) ? 1 : 0;
    if (b.lead && mk_lane() == 0) { (void)__hip_atomic_fetch_or(&bar[XB_GM(blockIdx.x & 7u)], 1u << b.x, __ATOMIC_RELAXED, __HIP_MEMORY_SCOPE_AGENT); (void)xb_add(&bar[XB_XCNT(b.x)], 1u); }
    return b;
}
__device__ __forceinline__ void xcd_barrier_complete(unsigned* bar, unsigned x, unsigned& nloc, unsigned& nx) {
    const unsigned G = gridDim.x * gridDim.y * gridDim.z;
    unsigned sum, cnt, mine, sp = 0u;
    for (;;) {
        sum = 0u; cnt = 0u; mine = 0u;
#pragma unroll
        for (unsigned j = 0; j < 16; ++j) { const unsigned c = xb_ld(&bar[XB_XCNT(j)]); sum += c; cnt += (c > 0u) ? 1u : 0u; mine = (j == x) ? c : mine; }
        if (sum == G) break;
        __builtin_amdgcn_s_sleep(1);
        if ((++sp & 255u) == 0u) { if (xb_ld(&bar[XB_TMO])) break; if (sp > XB_SPIN_CAP) { atomicAdd(&bar[XB_TMO], 1u); break; } }
    }
    nloc = mine > 0u ? mine : 1u; nx = cnt > 0u ? cnt : 1u;
}

__device__ __forceinline__ void xcd_barrier(const XcdBarrier& b, const bool want_local) {
    asm volatile("s_waitcnt vmcnt(0)" ::: "memory");
    __syncthreads();
    if (b.lead && mk_lane() == 0) {
        unsigned* bar = b.bar;
        __builtin_amdgcn_s_waitcnt(0);
        unsigned nloc = b.st[0], nx = b.st[1];
        if (nloc == 0u) { xcd_barrier_complete(bar, b.x, nloc, nx); b.st[0] = nloc; b.st[1] = nx; }
        const unsigned old = xb_add(&bar[XB_XSUB(b.x)], 1u);
        const unsigned gen = old / nloc;
        const bool local = want_local && (b.st[2] == 1u);
        if (old + 1u == (gen + 1u) * nloc && local) {
            __builtin_amdgcn_fence(__ATOMIC_ACQUIRE, "agent");
            xb_add(&bar[XB_XGEN(b.x)], 1u);
            asm volatile("s_waitcnt vmcnt(0)" ::: "memory");
        } else if (old + 1u == (gen + 1u) * nloc) {
            __builtin_amdgcn_fence(__ATOMIC_RELEASE, "agent");
            asm volatile("s_waitcnt vmcnt(0)" ::: "memory");
            const unsigned og = xb_add(&bar[XB_TOP], 1u);
            const unsigned tg = og / nx;
            if (og + 1u == (tg + 1u) * nx) xb_add(&bar[XB_TOPGEN], 1u);
            else XB_SPIN(xb_ld(&bar[XB_TOPGEN]) == tg, bar);
            __builtin_amdgcn_fence(__ATOMIC_ACQUIRE, "agent");
            xb_add(&bar[XB_XGEN(b.x)], 1u);
            asm volatile("s_waitcnt vmcnt(0)" ::: "memory");
        } else {
            XB_SPIN(xb_ld(&bar[XB_XGEN(b.x)]) == gen, bar);
            __builtin_amdgcn_fence(__ATOMIC_ACQUIRE, "agent");
            asm volatile("s_waitcnt vmcnt(0)" ::: "memory");
        }
        if (b.st[2] == 0u) {
            unsigned all = 0u; bool ok = (gridDim.x == 256u);
#pragma unroll
            for (unsigned g = 0; g < 8; ++g) { const unsigned m = xb_ld(&bar[XB_GM(g)]); ok = ok && (m != 0u) && ((m & (m - 1u)) == 0u) && ((all & m) == 0u); all |= m; }
            b.st[2] = ok ? 1u : 2u;
        }
    }
    __syncthreads();
}

struct Args { const float* in[14]; float* out; unsigned char* ws; int ph_lo, ph_hi; };

template <int FMT>
__device__ __forceinline__ void tr_item(const float* W, int ldw, int k0, int c0, int nvalid, const float* gain, float scale, void* WTv, int ldt, int drow0, int dk0, LAS float* scr, int lane) {
    const int j = lane & 31;
    float tv[32];
#pragma unroll
    for (int i = 0; i < 32; ++i) { const int kk = 2 * i + (lane >> 5); tv[i] = (j < nvalid) ? W[(size_t)(k0 + kk) * ldw + c0 + j] : 0.f; }
#pragma unroll
    for (int i = 0; i < 32; ++i) { const int kk = 2 * i + (lane >> 5); float v = tv[i] * scale; if (gain) v *= gain[k0 + kk]; scr[kk * 33 + j] = v; }
    LDS_WAIT(); asm volatile("" ::: "memory");
    if (FMT == 2) {
        unsigned char* WT = (unsigned char*)WTv; const int c = lane & 3;
#pragma unroll
        for (int jj = 0; jj < 2; ++jj) { const int n = (lane >> 2) + 16 * jj; const LAS float* s = scr + (16 * c) * 33 + n;
            v4u o; o.x = pg8::pk4_fp8(s[0 * 33], s[1 * 33], s[2 * 33], s[3 * 33]); o.y = pg8::pk4_fp8(s[4 * 33], s[5 * 33], s[6 * 33], s[7 * 33]);
            o.z = pg8::pk4_fp8(s[8 * 33], s[9 * 33], s[10 * 33], s[11 * 33]); o.w = pg8::pk4_fp8(s[12 * 33], s[13 * 33], s[14 * 33], s[15 * 33]);
            *(v4u*)(WT + (size_t)(drow0 + n) * ldt + dk0 + k0 + 16 * c) = o; }
    } else {
        bf16* WT = (bf16*)WTv; const int c = lane & 7;
#pragma unroll
        for (int jj = 0; jj < 4; ++jj) { const int n = (lane >> 3) + 8 * jj; const LAS float* s = scr + (8 * c) * 33 + n;
            v4u o;
            if (FMT == 1) { o.x = pg8::cvt_pk_f16(s[0 * 33], s[1 * 33]); o.y = pg8::cvt_pk_f16(s[2 * 33], s[3 * 33]); o.z = pg8::cvt_pk_f16(s[4 * 33], s[5 * 33]); o.w = pg8::cvt_pk_f16(s[6 * 33], s[7 * 33]); }
            else { o.x = pk2(s[0 * 33], s[1 * 33]); o.y = pk2(s[2 * 33], s[3 * 33]); o.z = pk2(s[4 * 33], s[5 * 33]); o.w = pk2(s[6 * 33], s[7 * 33]); }
            *(v4u*)(WT + (size_t)(drow0 + n) * ldt + dk0 + k0 + 8 * c) = o; }
    }
    LDS_WAIT(); asm volatile("" ::: "memory");
}
__device__ __forceinline__ void w1_map(int rg, int& c0, int& nvalid) {
    const int n0 = rg * 32, pn = n0 >> 8, c = n0 & 255, bj = c >> 7, wc = (c & 127) >> 5; nvalid = 32;
    if (pn < 2) c0 = OQ + (pn * 4 + wc) * 64 + 32 * bj;
    else if (pn == 2) { if (wc == 0) c0 = OKK + 32 * bj; else if (wc == 1) c0 = OV + 32 * bj; else if (wc == 2) c0 = OKI + 32 * bj; else { c0 = OWI; nvalid = bj == 0 ? 8 : 0; } }
    else if (pn < 5) c0 = OQI + ((pn - 3) * 4 + wc) * 64 + 32 * bj;
    else if (pn < 7) c0 = OU + (pn - 5) * 256 + c;
    else c0 = OG + bj * 1024 + (pn - 7) * 128 + (c & 127);
}

__device__ __forceinline__ unsigned unit_tab(int s) {
    unsigned r = 0x0c132c2fu;
    r = (s == 1) ? 0x031d293au : r;
    r = (s == 2) ? 0x0e1c2628u : r;
    r = (s == 3) ? 0x12212224u : r;
    r = (s == 4) ? 0x090d2e36u : r;
    r = (s == 5) ? 0x041e2b35u : r;
    r = (s == 6) ? 0x0b10253bu : r;
    r = (s == 7) ? 0x14161f30u : r;
    r = (s == 8) ? 0x07202338u : r;
    r = (s == 9) ? 0x02173139u : r;
    r = (s == 10) ? 0x08191b3eu : r;
    r = (s == 11) ? 0x0111333fu : r;
    r = (s == 12) ? 0x00183237u : r;
    r = (s == 13) ? 0x060a343du : r;
    r = (s == 14) ? 0x0f1a272au : r;
    r = (s == 15) ? 0x05152d3cu : r;
    return r;
}

template <int W>
__device__ __forceinline__ void pool_win(const bf16* Ub, unsigned char* AP, int tb, int tin, int c0) {
    v4u rows[W + 15];
#pragma unroll
    for (int r = 0; r < W + 15; ++r) { const int rel = r - (W - 1); rows[r] = (tin + rel >= 0) ? *(const v4u*)(Ub + (size_t)(tb + rel) * 512 + c0) : (v4u){0u, 0u, 0u, 0u}; }
    float sum[8];
#pragma unroll
    for (int e = 0; e < 8; ++e) sum[e] = 0.f;
#pragma unroll
    for (int r = 0; r < W - 1; ++r) { f32x4 a, b_; pg8::unpack8(rows[r], a, b_);
#pragma unroll
        for (int e = 0; e < 4; ++e) { sum[e] += a[e]; sum[4 + e] += b_[e]; } }
#pragma unroll
    for (int tt = 0; tt < 16; ++tt) {
        const int t = tin + tt; f32x4 a, b_; pg8::unpack8(rows[W - 1 + tt], a, b_);
#pragma unroll
        for (int e = 0; e < 4; ++e) { sum[e] += a[e]; sum[4 + e] += b_[e]; }
        if (tt > 0) { f32x4 a2, b2; pg8::unpack8(rows[tt - 1], a2, b2);
#pragma unroll
            for (int e = 0; e < 4; ++e) { sum[e] -= a2[e]; sum[4 + e] -= b2[e]; } }
        const float inv = 1.0f / (float)((t + 1 < W) ? t + 1 : W);
        f32x4 d0, d1;
#pragma unroll
        for (int e = 0; e < 4; ++e) { d0[e] = sum[e] * inv - a[e]; d1[e] = sum[4 + e] * inv - b_[e]; }
        *(unsigned long long*)(AP + (size_t)(tb + tt) * 1024 + 512 + c0) = pg8::pack8_fp8(d0, d1);
    }
}

__global__ void __launch_bounds__(NWAVES * 64, 2) mk_fwd(Args args) {
    extern __shared__ __attribute__((aligned(16))) unsigned char lds_raw[];
    LAS unsigned char* lds = (LAS unsigned char*)lds_raw;
    volatile LAS unsigned* MISC = (volatile LAS unsigned*)(lds + MISC_OFF);
    const int wave = __builtin_amdgcn_readfirstlane(threadIdx.x >> 6);
    const int G = gridDim.x; const int bx = blockIdx.x; const int vcu = (G % 8 == 0) ? (bx % 8) * (G / 8) + bx / 8 : bx;
    unsigned char* ws = args.ws;
    for (int u = wave * 64 + mk_lane(); u < (LDS_BYTES - LDSCTL_OFF) / 4; u += NWAVES * 64) ((LAS unsigned*)(lds + LDSCTL_OFF))[u] = 0u;
    __syncthreads();
    XcdBarrier bar; bar.bar = (unsigned*)(ws + WS_CTL) + CW_BAR; bar.x = 0; bar.st = nullptr; bar.lead = 0;
    if (!MK_PER_PHASE) bar = xcd_barrier_post((unsigned*)(ws + WS_CTL) + CW_BAR, MISC + 8, wave);
#define GRID_BAR() do { if (!MK_PER_PHASE) xcd_barrier(bar, false); } while (0)
#define GRID_BAR_L() do { if (!MK_PER_PHASE) xcd_barrier(bar, true); } while (0)
    const int lo = args.ph_lo, hi_ = args.ph_hi;
#define IN(k) (lo <= (k) && (k) < hi_)
#define BOTH(k) (IN(k) && IN((k) + 1))
    const int gw = vcu * NWAVES + wave, NGW = G * NWAVES;

    if (IN(0)) {
        const float* x = args.in[0]; const float* norm_mix = args.in[1]; const float* w_in = args.in[2]; const float* w_pg = args.in[5]; const float* pool_scale = args.in[6];
        const float* w_ba = args.in[7]; const float* w_bp = args.in[8]; const float* w_out = args.in[9]; const float* norm_ffn = args.in[10]; const float* w_g = args.in[11]; const float* w_u = args.in[12]; const float* w_d = args.in[13];
        bf16* W1T = (bf16*)(ws + WS_W1T); unsigned char* W3T = ws + WS_W3T; unsigned char* W4T = ws + WS_W4T; unsigned char* W5T = ws + WS_W5T; unsigned char* W6T = ws + WS_W6T;
        float* RSTD = (float*)(ws + WS_RSTD); bf16* XB = (bf16*)(ws + WS_XB); unsigned char* W1T8 = ws + WS_W1T8; unsigned char* XF8 = ws + WS_XF8;
        const int lane = mk_lane();
        LAS float* scr = (LAS float*)(lds + wave * 16384);
        constexpr int I1 = (N1 / 32) * (D / 64), I3 = (D / 32) * (512 / 64), I4 = (D / 32) * (D / 64), I5 = (N5 / 32) * (D / 64), I6 = (D / 32) * (FF / 64);
        constexpr int NITEMS = I1 + I3 + I4 + I5 + I6;
        for (int it = gw; it < NITEMS; it += NGW) {
            int r = it;
            if (r < I1) { const int rg = r / (D / 64), kb = r % (D / 64); int c0, nv; w1_map(rg, c0, nv); if (rg < 40) tr_item<1>(w_in, DIN, 64 * kb, c0, nv, norm_mix, 1.0f, W1T, D, rg * 32, 0, scr, lane); else tr_item<2>(w_in, DIN, 64 * kb, c0, nv, norm_mix, pg8::K_WSC, W1T8, D, rg * 32 - 1280, 0, scr, lane); continue; } r -= I1;
            if (r < I3) { const int rg = r / 8, kb = r % 8; tr_item<2>(w_ba, D, 64 * kb, rg * 32, 32, nullptr, pg8::K_WSC, W3T, D, rg * 32, 0, scr, lane); continue; } r -= I3;
            if (r < I4) { const int rg = r / 16, kb = r % 16; tr_item<2>(w_out, D, 64 * kb, rg * 32, 32, nullptr, pg8::K_WSC, W4T, D, rg * 32, 0, scr, lane); continue; } r -= I4;
            if (r < I5) { const int rg = r / 16, kb = r % 16; const int n0 = rg * 32, pn = n0 >> 8, c = n0 & 255; const float* src = (c >> 7) ? w_u : w_g;
                          tr_item<MK_FP8 ? 2 : 0>(src, FF, 64 * kb, pn * 128 + (c & 127), 32, norm_ffn, MK_FP8 ? pg8::K_WSC : 1.0f, W5T, D, rg * 32, 0, scr, lane); continue; } r -= I5;
            { const int rg = r / (FF / 64), kb = r % (FF / 64); tr_item<MK_FP8 ? 2 : 0>(w_d, D, 64 * kb, rg * 32, 32, nullptr, MK_FP8 ? pg8::K_WSC : 1.0f, W6T, FF, rg * 32, 0, scr, lane); }
        }
        for (int it = gw; it < 32 * 64; it += NGW) {
            const int i0 = (it >> 6) * 16, n0 = (it & 63) * 16, g = i0 >> 7, nl = lane & 15, q = lane >> 4;
#pragma unroll
            for (int k = 0; k < 8; ++k) { const int e = 4 * (lane + 64 * k), r = e >> 7, j = e & 127;
                const f32x4 a = *(const f32x4*)(w_pg + (size_t)i0 * 128 + e), c = *(const f32x4*)(pool_scale + g * 128 + j);
#pragma unroll
                for (int t = 0; t < 4; ++t) scr[(j + t) * 16 + r] = a[t] * c[t]; }
            float s0 = 0.f, s1 = 0.f, s2 = 0.f, s3 = 0.f;
            const float* bcol = w_bp + (size_t)(g * 128) * D + n0 + nl;
#pragma unroll
            for (int hb = 0; hb < 2; ++hb) {
                float bv[64];
#pragma unroll
                for (int j = 0; j < 64; ++j) bv[j] = bcol[(size_t)(hb * 64 + j) * D];
                LDS_WAIT(); asm volatile("" ::: "memory");
#pragma unroll
                for (int j = 0; j < 64; ++j) { const f32x4 a = *(const LAS f32x4*)(scr + (hb * 64 + j) * 16 + 4 * q);
                    s0 = __builtin_fmaf(a[0], bv[j], s0); s1 = __builtin_fmaf(a[1], bv[j], s1); s2 = __builtin_fmaf(a[2], bv[j], s2); s3 = __builtin_fmaf(a[3], bv[j], s3); }
            }
            LAS unsigned* ob = (LAS unsigned*)(scr + 2048);
            ob[nl * 4 + q] = pg8::pk4_fp8(s0 * pg8::K_WSC, s1 * pg8::K_WSC, s2 * pg8::K_WSC, s3 * pg8::K_WSC);
            LDS_WAIT(); asm volatile("" ::: "memory");
            if (lane < 16) *(v4u*)(W3T + (size_t)(n0 + lane) * D + 512 + i0) = *(const LAS v4u*)(ob + lane * 4);
            LDS_WAIT(); asm volatile("" ::: "memory");
        }
        if (BOTH(0)) GRID_BAR();
        const int xm_first = (G == 256) ? ((vcu >> 5) * 4096 + 4 * ((vcu & 31) * 8 + wave)) : gw * 4, xm_step = (G == 256) ? 1024 : NGW * 4, xm_end = (G == 256) ? ((vcu >> 5) * 4096 + 4096) : TOK;
        for (int m0 = xm_first; m0 < xm_end; m0 += xm_step) {
            const int m = m0 + (lane >> 4), sub = lane & 15;
            const f32x4* xr = (const f32x4*)(x + (size_t)m * D) + sub; f32x4 v[16]; float s = 0.f;
#pragma unroll
            for (int j = 0; j < 16; ++j) v[j] = xr[16 * j];
#pragma unroll
            for (int j = 0; j < 16; ++j) s += (v[j].x * v[j].x + v[j].y * v[j].y) + (v[j].z * v[j].z + v[j].w * v[j].w);
            s += __shfl_xor(s, 1); s += __shfl_xor(s, 2); s += __shfl_xor(s, 4); s += __shfl_xor(s, 8);
            if (sub == 0) RSTD[m] = 1.0f / sqrtf(s * (1.0f / D) + EPS);
            unsigned long long* o8 = (unsigned long long*)(XB + (size_t)m * D) + sub;
#pragma unroll
            for (int j = 0; j < 16; ++j) o8[16 * j] = (unsigned long long)pg8::cvt_pk_f16(v[j].x, v[j].y) | ((unsigned long long)pg8::cvt_pk_f16(v[j].z, v[j].w) << 32);
            unsigned* o4 = (unsigned*)(XF8 + (size_t)m * D) + sub;
#pragma unroll
            for (int j = 0; j < 16; ++j) o4[16 * j] = pg8::pk4_fp8(v[j].x, v[j].y, v[j].z, v[j].w);
        }
        if (BOTH(0)) GRID_BAR_L();
    }
    if (IN(1)) {
        const float* q_norm = args.in[3]; const float* k_norm = args.in[4];
        bf16* W1T = (bf16*)(ws + WS_W1T); float* RSTD = (float*)(ws + WS_RSTD); float* WIb = (float*)(ws + WS_WI); bf16* XB = (bf16*)(ws + WS_XB);
        bf16* Kb = (bf16*)(ws + WS_K); bf16* Vb = (bf16*)(ws + WS_V); bf16* KIb = (bf16*)(ws + WS_KI); bf16* Rb = (bf16*)(ws + WS_R); bf16* SPb = (bf16*)(ws + WS_R) + 1024;
        bf16* Qb = (bf16*)(ws + WS_Q); bf16* QIb = (bf16*)(ws + WS_QI); bf16* Ub = (bf16*)(ws + WS_U);
        { pg8::Gemm g{XB, W1T, TOK, 1280, D}; pg8::ListOrder S; S.init(TOK, 1280, G, bx); S.mode = 0;
          pg8::Epi1 E{RSTD, q_norm, k_norm, Qb, Kb, Vb, QIb, KIb, Ub, Rb, SPb, WIb, 0, 1.0f};
          pg8::gemm_phase<pg8::Epi1, pg8::ListOrder, true, true, 1>(lds, g, S, E, wave); }
        { unsigned char* W1T8 = ws + WS_W1T8; unsigned char* XF8 = ws + WS_XF8;
          pg8::Gemm g{(const bf16*)XF8, (const bf16*)W1T8, TOK, 2560, D}; pg8::ListOrder S; S.init(TOK, 2560, G, bx); S.mode = 1;
          pg8::Epi1 E{RSTD, q_norm, k_norm, Qb, Kb, Vb, QIb, KIb, Ub, Rb, SPb, WIb, 5, pg8::K_WSCI};
          pg8::gemm_phase<pg8::Epi1, pg8::ListOrder, true, true, 2>(lds, g, S, E, wave); }
        if (BOTH(1)) GRID_BAR_L();
    }
    if (IN(2)) {
        float* WIb = (float*)(ws + WS_WI);
        bf16* Kb = (bf16*)(ws + WS_K); bf16* Vb = (bf16*)(ws + WS_V); bf16* KIb = (bf16*)(ws + WS_KI); unsigned char* AP = ws + WS_AP;
        bf16* Qb = (bf16*)(ws + WS_Q); bf16* QIb = (bf16*)(ws + WS_QI); bf16* Ub = (bf16*)(ws + WS_U);
        const int ptask0 = (G == 256) ? (((vcu >> 4) * 32 + (((vcu & 15) * 8 + wave) >> 2)) * 4 + (wave & 3)) : gw, ptstep = (G == 256) ? TOK : NGW;
        for (int task = ptask0; task < TOK / 16; task += ptstep) {
            const int ln = mk_lane(); const int g = task & 3, tb = (task >> 2) * 64 + (ln >> 4) * 16, tin = tb & (SEQ - 1), c0 = g * 128 + (ln & 15) * 8;
            if (g == 0) pool_win<2>(Ub, AP, tb, tin, c0); else if (g == 1) pool_win<4>(Ub, AP, tb, tin, c0); else if (g == 2) pool_win<8>(Ub, AP, tb, tin, c0); else pool_win<16>(Ub, AP, tb, tin, c0);
        }
        __syncthreads();
        float qk2_;
        { const float* q_norm = args.in[3]; const float* k_norm = args.in[4]; const int lq = mk_lane() & 63; float gq = __builtin_fabsf(q_norm[lq]), gk = __builtin_fabsf(k_norm[lq]);
#pragma unroll
          for (int o_ = 1; o_ < 64; o_ <<= 1) { gq = __builtin_fmaxf(gq, __shfl_xor(gq, o_)); gk = __builtin_fmaxf(gk, __shfl_xor(gk, o_)); }
          qk2_ = __builtin_bit_cast(float, __builtin_amdgcn_readfirstlane(__builtin_bit_cast(int, 2.0f * 11.6f * gq * gk))); }
        const att::Tensors AT{Qb, Kb, Vb, QIb, KIb, WIb, AP, qk2_};
        const int nun = (G == 256) ? 4 : (NB * 64 - vcu + G - 1) / G;
#define UNIT_OF(i, b_, q_) do { if (G == 256) { const int s_ = vcu & 15; b_ = vcu >> 4; q_ = (int)((unit_tab(s_) >> (8 * (i))) & 0xffu); } \
                                else { const int un_ = vcu + (i) * G; b_ = un_ >> 6; q_ = un_ & 63; } } while (0)
        att::UnitPF pf;
        if (nun > 0) { int b0, q0; UNIT_OF(0, b0, q0); att::unit_prefetch(pf, b0, q0, AT, wave, lds, true); }
#pragma unroll 1
        for (int i = 0; i < nun; ++i) {
            int b, qb, nb = 0, nqb = 0; UNIT_OF(i, b, qb);
            const bool has_next = (i + 1 < nun); if (has_next) UNIT_OF(i + 1, nb, nqb);
            att::attn_unit(b, qb, AT, lds, pf, has_next, nb, nqb, wave);
        }
#undef UNIT_OF
        if (BOTH(2)) GRID_BAR_L();
    }
    if (IN(3)) {
        unsigned char* W3T = ws + WS_W3T; bf16* Rb = (bf16*)(ws + WS_R); bf16* SPb = (bf16*)(ws + WS_R) + 1024; unsigned char* AP = ws + WS_AP; unsigned char* MG = ws + WS_MG;
        pg8::Gemm g{(const bf16*)AP, (const bf16*)W3T, TOK, D, D}; pg8::StaticOrder S; S.init(TOK, D, G, bx);
        pg8::Epi3 E{Rb, SPb, MG};
        pg8::gemm_phase<pg8::Epi3, pg8::StaticOrder, true, true, 2>(lds, g, S, E, wave);
        if (BOTH(3)) GRID_BAR_L();
    }
    if (IN(4)) {
        bf16* XB = (bf16*)(ws + WS_XB); unsigned char* W4T = ws + WS_W4T; unsigned char* MG = ws + WS_MG; bf16* H2 = (bf16*)(ws + WS_H2); unsigned char* H2F8 = ws + WS_H2F8; float* SSQ = (float*)(ws + WS_SSQ);
        pg8::Gemm g{(const bf16*)MG, (const bf16*)W4T, TOK, D, D}; pg8::StaticOrder S; S.init(TOK, D, G, bx);
        pg8::Epi4 E{XB, H2, H2F8, SSQ};
        pg8::gemm_phase<pg8::Epi4, pg8::StaticOrder, true, true, 2>(lds, g, S, E, wave);
        if (BOTH(4)) GRID_BAR_L();
    }
    if (IN(5)) {
        unsigned char* W5T = ws + WS_W5T; unsigned char* H2F8 = ws + WS_H2F8; float* SSQ = (float*)(ws + WS_SSQ); unsigned char* ACT = ws + WS_ACT;
        bf16* H2 = (bf16*)(ws + WS_H2);
        pg8::Gemm g{MK_FP8 ? (const bf16*)H2F8 : (const bf16*)H2, (const bf16*)W5T, TOK, N5, D}; pg8::StaticOrder S; S.init(TOK, N5, G, bx);
        pg8::Epi5 E{SSQ, ACT};
        pg8::gemm_phase<pg8::Epi5, pg8::StaticOrder, true, true, MK_FP8 ? 2 : 0>(lds, g, S, E, wave);
        if (BOTH(5)) GRID_BAR_L();
    }
    if (IN(6)) {
        float* out = args.out; unsigned char* W6T = ws + WS_W6T; unsigned char* ACT = ws + WS_ACT; bf16* H2 = (bf16*)(ws + WS_H2);
        pg8::Gemm g{(const bf16*)ACT, (const bf16*)W6T, TOK, D, FF, 4096}; pg8::StaticOrder S; S.init(TOK, D, G, bx);
        pg8::Epi6 E{H2, out};
        pg8::gemm_phase<pg8::Epi6, pg8::StaticOrder, true, true, MK_FP8 ? 2 : 0>(lds, g, S, E, wave);
    }
#undef IN
#undef BOTH
#undef GRID_BAR
#undef GRID_BAR_L
}

extern "C" void kernel_launch(void* const* d_in, const int* in_sizes, int n_in, void* d_out, int out_size, void* d_ws, size_t ws_size, hipStream_t stream) {
    static int grid = 0;
    if (grid == 0) {
        if (n_in != 14 || in_sizes[0] != TOK * D || out_size != TOK * D || ws_size < WS_END) { fprintf(stderr, "kernel_launch: unexpected shapes (n_in %d, in0 %d, out %d, ws %zu)\n", n_in, n_in > 0 ? in_sizes[0] : -1, out_size, ws_size); grid = -1; return; }
        int dev = 0, cus = 0, per_cu = 0;
        if (hipGetDevice(&dev) != hipSuccess || hipDeviceGetAttribute(&cus, hipDeviceAttributeMultiprocessorCount, dev) != hipSuccess) { grid = -1; return; }
        if (hipFuncSetAttribute((const void*)mk_fwd, hipFuncAttributeMaxDynamicSharedMemorySize, LDS_BYTES) != hipSuccess) { fprintf(stderr, "kernel_launch: hipFuncSetAttribute failed\n"); grid = -1; return; }
        if (hipOccupancyMaxActiveBlocksPerMultiprocessor(&per_cu, (const void*)mk_fwd, NWAVES * 64, LDS_BYTES) != hipSuccess || per_cu < 1) fprintf(stderr, "kernel_launch: occupancy query says %d\n", per_cu);
        (void)hipGetLastError();
        grid = cus;
    }
    if (grid < 0) return;
    (void)hipMemsetAsync((char*)d_ws + WS_CTL, 0, CTL_ZERO_BYTES, stream);
    Args a{};
    for (int i = 0; i < 14; ++i) a.in[i] = (const float*)d_in[i];
    a.out = (float*)d_out; a.ws = (unsigned char*)d_ws;
#if MK_PER_PHASE
    for (int p = 0; p < 7; ++p) { a.ph_lo = p; a.ph_hi = p + 1; hipLaunchKernelGGL(mk_fwd, dim3(grid), dim3(NWAVES * 64), LDS_BYTES, stream, a);
#ifdef MK_REPEAT
        if (p == MK_REPEAT) hipLaunchKernelGGL(mk_fwd, dim3(grid), dim3(NWAVES * 64), LDS_BYTES, stream, a);
#endif
    }
#else
    a.ph_lo = 0; a.ph_hi = 7; hipLaunchKernelGGL(mk_fwd, dim3(grid), dim3(NWAVES * 64), LDS_BYTES, stream, a);
#endif
}
```

```cpp
#include <hip/hip_runtime.h>
#include <cstdio>
#include <cstdint>

#ifndef MK_PER_PHASE
#define MK_PER_PHASE 0
#endif
#ifndef MK_FP8
#define MK_FP8 1
#endif

__device__ __forceinline__ int mk_lane() { int l; asm volatile("v_mbcnt_lo_u32_b32 %0, -1, 0\n\tv_mbcnt_hi_u32_b32 %0, -1, %0" : "=v"(l)); return l; }
namespace pg8 {
#define PG8_LAS __attribute__((address_space(3)))
typedef unsigned short bf16_t;
typedef short bf16x8 __attribute__((ext_vector_type(8)));
typedef float f32x4 __attribute__((ext_vector_type(4)));
typedef unsigned u32x4 __attribute__((ext_vector_type(4)));
constexpr int BM = 256, BK = 64, HALF = 128, HTB = HALF * BK * 2  , STAGE_BYTES = 8 * HTB, NXCD = 8, WGM = 8;

__host__ __device__ __forceinline__ int lds_byte(int r, int c) { const int st = (r >> 4) * 2 + (c >> 5), rr = r & 15, cc = c & 31, ob = rr * 64 + cc * 2; return st * 1024 + (ob ^ (((ob >> 9) & 1) << 5)); }
__host__ __device__ __forceinline__ void stage_rc(int b, int& R, int& C) { const int st = b / 1024, sb = b % 1024, swz = sb ^ (((sb >> 9) & 1) << 5); R = (st >> 1) * 16 + swz / 64; C = (st & 1) * 32 + (swz % 64) / 2; }
__host__ __device__ __forceinline__ int perm32(int rho) { const int n = rho >> 4, i = rho & 15; return 8 * (i >> 2) + 4 * n + (i & 3); }

struct Unit { int pm, pn; };
struct Gemm { const bf16_t* A; const bf16_t* Bt; int M, N, K; int lda = 0; };

struct StaticOrder {
    int nM, nN, nwg, G, c;
    __host__ __device__ void init(int M, int N, int G_, int c_) { nM = M / BM; nN = N / BM; nwg = nM * nN; G = G_; c = c_; }
    __host__ __device__ bool next(int i, Unit& u) const {
        const long L = (long)i * G + c; if (L >= nwg) return false;
        int wgid = (int)L; { const int q = nwg / NXCD, r = nwg % NXCD, xcd = wgid % NXCD, off = wgid / NXCD; wgid = (xcd < r ? xcd * (q + 1) : r * (q + 1) + (xcd - r) * q) + off; }
        const int nig = WGM * nN, gid = wgid / nig, fm = gid * WGM, gsz = (nM - fm) < WGM ? (nM - fm) : WGM;
        u.pm = fm + ((wgid % nig) % gsz); u.pn = (wgid % nig) / gsz; return true;
    }
    __device__ __forceinline__ void a_ready(const Unit&) const {}
    __device__ __forceinline__ void done(const Unit&) const {}
};


template <bool FP8> __host__ __device__ __forceinline__ int lds_xor(int rr) { return FP8 ? (((rr >> 1) & 1) | (rr & 4)) : rr; }
template <bool FP8> __host__ __device__ __forceinline__ int lds_byte2(int r, int ch) { const int rr = r & 7; return (r >> 3) * 1024 + rr * 128 + ((ch ^ lds_xor<FP8>(rr)) << 4); }
template <bool FP8> __host__ __device__ __forceinline__ void stage_rc2(int b, int& R, int& CB) { const int st = b >> 10, i = (b & 1023) >> 4, rr = i >> 3, chp = i & 7; R = st * 8 + rr; CB = (chp ^ lds_xor<FP8>(rr)) << 4; }

struct ListOrder : StaticOrder {
    int mode;
    __host__ __device__ bool next(int i, Unit& u) const {
        long L;
        if (G != 256) { L = (long)i * G + c; }
        else if (mode == 0) { if (i >= 3 || (i == 2 && c >= 128)) return false; L = 256 * i + c; }
        else { if (c < 128) { if (i >= 4) return false; L = c + 128 * i; } else { if (i >= 6) return false; L = 512 + (c - 128) + 128 * i; } }
        if (L >= nwg) return false;
        int wgid = (int)L; { const int q = nwg / NXCD, r = nwg % NXCD, xcd = wgid % NXCD, off = wgid / NXCD; wgid = (xcd < r ? xcd * (q + 1) : r * (q + 1) + (xcd - r) * q) + off; }
        const int nig = WGM * nN, gid = wgid / nig, fm = gid * WGM, gsz = (nM - fm) < WGM ? (nM - fm) : WGM;
        u.pm = fm + ((wgid % nig) % gsz); u.pn = (wgid % nig) / gsz; return true;
    }
};


typedef float f32x2 __attribute__((ext_vector_type(2)));
typedef __bf16 bf16x2_t __attribute__((ext_vector_type(2)));
__device__ __forceinline__ unsigned cvt_pk_bf16(float lo, float hi) { f32x2 v = {lo, hi}; bf16x2_t b = __builtin_convertvector(v, bf16x2_t); return __builtin_bit_cast(unsigned, b); }
__device__ __forceinline__ u32x4 pack8(f32x4 a, f32x4 b) { u32x4 w; w.x = cvt_pk_bf16(a[0], a[1]); w.y = cvt_pk_bf16(a[2], a[3]); w.z = cvt_pk_bf16(b[0], b[1]); w.w = cvt_pk_bf16(b[2], b[3]); return w; }
typedef _Float16 f16x2_t __attribute__((ext_vector_type(2)));
__device__ __forceinline__ unsigned cvt_pk_f16(float lo, float hi) { f32x2 v = {lo, hi}; f16x2_t h = __builtin_convertvector(v, f16x2_t); return __builtin_bit_cast(unsigned, h); }
__device__ __forceinline__ u32x4 pack8h(f32x4 a, f32x4 b) { u32x4 w; w.x = cvt_pk_f16(a[0], a[1]); w.y = cvt_pk_f16(a[2], a[3]); w.z = cvt_pk_f16(b[0], b[1]); w.w = cvt_pk_f16(b[2], b[3]); return w; }
__device__ __forceinline__ void unpack8(u32x4 w, f32x4& a, f32x4& b) {
    a[0] = __uint_as_float(w.x << 16); a[1] = __uint_as_float(w.x & 0xffff0000u); a[2] = __uint_as_float(w.y << 16); a[3] = __uint_as_float(w.y & 0xffff0000u);
    b[0] = __uint_as_float(w.z << 16); b[1] = __uint_as_float(w.z & 0xffff0000u); b[2] = __uint_as_float(w.w << 16); b[3] = __uint_as_float(w.w & 0xffff0000u); }
__device__ __forceinline__ float h2f(unsigned h) { return (float)__builtin_bit_cast(_Float16, (unsigned short)h); }
__device__ __forceinline__ void unpack8h(u32x4 w, f32x4& a, f32x4& b) {
    a[0] = h2f(w.x & 0xffffu); a[1] = h2f(w.x >> 16); a[2] = h2f(w.y & 0xffffu); a[3] = h2f(w.y >> 16);
    b[0] = h2f(w.z & 0xffffu); b[1] = h2f(w.z >> 16); b[2] = h2f(w.w & 0xffffu); b[3] = h2f(w.w >> 16); }
__device__ __forceinline__ unsigned pk4_fp8(float a, float b, float c, float d) { unsigned r = __builtin_amdgcn_cvt_pk_fp8_f32(a, b, 0u, false); return (unsigned)__builtin_amdgcn_cvt_pk_fp8_f32(c, d, r, true); }
__device__ __forceinline__ unsigned long long pack8_fp8(f32x4 a, f32x4 b) { return (unsigned long long)pk4_fp8(a[0], a[1], a[2], a[3]) | ((unsigned long long)pk4_fp8(b[0], b[1], b[2], b[3]) << 32); }
constexpr float K_WSC = 64.0f, K_WSCI = 1.0f / 64.0f;
__device__ __forceinline__ float sum_fq(float s) {
    auto r16 = __builtin_amdgcn_permlane16_swap(__float_as_uint(s), __float_as_uint(s), false, false); s = __uint_as_float(r16[0]) + __uint_as_float(r16[1]);
    auto r32 = __builtin_amdgcn_permlane32_swap(__float_as_uint(s), __float_as_uint(s), false, false); return __uint_as_float(r32[0]) + __uint_as_float(r32[1]); }
__device__ __forceinline__ float fexp(float x) { return __builtin_amdgcn_exp2f(x * 1.4426950408889634f); }
__device__ __forceinline__ float frcp(float x) { return __builtin_amdgcn_rcpf(x); }

constexpr float K_EPS = 1e-6f, K_C2 = 0.125f * 1.4426950408889634f, K_IDXS = 0.04419417382415922f;

struct Epi1 {
    static constexpr bool PERM = true, AFTER_DRAIN = false, MID = false;
    const float* rstd; const float* qn; const float* kn;
    bf16_t *Q, *K, *V, *QI, *KI, *U, *R, *SP; float* WI; int pn_off; float wsc; mutable int cpm = -1; mutable float crs[2][4] = {};
    __device__ __forceinline__ void mid(f32x4 (&)[2][2][4][2], const Unit&, int, int, int, int) const {}
    template <bool NORM, bool F16 = false>
    __device__ __forceinline__ void head_tile(const f32x4 (&acc)[2][2][4][2], const float (&rsr)[2][4], int row0, int fq, bf16_t* dst, int pitch, int colbase, const float* gain, float scale) const {
        f32x4 g[2][2];
#pragma unroll
        for (int bj = 0; bj < 2; ++bj)
#pragma unroll
            for (int n = 0; n < 2; ++n) g[bj][n] = NORM ? *(const f32x4*)(gain + 32 * bj + 8 * fq + 4 * n) : (f32x4){1.f, 1.f, 1.f, 1.f};
#pragma unroll
        for (int ai = 0; ai < 2; ++ai)
#pragma unroll
            for (int m = 0; m < 4; ++m) {
                const int row = row0 + ai * HALF + m * 16; const float rs = rsr[ai][m];
                f32x4 v[2][2]; float ss = 0.f;
#pragma unroll
                for (int bj = 0; bj < 2; ++bj)
#pragma unroll
                    for (int n = 0; n < 2; ++n) { v[bj][n] = acc[ai][bj][m][n] * rs; const f32x4 q = v[bj][n] * v[bj][n]; ss += (q[0] + q[1]) + (q[2] + q[3]); }
                float mul = scale;
                if (NORM) { ss = sum_fq(ss); mul = __builtin_amdgcn_rsqf(ss * (1.0f / 64.0f) + K_EPS) * scale; }
#pragma unroll
                for (int bj = 0; bj < 2; ++bj) {
                    const f32x4 o0 = v[bj][0] * g[bj][0] * mul, o1 = v[bj][1] * g[bj][1] * mul;
                    *(u32x4*)(dst + (size_t)row * pitch + colbase + 32 * bj + 8 * fq) = F16 ? pack8h(o0, o1) : pack8(o0, o1);
                }
            }
    }
    __device__ __forceinline__ void operator()(const f32x4 (&acc)[2][2][4][2], const Unit& u, int wr, int wc, int fr, int fq) const {
        asm volatile("" : "+v"(fr), "+v"(fq));
        const int row0 = u.pm * BM + wr * 64 + fr; const int pn = u.pn + pn_off;
        float rsr[2][4];
        if (u.pm != cpm) {
#pragma unroll
            for (int ai = 0; ai < 2; ++ai)
#pragma unroll
                for (int m = 0; m < 4; ++m) crs[ai][m] = rstd[row0 + ai * HALF + m * 16];
            cpm = u.pm;
        }
#pragma unroll
        for (int ai = 0; ai < 2; ++ai)
#pragma unroll
            for (int m = 0; m < 4; ++m) rsr[ai][m] = crs[ai][m];
        if (pn >= 7) {
            const int cb = (pn - 7) * 128 + wc * 32 + 8 * fq;
#pragma unroll
            for (int ai = 0; ai < 2; ++ai)
#pragma unroll
                for (int m = 0; m < 4; ++m) {
                    const int row = row0 + ai * HALF + m * 16; const float rs = rsr[ai][m] * wsc;
                    f32x4 r[2], s[2];
#pragma unroll
                    for (int n = 0; n < 2; ++n)
#pragma unroll
                        for (int i = 0; i < 4; ++i) {
                            const float ea = fminf(fexp(-acc[ai][0][m][n][i] * rs), 1e30f), ep = fminf(fexp(-acc[ai][1][m][n][i] * rs), 1e30f);
                            const float sp = frcp(1.f + ep); s[n][i] = sp; r[n][i] = (1.f + ep) * frcp(1.f + ea);
                        }
                    *(u32x4*)(R + (size_t)row * 2048 + cb) = pack8(r[0], r[1]);
                    *(u32x4*)(SP + (size_t)row * 2048 + cb) = pack8(s[0], s[1]);
                }
        } else if (pn >= 5) {
#pragma unroll
            for (int ai = 0; ai < 2; ++ai)
#pragma unroll
                for (int m = 0; m < 4; ++m) {
                    const int row = row0 + ai * HALF + m * 16; const float rs = rsr[ai][m] * wsc;
#pragma unroll
                    for (int bj = 0; bj < 2; ++bj)
                        *(u32x4*)(U + (size_t)row * 512 + (pn - 5) * 256 + bj * HALF + wc * 32 + 8 * fq) = pack8(acc[ai][bj][m][0] * rs, acc[ai][bj][m][1] * rs);
                }
        } else if (pn == 2) {
            if (wc == 0) head_tile<true>(acc, rsr, row0, fq, K, 64, 0, kn, 1.0f);
            else if (wc == 1) head_tile<false>(acc, rsr, row0, fq, V, 64, 0, nullptr, 1.0f);
            else if (wc == 2) head_tile<false, true>(acc, rsr, row0, fq, KI, 64, 0, nullptr, 1.0f);
            else {
                if (fq == 0) {
#pragma unroll
                    for (int ai = 0; ai < 2; ++ai)
#pragma unroll
                        for (int m = 0; m < 4; ++m) {
                            const int row = row0 + ai * HALF + m * 16; const float rs = rsr[ai][m] * K_IDXS;
                            *(f32x4*)(WI + (size_t)row * 8) = acc[ai][0][m][0] * rs; *(f32x4*)(WI + (size_t)row * 8 + 4) = acc[ai][0][m][1] * rs;
                        }
                }
            }
        } else if (pn < 2) head_tile<true>(acc, rsr, row0, fq, Q, 512, (pn * 4 + wc) * 64, qn, K_C2);
        else head_tile<false, true>(acc, rsr, row0, fq, QI, 512, ((pn - 3) * 4 + wc) * 64, nullptr, 1.0f);
    }
};

struct Epi3 {
    static constexpr bool PERM = true, AFTER_DRAIN = false, MID = true;
    const bf16_t* R; const bf16_t* SP; unsigned char* MG;
    __device__ __forceinline__ void scale_by(f32x4 (&acc)[2][2][4][2], const bf16_t* Sc, const Unit& u, int wr, int wc, int fr, int fq) const {
        asm volatile("" : "+v"(fr), "+v"(fq));
        const int row0 = u.pm * BM + wr * 64 + fr, col0 = u.pn * BM + wc * 32 + 8 * fq;
#pragma unroll
        for (int ai = 0; ai < 2; ++ai) {
            u32x4 w[4][2];
#pragma unroll
            for (int m = 0; m < 4; ++m)
#pragma unroll
                for (int bj = 0; bj < 2; ++bj) w[m][bj] = *(const u32x4*)(Sc + (size_t)(row0 + ai * HALF + m * 16) * 2048 + col0 + bj * HALF);
#pragma unroll
            for (int m = 0; m < 4; ++m)
#pragma unroll
                for (int bj = 0; bj < 2; ++bj) { f32x4 a, b; unpack8(w[m][bj], a, b); acc[ai][bj][m][0] *= a; acc[ai][bj][m][1] *= b; }
        }
    }
    __device__ __forceinline__ void mid(f32x4 (&acc)[2][2][4][2], const Unit& u, int wr, int wc, int fr, int fq) const { scale_by(acc, R, u, wr, wc, fr, fq); }
    __device__ __forceinline__ void operator()(const f32x4 (&acc)[2][2][4][2], const Unit& u, int wr, int wc, int fr, int fq) const {
        asm volatile("" : "+v"(fr), "+v"(fq));
        const int row0 = u.pm * BM + wr * 64 + fr, col0 = u.pn * BM + wc * 32 + 8 * fq;
#pragma unroll
        for (int ai = 0; ai < 2; ++ai) {
            u32x4 w[4][2];
#pragma unroll
            for (int m = 0; m < 4; ++m)
#pragma unroll
                for (int bj = 0; bj < 2; ++bj) w[m][bj] = *(const u32x4*)(SP + (size_t)(row0 + ai * HALF + m * 16) * 2048 + col0 + bj * HALF);
#pragma unroll
            for (int m = 0; m < 4; ++m)
#pragma unroll
                for (int bj = 0; bj < 2; ++bj) {
                    const size_t off = (size_t)(row0 + ai * HALF + m * 16) * 1024 + col0 + bj * HALF;
                    f32x4 a, b; unpack8(w[m][bj], a, b);
                    *(unsigned long long*)(MG + off) = pack8_fp8(acc[ai][bj][m][0] * a * (8.0f * K_WSCI), acc[ai][bj][m][1] * b * (8.0f * K_WSCI));
                }
        }
    }
};

struct Epi4 {
    static constexpr bool PERM = true, AFTER_DRAIN = false, MID = false;
    const bf16_t* XB; bf16_t* H2; unsigned char* H2F8; float* SSQ;
    __device__ __forceinline__ void mid(f32x4 (&)[2][2][4][2], const Unit&, int, int, int, int) const {}
    __device__ __forceinline__ void operator()(const f32x4 (&acc)[2][2][4][2], const Unit& u, int wr, int wc, int fr, int fq) const {
        asm volatile("" : "+v"(fr), "+v"(fq));
        const int row0 = u.pm * BM + wr * 64 + fr, col0 = u.pn * BM + wc * 32 + 8 * fq;
#pragma unroll
        for (int ai = 0; ai < 2; ++ai) {
            u32x4 xw[4][2];
#pragma unroll
            for (int m = 0; m < 4; ++m)
#pragma unroll
                for (int bj = 0; bj < 2; ++bj) xw[m][bj] = *(const u32x4*)(XB + (size_t)(row0 + ai * HALF + m * 16) * 1024 + col0 + bj * HALF);
#pragma unroll
            for (int m = 0; m < 4; ++m) {
                const int row = row0 + ai * HALF + m * 16; float ss = 0.f;
#pragma unroll
                for (int bj = 0; bj < 2; ++bj) {
                    const size_t off = (size_t)row * 1024 + col0 + bj * HALF;
                    f32x4 a, b; unpack8h(xw[m][bj], a, b);
                    a += acc[ai][bj][m][0] * (K_WSCI * 0.125f); b += acc[ai][bj][m][1] * (K_WSCI * 0.125f);
                    const f32x4 q = a * a + b * b; ss += (q[0] + q[1]) + (q[2] + q[3]);
                    *(u32x4*)(H2 + off) = pack8(a, b);
                    *(unsigned long long*)(H2F8 + off) = pack8_fp8(a, b);
                }
                ss = sum_fq(ss);
                if (fq == 0) SSQ[(size_t)row * 16 + u.pn * 4 + wc] = ss;
            }
        }
    }
};

struct Epi5 {
    static constexpr bool PERM = true, AFTER_DRAIN = false, MID = false;
    const float* SSQ; unsigned char* ACT;
    mutable int cpm = -1; mutable float crs[2][4] = {};
    __device__ __forceinline__ void mid(f32x4 (&)[2][2][4][2], const Unit&, int, int, int, int) const {}
    __device__ __forceinline__ void operator()(const f32x4 (&acc)[2][2][4][2], const Unit& u, int wr, int wc, int fr, int fq) const {
        asm volatile("" : "+v"(fr), "+v"(fq));
        const int row0 = u.pm * BM + wr * 64 + fr, col0 = u.pn * 128 + wc * 32 + 8 * fq;
        float rsv[2][4];
        if (u.pm != cpm) { f32x4 part[2][4];
#pragma unroll
          for (int ai = 0; ai < 2; ++ai)
#pragma unroll
              for (int m = 0; m < 4; ++m) part[ai][m] = *(const f32x4*)(SSQ + (size_t)(row0 + ai * HALF + m * 16) * 16 + 4 * fq);
#pragma unroll
          for (int ai = 0; ai < 2; ++ai)
#pragma unroll
              for (int m = 0; m < 4; ++m) { float s = (part[ai][m][0] + part[ai][m][1]) + (part[ai][m][2] + part[ai][m][3]); s = sum_fq(s);
                  crs[ai][m] = __builtin_amdgcn_rsqf(s * (1.0f / 1024.0f) + K_EPS) * (MK_FP8 ? K_WSCI : 1.0f); }
          cpm = u.pm; }
#pragma unroll
        for (int ai = 0; ai < 2; ++ai)
#pragma unroll
            for (int m = 0; m < 4; ++m) rsv[ai][m] = crs[ai][m];
#pragma unroll
        for (int ai = 0; ai < 2; ++ai)
#pragma unroll
            for (int m = 0; m < 4; ++m) {
                const int row = row0 + ai * HALF + m * 16; const float rs = rsv[ai][m];
                const float k1 = -rs * 1.4426950408889634f, rs2 = rs * rs;
                f32x4 o[2];
#pragma unroll
                for (int n = 0; n < 2; ++n) {
                    const f32x4 ag = acc[ai][0][m][n], au = acc[ai][1][m][n];
                    const f32x4 t = ag * k1; f32x4 e;
#pragma unroll
                    for (int i = 0; i < 4; ++i) e[i] = __builtin_amdgcn_exp2f(t[i]);
                    const f32x4 d = e + 1.0f; f32x4 r;
#pragma unroll
                    for (int i = 0; i < 4; ++i) r[i] = __builtin_amdgcn_rcpf(d[i]);
                    o[n] = (ag * au) * (r * rs2);
                }
                if (MK_FP8) *(unsigned long long*)(ACT + (size_t)row * 4096 + col0) = pack8_fp8(o[0], o[1]); else *(u32x4*)((bf16_t*)ACT + (size_t)row * 2816 + col0) = pack8(o[0], o[1]);
            }
    }
};

struct Epi6 {
    static constexpr bool PERM = false, AFTER_DRAIN = false, MID = false;
    const bf16_t* H2; float* OUT;
    __device__ __forceinline__ void mid(f32x4 (&)[2][2][4][2], const Unit&, int, int, int, int) const {}
    __device__ __forceinline__ void operator()(const f32x4 (&acc)[2][2][4][2], const Unit& u, int wr, int wc, int fr, int fq) const {
        asm volatile("" : "+v"(fr), "+v"(fq));
        const int row0 = u.pm * BM + wr * 64 + fr, col0 = u.pn * BM + wc * 32 + 4 * fq;
#pragma unroll
        for (int ai = 0; ai < 2; ++ai) {
            unsigned long long hw[4][2][2];
#pragma unroll
            for (int m = 0; m < 4; ++m)
#pragma unroll
                for (int bj = 0; bj < 2; ++bj)
#pragma unroll
                    for (int n = 0; n < 2; ++n) hw[m][bj][n] = *(const unsigned long long*)(H2 + (size_t)(row0 + ai * HALF + m * 16) * 1024 + col0 + bj * HALF + n * 16);
#pragma unroll
            for (int m = 0; m < 4; ++m)
#pragma unroll
                for (int bj = 0; bj < 2; ++bj)
#pragma unroll
                    for (int n = 0; n < 2; ++n) {
                        const size_t off = (size_t)(row0 + ai * HALF + m * 16) * 1024 + col0 + bj * HALF + n * 16;
                        const unsigned long long w = hw[m][bj][n];
                        f32x4 r; r[0] = __uint_as_float((unsigned)w << 16); r[1] = __uint_as_float((unsigned)w & 0xffff0000u); r[2] = __uint_as_float((unsigned)(w >> 32) << 16); r[3] = __uint_as_float((unsigned)(w >> 32) & 0xffff0000u);
                        *(f32x4*)(OUT + off) = r + acc[ai][bj][m][n] * (MK_FP8 ? K_WSCI : 1.0f);
                    }
        }
    }
};

typedef int v8i_t __attribute__((ext_vector_type(8)));
typedef _Float16 f16x8_t __attribute__((ext_vector_type(8)));
typedef int v4i_t __attribute__((ext_vector_type(4)));
template <class Epi, class Sched, bool ALIGN_EPI = false, bool SP2 = false, int DT = 0>
__device__ __forceinline__ void gemm_phase(PG8_LAS unsigned char* lds, const Gemm g, const Sched& S, const Epi& E, const int wave_s) {
    const int wid = wave_s, lane = mk_lane(), tid = wid * 64 + lane, wr = wid >> 2, wc = wid & 3, fr = lane & 15, fq = lane >> 4;
    constexpr int ES = (DT == 2) ? 1 : 2, KST = (DT == 2) ? 16 : 1024;
    const int K = g.K, nt = K * ES / 128;
    const int rowA = g.lda ? g.lda : K * ES;
    unsigned voffA[2], voffB[2];
#pragma unroll
    for (int i = 0; i < 2; ++i) { int R, CB; stage_rc2<DT == 2>(tid * 16 + i * 8192, R, CB); const int Rb = Epi::PERM ? ((R & ~31) + perm32(R & 31)) : R;
        voffA[i] = (unsigned)(R * rowA + CB); voffB[i] = (unsigned)(Rb * K * ES + CB); }
    const size_t kstep = (size_t)(BK * 2);
    const size_t hstep = (size_t)HALF * K * ES;
    const size_t tstep = 2 * hstep;
    const size_t hstepA = (size_t)HALF * rowA, tstepA = 2 * hstepA;
    const unsigned ldsw = (unsigned)wid * 1024u;
    const int aoff = lds_byte2<DT == 2>(wr * 64 + fr, (DT == 2) ? 2 * fq : fq), boff = lds_byte2<DT == 2>(wc * 32 + fr, (DT == 2) ? 2 * fq : fq);
    const int aoff1 = aoff ^ ((DT == 2) ? 16 : 64), boff1 = boff ^ ((DT == 2) ? 16 : 64);
#define PG8_SA(b, h) (((b) * 2 + (h)) * HTB)
#define PG8_SB(b, h) ((4 + (b) * 2 + (h)) * HTB)
#define PG8_STAGE(bufoff, gbase, voff) do { _Pragma("unroll") for (int _i = 0; _i < 2; ++_i) \
        __builtin_amdgcn_global_load_lds((const unsigned*)((const char*)(gbase) + (voff)[_i]), (PG8_LAS unsigned*)(lds + (bufoff) + ldsw + _i * 8192), 16, 0, 0); } while (0)
#define PG8_LD8(dstv, ptr0, ptr1) do { const v4i_t lo_ = *(const PG8_LAS v4i_t*)(ptr0); const v4i_t hi_ = *(const PG8_LAS v4i_t*)(ptr1); dstv = __builtin_shufflevector(lo_, hi_, 0, 1, 2, 3, 4, 5, 6, 7); } while (0)
#define PG8_LDA(dst, b, h) do { if constexpr (DT == 2) { _Pragma("unroll") for (int m = 0; m < 4; ++m) PG8_LD8(dst##8[m], lds + PG8_SA(b, h) + aoff + m * 2048, lds + PG8_SA(b, h) + aoff1 + m * 2048); } else { \
        _Pragma("unroll") for (int m = 0; m < 4; ++m) _Pragma("unroll") for (int k = 0; k < 2; ++k) dst[m][k] = *(const PG8_LAS bf16x8*)(lds + PG8_SA(b, h) + (k ? aoff1 : aoff) + m * 2048); } } while (0)
#define PG8_LDB(dst, b, h) do { if constexpr (DT == 2) { _Pragma("unroll") for (int n = 0; n < 2; ++n) PG8_LD8(dst##8[n], lds + PG8_SB(b, h) + boff + n * 2048, lds + PG8_SB(b, h) + boff1 + n * 2048); } else { \
        _Pragma("unroll") for (int n = 0; n < 2; ++n) _Pragma("unroll") for (int k = 0; k < 2; ++k) dst[n][k] = *(const PG8_LAS bf16x8*)(lds + PG8_SB(b, h) + (k ? boff1 : boff) + n * 2048); } } while (0)
#define PG8_MMA(ai, bj, At, Bt) do { __builtin_amdgcn_s_setprio(1); _Pragma("unroll") for (int m = 0; m < 4; ++m) _Pragma("unroll") for (int n = 0; n < 2; ++n) { \
        if constexpr (DT == 2) { if (m == 0 && n == 0) asm volatile("s_nop 1\n\tv_mfma_f32_16x16x128_f8f6f4 %0, %1, %2, %0" : "+v"(acc[ai][bj][m][n]) : "v"(Bt##8[n]), "v"(At##8[m]));   \
            else asm volatile("v_mfma_f32_16x16x128_f8f6f4 %0, %1, %2, %0" : "+v"(acc[ai][bj][m][n]) : "v"(Bt##8[n]), "v"(At##8[m])); } \
        else if constexpr (DT == 1) { _Pragma("unroll") for (int k = 0; k < 2; ++k) acc[ai][bj][m][n] = __builtin_amdgcn_mfma_f32_16x16x32_f16(__builtin_bit_cast(f16x8_t, Bt[n][k]), __builtin_bit_cast(f16x8_t, At[m][k]), acc[ai][bj][m][n], 0, 0, 0); } \
        else { _Pragma("unroll") for (int k = 0; k < 2; ++k) acc[ai][bj][m][n] = __builtin_amdgcn_mfma_f32_16x16x32_bf16(Bt[n][k], At[m][k], acc[ai][bj][m][n], 0, 0, 0); } } \
        __builtin_amdgcn_s_setprio(0); } while (0)
#define PG8_WAIT_V(n) asm volatile("s_waitcnt vmcnt(" #n ")" ::: "memory")
#define PG8_WAIT_L(n) asm volatile("s_waitcnt lgkmcnt(" #n ")" ::: "memory")
#define PG8_BAR __builtin_amdgcn_s_barrier()
#define PG8_SCHED __builtin_amdgcn_sched_barrier(0)
    Unit cur, nxt; int ui = 0;
    if (!S.next(0, cur)) return;
    f32x4 acc[2][2][4][2];
#pragma unroll
    for (int a = 0; a < 2; ++a)
#pragma unroll
        for (int b = 0; b < 2; ++b)
#pragma unroll
            for (int m = 0; m < 4; ++m)
#pragma unroll
                for (int n = 0; n < 2; ++n) acc[a][b][m][n] = (f32x4){0.f, 0.f, 0.f, 0.f};
    bf16x8 At[4][2], B0[2][2], B1[2][2]; v8i_t At8[4], B08[2], B18[2];
    const char* cA = (const char*)g.A + (size_t)cur.pm * tstepA; const char* cB = (const char*)g.Bt + (size_t)cur.pn * tstep;
    S.a_ready(cur);
    if constexpr (SP2) {
        PG8_STAGE(PG8_SB(0, 0), cB, voffB); PG8_STAGE(PG8_SB(0, 1), cB + hstep, voffB); PG8_STAGE(PG8_SA(0, 0), cA, voffA); PG8_STAGE(PG8_SA(0, 1), cA + hstepA, voffA);
        if (wr == 1) PG8_BAR;
        PG8_WAIT_V(2); PG8_BAR;
        PG8_STAGE(PG8_SB(1, 0), cB + kstep, voffB); PG8_STAGE(PG8_SA(1, 0), cA + kstep, voffA); PG8_STAGE(PG8_SB(1, 1), cB + hstep + kstep, voffB);
        PG8_WAIT_V(6); PG8_BAR;
    } else {
        PG8_STAGE(PG8_SB(0, 0), cB, voffB); PG8_STAGE(PG8_SA(0, 0), cA, voffA); PG8_STAGE(PG8_SB(0, 1), cB + hstep, voffB); PG8_STAGE(PG8_SA(0, 1), cA + hstepA, voffA);
        if (wr == 1) PG8_BAR;
        PG8_WAIT_V(4); PG8_BAR;
        PG8_STAGE(PG8_SB(1, 0), cB + kstep, voffB); PG8_STAGE(PG8_SA(1, 0), cA + kstep, voffA); PG8_STAGE(PG8_SB(1, 1), cB + hstep + kstep, voffB);
        PG8_WAIT_V(6); PG8_BAR;
    }
    for (;;) {
        const bool has_next = S.next(ui + 1, nxt);
        const char* nA = has_next ? (const char*)g.A + (size_t)nxt.pm * tstepA : cA; const char* nB = has_next ? (const char*)g.Bt + (size_t)nxt.pn * tstep : cB;
#pragma unroll 1
        for (int t = 0; t < nt; t += 2) {
            if constexpr (Epi::MID) { if (t == (nt >> 1)) { if constexpr (DT == 2) asm volatile("s_nop 15\n\ts_nop 15" ::: "memory"); __builtin_amdgcn_sched_barrier(0); E.mid(acc, cur, wr, wc, fr, fq); if constexpr (DT == 2) { __builtin_amdgcn_sched_barrier(0); asm volatile("s_nop 4" ::: "memory"); } } }
            asm volatile("" : "+v"(voffA[0]), "+v"(voffA[1]), "+v"(voffB[0]), "+v"(voffB[1]));
            const bool last = (t == nt - 2);
            const char* a1 = cA + (size_t)(t + 1) * kstep;
            const char* a2 = last ? nA : cA + (size_t)(t + 2) * kstep; const char* b2 = last ? nB : cB + (size_t)(t + 2) * kstep;
            const char* a3 = a2 + kstep; const char* b3 = b2 + kstep;
            if (last && has_next) S.a_ready(nxt);
            if constexpr (SP2) {
            PG8_LDB(B0, 0, 0); PG8_LDB(B1, 0, 1); PG8_SCHED; PG8_LDA(At, 0, 0); PG8_STAGE(PG8_SA(1, 1), a1 + hstepA, voffA);
            PG8_WAIT_V(8); PG8_WAIT_L(0); PG8_BAR; PG8_MMA(0, 0, At, B0); PG8_MMA(0, 1, At, B1); PG8_BAR; PG8_SCHED;
            PG8_LDA(At, 0, 1); PG8_STAGE(PG8_SB(0, 0), b2, voffB); PG8_STAGE(PG8_SB(0, 1), b2 + hstep, voffB); PG8_STAGE(PG8_SA(0, 0), a2, voffA);
            PG8_WAIT_V(8); PG8_WAIT_L(0); PG8_BAR; PG8_MMA(1, 0, At, B0); PG8_MMA(1, 1, At, B1); PG8_BAR; PG8_SCHED;
            PG8_LDB(B0, 1, 0); PG8_LDB(B1, 1, 1); PG8_SCHED; PG8_LDA(At, 1, 0); PG8_STAGE(PG8_SA(0, 1), a2 + hstepA, voffA);
            PG8_WAIT_V(8); PG8_WAIT_L(0); PG8_BAR; PG8_MMA(0, 0, At, B0); PG8_MMA(0, 1, At, B1); PG8_BAR; PG8_SCHED;
            PG8_LDA(At, 1, 1); PG8_STAGE(PG8_SB(1, 0), b3, voffB); PG8_STAGE(PG8_SB(1, 1), b3 + hstep, voffB); PG8_STAGE(PG8_SA(1, 0), a3, voffA);
            PG8_WAIT_V(8); PG8_WAIT_L(0); PG8_BAR; PG8_MMA(1, 0, At, B0); PG8_MMA(1, 1, At, B1); PG8_BAR; PG8_SCHED;
            } else {
            PG8_LDB(B0, 0, 0); PG8_SCHED; PG8_LDA(At, 0, 0); PG8_STAGE(PG8_SA(1, 1), a1 + hstepA, voffA);
            PG8_WAIT_L(8); PG8_BAR; PG8_WAIT_L(0); PG8_MMA(0, 0, At, B0); PG8_BAR; PG8_SCHED;
            PG8_LDB(B1, 0, 1); PG8_STAGE(PG8_SB(0, 0), b2, voffB);
            PG8_BAR; PG8_WAIT_L(0); PG8_MMA(0, 1, At, B1); PG8_BAR;
            PG8_LDA(At, 0, 1); PG8_STAGE(PG8_SA(0, 0), a2, voffA);
            PG8_BAR; PG8_WAIT_L(0); PG8_MMA(1, 0, At, B0); PG8_BAR; PG8_SCHED;
            PG8_STAGE(PG8_SB(0, 1), b2 + hstep, voffB);
            PG8_WAIT_V(6); PG8_BAR; PG8_MMA(1, 1, At, B1); PG8_BAR;
            PG8_LDB(B0, 1, 0); PG8_SCHED; PG8_LDA(At, 1, 0); PG8_STAGE(PG8_SA(0, 1), a2 + hstepA, voffA);
            PG8_WAIT_L(8); PG8_BAR; PG8_WAIT_L(0); PG8_MMA(0, 0, At, B0); PG8_BAR; PG8_SCHED;
            PG8_LDB(B1, 1, 1); PG8_STAGE(PG8_SB(1, 0), b3, voffB);
            PG8_BAR; PG8_WAIT_L(0); PG8_MMA(0, 1, At, B1); PG8_BAR;
            PG8_LDA(At, 1, 1); PG8_STAGE(PG8_SA(1, 0), a3, voffA);
            PG8_BAR; PG8_WAIT_L(0); PG8_MMA(1, 0, At, B0); PG8_BAR; PG8_SCHED;
            PG8_STAGE(PG8_SB(1, 1), b3 + hstep, voffB);
            PG8_WAIT_V(6); PG8_BAR; PG8_MMA(1, 1, At, B1); PG8_BAR;
            }
        }
        if constexpr (DT == 2) { asm volatile("s_nop 15\n\ts_nop 15" ::: "memory"); __builtin_amdgcn_sched_barrier(0); }
        if constexpr (ALIGN_EPI) { if (wr == 0) PG8_BAR; }
        if constexpr (!Epi::AFTER_DRAIN) { E(acc, cur, wr, wc, fr, fq); S.done(cur); }
        if (!has_next) break;
#pragma unroll
        for (int a = 0; a < 2; ++a)
#pragma unroll
            for (int b = 0; b < 2; ++b)
#pragma unroll
                for (int m = 0; m < 4; ++m)
#pragma unroll
                    for (int n = 0; n < 2; ++n) acc[a][b][m][n] = (f32x4){0.f, 0.f, 0.f, 0.f};
        cur = nxt; cA = nA; cB = nB; ++ui;
        if constexpr (ALIGN_EPI) { if (wr == 1) PG8_BAR; }
    }
    PG8_WAIT_V(0);
    if constexpr (!ALIGN_EPI) { if (wr == 0) PG8_BAR; }
    PG8_BAR;
    if constexpr (Epi::AFTER_DRAIN) { E.fused(acc, cur, wr, wc, fr, fq, lds, wid, lane); S.done(cur); }
#undef PG8_SA
#undef PG8_SB
#undef PG8_STAGE
#undef PG8_LD8
#undef PG8_LDA
#undef PG8_LDB
#undef PG8_MMA
#undef PG8_WAIT_V
#undef PG8_WAIT_L
#undef PG8_BAR
#undef PG8_SCHED
}
}

namespace att {
typedef unsigned short bf16_t;
typedef short bf16x8 __attribute__((ext_vector_type(8)));
typedef short s16x4 __attribute__((ext_vector_type(4)));
typedef _Float16 f16x8 __attribute__((ext_vector_type(8)));
typedef short v4i16_t __attribute__((ext_vector_type(4)));
typedef float f32x16 __attribute__((ext_vector_type(16)));
typedef float f32x32 __attribute__((ext_vector_type(32)));
typedef float f32x4 __attribute__((ext_vector_type(4)));
typedef float f32x2_t __attribute__((ext_vector_type(2)));
typedef __bf16 bf16x2_t __attribute__((ext_vector_type(2)));
typedef unsigned u32x4 __attribute__((ext_vector_type(4)));
#define ALAS __attribute__((address_space(3)))
typedef ALAS unsigned char* lptr;
constexpr int SEQ = 2048;
constexpr int LK = 0, LV = 32768, VSLOT = 8320, VDH = 4160, LBM = 66048, LWS = 74240, LOST = 76288, LBYTES = 109056;
constexpr float LOG2E = 1.4426950408889634f;
constexpr float THR = 8.0f;

__device__ __forceinline__ int crow(int r, int hi) { return (r & 3) + 8 * (r >> 2) + 4 * hi; }
__device__ __forceinline__ unsigned cvtpk_s(float lo, float hi) { f32x2_t v = {lo, hi}; bf16x2_t b = __builtin_convertvector(v, bf16x2_t); return __builtin_bit_cast(unsigned, b); }
__device__ __forceinline__ s16x4 vtr(lptr p) { return __builtin_bit_cast(s16x4, __builtin_amdgcn_ds_read_tr16_b64_v4i16((ALAS v4i16_t*)p)); }
__device__ __forceinline__ float bf_round(float f) { unsigned u = __float_as_uint(f); u = (u + 0x7fffu + ((u >> 16) & 1u)) & 0xffff0000u; return __uint_as_float(u); }
__device__ __forceinline__ unsigned fkey(float f) { const unsigned u = __float_as_uint(f); return u ^ ((unsigned)((int)u >> 31) | 0x80000000u); }
__device__ __forceinline__ int half_sum(int v) {
    v += __builtin_amdgcn_update_dpp(0, v, 0xB1, 0xF, 0xF, true);
    v += __builtin_amdgcn_update_dpp(0, v, 0x4E, 0xF, 0xF, true);
    v += __builtin_amdgcn_update_dpp(0, v, 0x141, 0xF, 0xF, true);
    v += __builtin_amdgcn_update_dpp(0, v, 0x140, 0xF, 0xF, true);
    auto rr = __builtin_amdgcn_permlane16_swap((unsigned)v, (unsigned)v, false, false);
    return (int)rr[0] + (int)rr[1];
}
__device__ __forceinline__ float relu1(float x) { const int i = __float_as_int(x); return __int_as_float(i > 0 ? i : 0); }
__device__ __forceinline__ void cnt4(int& c0, int& c1, float k0, float k1, float k2, float k3, float cand) {
    asm volatile("v_cmp_le_f32_e32 vcc, %6, %2\n\tv_addc_co_u32_e32 %0, vcc, 0, %0, vcc\n\tv_cmp_le_f32_e32 vcc, %6, %3\n\tv_addc_co_u32_e32 %1, vcc, 0, %1, vcc\n\t"
                 "v_cmp_le_f32_e32 vcc, %6, %4\n\tv_addc_co_u32_e32 %0, vcc, 0, %0, vcc\n\tv_cmp_le_f32_e32 vcc, %6, %5\n\tv_addc_co_u32_e32 %1, vcc, 0, %1, vcc"
                 : "+v"(c0), "+v"(c1) : "v"(k0), "v"(k1), "v"(k2), "v"(k3), "v"(cand) : "vcc");
}
__device__ __forceinline__ float dppf(float v, int ctl) { return ctl == 0 ? __uint_as_float(__builtin_amdgcn_update_dpp(0u, __float_as_uint(v), 0xB1, 0xF, 0xF, true)) : ctl == 1 ? __uint_as_float(__builtin_amdgcn_update_dpp(0u, __float_as_uint(v), 0x4E, 0xF, 0xF, true))
                                                        : ctl == 2 ? __uint_as_float(__builtin_amdgcn_update_dpp(0u, __float_as_uint(v), 0x141, 0xF, 0xF, true)) : __uint_as_float(__builtin_amdgcn_update_dpp(0u, __float_as_uint(v), 0x140, 0xF, 0xF, true)); }
__device__ __forceinline__ float half_max(float v) { v = __builtin_fmaxf(v, dppf(v, 0)); v = __builtin_fmaxf(v, dppf(v, 1)); v = __builtin_fmaxf(v, dppf(v, 2)); v = __builtin_fmaxf(v, dppf(v, 3));
    auto rr = __builtin_amdgcn_permlane16_swap(__float_as_uint(v), __float_as_uint(v), false, false); return __builtin_fmaxf(__uint_as_float(rr[0]), __uint_as_float(rr[1])); }
__device__ __forceinline__ float half_min(float v) { v = __builtin_fminf(v, dppf(v, 0)); v = __builtin_fminf(v, dppf(v, 1)); v = __builtin_fminf(v, dppf(v, 2)); v = __builtin_fminf(v, dppf(v, 3));
    auto rr = __builtin_amdgcn_permlane16_swap(__float_as_uint(v), __float_as_uint(v), false, false); return __builtin_fminf(__uint_as_float(rr[0]), __uint_as_float(rr[1])); }
#define MX3(a, b, c) __builtin_fmaxf(__builtin_fmaxf((a), (b)), (c))
__device__ __forceinline__ float rowmax(const f32x16& p0, const f32x16& p1) {
    float a = MX3(p0[0], p0[1], p1[0]), b = MX3(p0[2], p0[3], p1[1]); a = MX3(a, p1[2], p1[3]);
#pragma unroll
    for (int r = 4; r < 16; r += 4) { a = MX3(a, p0[r], p0[r + 1]); b = MX3(b, p0[r + 2], p0[r + 3]); a = MX3(a, p1[r], p1[r + 1]); b = MX3(b, p1[r + 2], p1[r + 3]); }
    float m = __builtin_fmaxf(a, b); auto rr = __builtin_amdgcn_permlane32_swap(__float_as_uint(m), __float_as_uint(m), false, false);
    return __builtin_fmaxf(__uint_as_float(rr[0]), __uint_as_float(rr[1])); }

struct Tensors { const bf16_t* Q; const bf16_t* K; const bf16_t* V; const bf16_t* QI; const bf16_t* KI; const float* WI; unsigned char* AP; float qk2; };

__device__ __forceinline__ u32x4 tile_ld(const bf16_t* base, long row0, int tid) { const unsigned voff = (unsigned)((tid >> 3) * 128 + (tid & 7) * 16); return *(const u32x4*)((const char*)(base + row0 * 64) + voff); }
__device__ __forceinline__ void kimg_st(lptr lds, int slot, int tid, u32x4 v) { const int row = tid >> 3, ch = tid & 7; *(ALAS u32x4*)(lds + LK + slot * 8192 + row * 128 + ((ch ^ ((row >> 1) & 7)) << 4)) = v; }
__device__ __forceinline__ void kimg_dma(lptr lds, int slot, int wid, int lane, const bf16_t* base, long row0) {
    const int row = 8 * wid + (lane >> 3), ch = (lane & 7) ^ ((row >> 1) & 7);
    __builtin_amdgcn_global_load_lds((const unsigned*)((const char*)(base + row0 * 64) + row * 128 + ch * 16), (ALAS unsigned*)(lds + LK + slot * 8192 + wid * 1024), 16, 0, 0);
}
__device__ __forceinline__ int kfrag_off(int r32, int hi, int d0) { return r32 * 128 + (((2 * d0 + hi) ^ ((r32 >> 1) & 7)) << 4); }
__device__ __forceinline__ void vimg_st(lptr lds, int slot, int tid, u32x4 v) { *(ALAS u32x4*)(lds + LV + slot * VSLOT + ((tid & 7) >> 2) * VDH + (tid >> 3) * 64 + (tid & 3) * 16) = v; }

struct UnitPF { bf16x8 qi[4]; f32x4 wv[4]; };
__device__ __forceinline__ void unit_prefetch(UnitPF& pf, int b, int qb, const Tensors& T, const int wave_s, lptr lds, const bool dma) {
    int tid = threadIdx.x; asm volatile("" : "+v"(tid));
    const int lane = tid & 63, r32 = lane & 31, hi = lane >> 5; const int wid = __builtin_amdgcn_readfirstlane(threadIdx.x >> 6);
    const int t0 = qb * 32, NT = (qb >> 1) + 1; const long rowbase = (long)b * SEQ; const long tq_row = rowbase + t0 + 4 * wid + (r32 >> 3);
#pragma unroll
    for (int d0 = 0; d0 < 4; ++d0) pf.qi[d0] = *(const bf16x8*)(T.QI + tq_row * 512 + (r32 & 7) * 64 + d0 * 16 + hi * 8);
#pragma unroll
    for (int g = 0; g < 4; ++g) pf.wv[g] = *(const f32x4*)(T.WI + (rowbase + t0 + 4 * wid + g) * 8 + 4 * hi);
    if (dma) {
#pragma unroll
        for (int t = 0; t < 4; ++t) if (t < NT) kimg_dma(lds, t, wid, lane, T.KI, rowbase + 64 * t);
    }
}
__device__ __forceinline__ void attn_unit(int b, int qb, const Tensors& T, lptr lds, UnitPF& pf, bool has_next, int nb, int nqb, const int wave_s) {
    int tid_ = threadIdx.x; asm volatile("" : "+v"(tid_));
    const int tid = tid_, lane = tid & 63, r32 = lane & 31, hi = lane >> 5; const int wid = __builtin_amdgcn_readfirstlane(threadIdx.x >> 6);
    const int t0 = qb * 32, NT = (qb >> 1) + 1;
    const long rowbase = (long)b * SEQ;
    const int g_row = r32 >> 3, h_row = r32 & 7;
    const long tq_row = rowbase + t0 + 4 * wid + g_row;

    f32x32 keyv[2][2];
#define KEY(j, n, pr) keyv[n][pr][j]
#ifndef REP_IDX
#define REP_IDX 1
#endif
#ifndef REP_SEL
#define REP_SEL 1
#endif
#ifndef REP_ATT
#define REP_ATT 1
#endif
#pragma unroll 1
    for (int rep_i = 0; rep_i < REP_IDX; ++rep_i) {
        bf16x8 qi[4]; f32x4 wv[4];
#pragma unroll
        for (int d0 = 0; d0 < 4; ++d0) { qi[d0] = pf.qi[d0]; wv[d0] = pf.wv[d0]; }
        const int lanev = r32 - hi;
        __syncthreads();
        int kfo0 = kfrag_off(r32, hi, 0); asm volatile("" : "+v"(kfo0));
        bf16x8 F[8];
#pragma unroll
        for (int q = 0; q < 8; ++q) F[q] = *(const ALAS bf16x8*)(lds + LK + (kfo0 ^ ((q >> 1) << 5)) + (q & 1) * 4096);
#pragma unroll
        for (int n = 0; n < 2; ++n) { keyv[n][0] = (f32x32)(__builtin_nanf("")); keyv[n][1] = (f32x32)(__builtin_nanf("")); }
#pragma unroll 1
        for (int jb = 0; jb < NT; jb += 2) {
#pragma unroll
            for (int u = 0; u < 2; ++u) {
                const int j = jb + u;
                if (u == 0 || j < NT) {
                    if (u == 0) {
                        if (j + 4 < NT) kimg_dma(lds, (j + 4) % 6, wid, lane, T.KI, rowbase + 64 * (j + 4));
                        if (j + 5 < NT) kimg_dma(lds, (j + 5) % 6, wid, lane, T.KI, rowbase + 64 * (j + 5));
                    }
                    f32x16 acc0 = {}, acc1 = {};
#pragma unroll
                    for (int d0 = 0; d0 < 4; ++d0) {
                        acc0 = __builtin_amdgcn_mfma_f32_32x32x16_f16(__builtin_bit_cast(f16x8, qi[d0]), __builtin_bit_cast(f16x8, F[2 * d0]), acc0, 0, 0, 0);
                        acc1 = __builtin_amdgcn_mfma_f32_32x32x16_f16(__builtin_bit_cast(f16x8, qi[d0]), __builtin_bit_cast(f16x8, F[2 * d0 + 1]), acc1, 0, 0, 0);
                    }
                    __builtin_amdgcn_sched_barrier(0);
                    if (j + 1 < NT) {
                        const int so = ((j + 1) % 6) * 8192;
#pragma unroll
                        for (int q = 0; q < 8; ++q) F[q] = *(const ALAS bf16x8*)(lds + LK + so + (kfo0 ^ ((q >> 1) << 5)) + (q & 1) * 4096);
                    }
                    __builtin_amdgcn_sched_barrier(0);
#pragma unroll
                    for (int n = 0; n < 2; ++n) {
                        const f32x16& acc = n ? acc1 : acc0;
                        float part[4];
#pragma unroll
                        for (int g = 0; g < 4; ++g) {
                            float s = wv[g][0] * relu1(acc[4 * g]);
                            s = __builtin_fmaf(wv[g][1], relu1(acc[4 * g + 1]), s);
                            s = __builtin_fmaf(wv[g][2], relu1(acc[4 * g + 2]), s);
                            s = __builtin_fmaf(wv[g][3], relu1(acc[4 * g + 3]), s);
                            part[g] = s;
                        }
#pragma unroll
                        for (int pr = 0; pr < 2; ++pr) {
                            auto rr = __builtin_amdgcn_permlane32_swap(__float_as_uint(part[2 * pr]), __float_as_uint(part[2 * pr + 1]), false, false);
                            const float v = __uint_as_float(rr[0]) + __uint_as_float(rr[1]);
                            const int urel = t0 + 4 * wid + 2 * pr - 64 * j - 32 * n;
                            KEY(j, n, pr) = (lanev <= urel) ? v : __builtin_nanf("");
                        }
                    }
                    if (u == 1) __syncthreads();
                }
            }
        }
        __syncthreads();
    }
    int tidL = tid; asm volatile("" : "+v"(tidL));
    const int lane3 = tidL & 63, r32c = lane3 & 31, hic = lane3 >> 5;
    const long tq_row3 = rowbase + t0 + 4 * wid + (r32c >> 3);
    bf16x8 qr[4];
#pragma unroll
    for (int d0 = 0; d0 < 4; ++d0) qr[d0] = *(const bf16x8*)(T.Q + tq_row3 * 512 + (r32c & 7) * 64 + d0 * 16 + hic * 8);
    u32x4 sk = tile_ld(T.K, rowbase + 64 * (NT - 1), tidL), sv = tile_ld(T.V, rowbase + 64 * (NT - 1), tidL);
    u32x4 sk2 = tile_ld(T.K, rowbase + 64 * (NT > 1 ? NT - 2 : 0), tidL), sv2 = tile_ld(T.V, rowbase + 64 * (NT > 1 ? NT - 2 : 0), tidL);
    u32x4 skA = tile_ld(T.K, rowbase + 64 * (NT > 2 ? NT - 3 : 0), tidL), svA = tile_ld(T.V, rowbase + 64 * (NT > 2 ? NT - 3 : 0), tidL);
    u32x4 skB = tile_ld(T.K, rowbase + 64 * (NT > 3 ? NT - 4 : 0), tidL), svB = tile_ld(T.V, rowbase + 64 * (NT > 3 ? NT - 4 : 0), tidL);
    ALAS unsigned* bm = (ALAS unsigned*)(lds + LBM) + wid * 256;
#pragma unroll 1
    for (int rep_s = 0; rep_s < REP_SEL; ++rep_s) {
        float Tk[2], lo[2], hi2[2], fl[2], fh[2]; bool done[2], conv[2], strad[2]; int nq[2], side[2];
#pragma unroll
        for (int pr = 0; pr < 2; ++pr) {
            nq[pr] = t0 + 4 * wid + 2 * pr + hi + 1;
            Tk[pr] = -__builtin_inff(); done[pr] = (nq[pr] <= 256); conv[pr] = done[pr]; lo[pr] = 0.f; hi2[pr] = 0.f; strad[pr] = false;
            fl[pr] = __builtin_amdgcn_logf((float)nq[pr]) - 8.0028150f; fh[pr] = -9.0028150f; side[pr] = 0;
        }
        if (!__all(done[0] && done[1])) {
#pragma unroll
            for (int pr = 0; pr < 2; ++pr) {
                float vmax = -__builtin_inff(), vmin = __builtin_inff();
#pragma unroll
                for (int jg = 0; jg < 8; ++jg) if (4 * jg < NT) {
#pragma unroll
                    for (int q = 0; q < 4; ++q)
#pragma unroll
                        for (int n = 0; n < 2; ++n) { vmax = __builtin_fmaxf(vmax, KEY(4 * jg + q, n, pr)); vmin = __builtin_fminf(vmin, KEY(4 * jg + q, n, pr)); }
                }
                lo[pr] = half_min(vmin); float h = half_max(vmax);
                { const int hb = __float_as_int(h); h = (h == 0.f) ? 1.4e-45f : __int_as_float(hb + (hb >= 0 ? 1 : -1)); }
                hi2[pr] = h;
                strad[pr] = (lo[pr] < 0.f) & (h > 0.f);
            }
#pragma unroll 1
            for (int it = 0; it < 96; ++it) {
                float mid[2];
#pragma unroll
                for (int pr = 0; pr < 2; ++pr) {
                    float m = lo[pr] + (hi2[pr] - lo[pr]) * (fl[pr] * __builtin_amdgcn_rcpf(fl[pr] - fh[pr]));
                    const float mb = 0.5f * lo[pr] + 0.5f * hi2[pr];
                    const bool in1 = (m > lo[pr]) & (m < hi2[pr]);
                    m = ((it >= 14) | !in1) ? mb : m;
                    if (it == 0) m = strad[pr] ? ((hi2[pr] > 1.4e-45f) ? 1.4e-45f : 0.f) : m;
                    if (it == 1) m = (strad[pr] & (hi2[pr] == 1.4e-45f) & (lo[pr] < 0.f)) ? 0.f : m;
                    const bool in2 = (m > lo[pr]) & (m < hi2[pr]);
                    conv[pr] = conv[pr] | !in2 | done[pr];
                    mid[pr] = m;
                }
                if (__all(conv[0] & conv[1])) break;
                int c0a = 0, c0b = 0, c1a = 0, c1b = 0;
#pragma unroll
                for (int jg = 0; jg < 8; ++jg) if (4 * jg < NT) {
                    cnt4(c0a, c0b, KEY(4 * jg, 0, 0), KEY(4 * jg, 1, 0), KEY(4 * jg + 1, 0, 0), KEY(4 * jg + 1, 1, 0), mid[0]);
                    cnt4(c1a, c1b, KEY(4 * jg, 0, 1), KEY(4 * jg, 1, 1), KEY(4 * jg + 1, 0, 1), KEY(4 * jg + 1, 1, 1), mid[1]);
                    cnt4(c0a, c0b, KEY(4 * jg + 2, 0, 0), KEY(4 * jg + 2, 1, 0), KEY(4 * jg + 3, 0, 0), KEY(4 * jg + 3, 1, 0), mid[0]);
                    cnt4(c1a, c1b, KEY(4 * jg + 2, 0, 1), KEY(4 * jg + 2, 1, 1), KEY(4 * jg + 3, 0, 1), KEY(4 * jg + 3, 1, 1), mid[1]);
                }
                int c[2]; c[0] = half_sum(c0a + c0b); c[1] = half_sum(c1a + c1b);
#pragma unroll
                for (int pr = 0; pr < 2; ++pr) {
                    const bool ge = (c[pr] >= 256), ul = !conv[pr] & ge, uh = !conv[pr] & !ge;
                    const float fc = __builtin_amdgcn_logf((float)c[pr] + (ge ? 0.f : 0.5f)) - 8.0028150f;
                    const float fhn = ul ? ((side[pr] > 0) ? 0.5f * fh[pr] : fh[pr]) : (uh ? fc : fh[pr]), fln = uh ? ((side[pr] < 0) ? 0.5f * fl[pr] : fl[pr]) : (ul ? fc : fl[pr]);
                    fh[pr] = fhn; fl[pr] = fln; side[pr] = ul ? 1 : (uh ? -1 : side[pr]);
                    lo[pr] = ul ? mid[pr] : lo[pr]; hi2[pr] = uh ? mid[pr] : hi2[pr]; done[pr] = done[pr] | (ul & (c[pr] == 256));
                }
            }
#pragma unroll
            for (int pr = 0; pr < 2; ++pr) { Tk[pr] = lo[pr]; if (nq[pr] <= 256) { Tk[pr] = -__builtin_inff(); done[pr] = true; } }
        }
#pragma unroll
        for (int pr = 0; pr < 2; ++pr) {
        if (__all(done[pr])) {
#pragma unroll
            for (int jh = 0; jh < 2; ++jh) if (16 * jh < NT) {
                unsigned wx = 0u;
#pragma unroll
                for (int j = 16 * jh; j < 16 * jh + 16; ++j) if (j < NT) {
#pragma unroll
                    for (int n = 0; n < 2; ++n) {
                        const unsigned long long pb = __ballot(KEY(j, n, pr) >= Tk[pr]);
                        asm volatile("s_nop 1\n\tv_writelane_b32 %0, %1, %3\n\tv_writelane_b32 %0, %2, %4" : "+v"(wx) : "s"((unsigned)pb), "s"((unsigned)(pb >> 32)), "i"(2 * (j & 15) + n), "i"(32 + 2 * (j & 15) + n));
                    }
                }
                bm[(32 * jh + r32) * 4 + 2 * pr + hi] = wx;
            }
        } else {
        int gt = 0;
#pragma unroll
        for (int j = 0; j < 32; ++j) if (j < NT) { gt += (KEY(j, 0, pr) > Tk[pr]) ? 1 : 0; gt += (KEY(j, 1, pr) > Tk[pr]) ? 1 : 0; }
        gt = half_sum(gt);
        const int need = 256 - gt; int seen = 0;
#pragma unroll
        for (int j = 0; j < 32; ++j) if (j < NT) {
#pragma unroll
            for (int n = 0; n < 2; ++n) {
                const float k = KEY(j, n, pr); const bool eq = (k == Tk[pr]);
                const unsigned long long bal = __ballot(eq);
                const unsigned mine = hi ? (unsigned)(bal >> 32) : (unsigned)bal;
                const int before = __popc(mine & ((1u << r32) - 1u));
                const bool pick = (k > Tk[pr]) || (eq && (seen + before < need));
                const unsigned long long pb = __ballot(pick);
                if (r32 == 0) bm[(2 * j + n) * 4 + 2 * pr + hi] = hi ? (unsigned)(pb >> 32) : (unsigned)pb;
                seen += __popc(mine);
            }
        }
        }
        }
    }
    const int laneA = mk_lane() & 63, r32a = laneA & 31, hia = laneA >> 5, tidA = wid * 64 + laneA;
    const int h_c = r32a & 7, g_c = r32a >> 3;
    bf16x8 qx;
    {
        const float c1 = bf_round(LOG2E), c2 = bf_round(LOG2E - c1), c3 = bf_round((LOG2E - c1) - c2), sc = __builtin_amdgcn_exp2f(-(float)(h_c + 1));
        const unsigned a1 = __float_as_uint(c1 * sc) >> 16, a2 = __float_as_uint(c2 * sc) >> 16, a3 = __float_as_uint(c3 * sc) >> 16, one = 0x3F80u;
        u32x4 w;
        w.x = hia ? ((g_c == 0 ? one : 0u) | ((g_c == 1 ? one : 0u) << 16)) : (a1 | (a2 << 16));
        w.y = hia ? ((g_c == 2 ? one : 0u) | ((g_c == 3 ? one : 0u) << 16)) : (a3 | (a1 << 16));
        w.z = hia ? 0u : (a2 | (a3 << 16)); w.w = 0u;
        qx = __builtin_bit_cast(bf16x8, w);
    }
    unsigned spk[2];
#pragma unroll
    for (int n = 0; n < 2; ++n) { const unsigned s = __float_as_uint((float)(32 * n + r32a)) >> 16; spk[n] = s | (s << 16); }
    const unsigned hmc = 0u - (unsigned)hia; unsigned spkz[2];
#pragma unroll
    for (int n = 0; n < 2; ++n) spkz[n] = (spk[n] & ~hmc) | (0x3F803F80u & hmc);
    const unsigned kww = 0x3F80u & hmc;
    const unsigned nhm = ~hmc, Klo = hmc & 0x0000C680u, Khi = hmc & 0xC6800000u;
    unsigned spkh0[2];
#pragma unroll
    for (int n = 0; n < 2; ++n) spkh0[n] = spk[n] & 0xffff0000u & nhm;
    ALAS float* wsf = (ALAS float*)(lds + LWS) + wid * 64;
    const ALAS u32x4* bmw = (const ALAS u32x4*)((ALAS unsigned*)(lds + LBM) + wid * 256);
    float mhat = 0.f; f32x16 o[2]; o[0] = f32x16{}; o[1] = f32x16{};
    const bool fastok = (T.qk2 < 100.f); bool need = true;
    f32x16 ol = f32x16{};
    const bf16x8 ones8 = __builtin_bit_cast(bf16x8, (u32x4){0x3F803F80u, 0x3F803F80u, 0x3F803F80u, 0x3F803F80u});
#pragma unroll 1
    for (int rep_a = 0; rep_a < REP_ATT; ++rep_a) {
        mhat = 0.f; ol = f32x16{}; o[0] = f32x16{}; o[1] = f32x16{}; need = true;
        kimg_st(lds, 0, tidA, sk); vimg_st(lds, 0, tidA, sv);
        if (NT > 1) { kimg_st(lds, 1, tidA, sk2); vimg_st(lds, 1, tidA, sv2); }
        __syncthreads();
#pragma unroll 1
        for (int jb = 0; jb < NT; jb += 2) {
#pragma unroll
          for (int u = 0; u < 2; ++u) {
            const int jj = jb + u;
            if (u == 0 || jj < NT) {
            const int j = NT - 1 - jj, slot = jj & 3;
            if (u == 0) {
                if (jj + 2 < NT) { kimg_st(lds, (jj + 2) & 3, tidA, skA); vimg_st(lds, (jj + 2) & 3, tidA, svA); }
                if (jj + 3 < NT) { kimg_st(lds, (jj + 3) & 3, tidA, skB); vimg_st(lds, (jj + 3) & 3, tidA, svB); }
                int tl = tidA; asm volatile("" : "+v"(tl));
                if (jj + 4 < NT) { skA = tile_ld(T.K, rowbase + 64 * (j - 4), tl); svA = tile_ld(T.V, rowbase + 64 * (j - 4), tl); }
                if (jj + 5 < NT) { skB = tile_ld(T.K, rowbase + 64 * (j - 5), tl); svB = tile_ld(T.V, rowbase + 64 * (j - 5), tl); }
            }
            const unsigned pp = __float_as_uint((float)(-64 * jj)) >> 16, ppk = pp | (pp << 16);
            const unsigned ppk0 = ppk & nhm, pp0 = pp & nhm;
            bf16x8 kx[2];
#pragma unroll
            for (int n = 0; n < 2; ++n) {
                const u32x4 W = bmw[2 * j + n];
                const unsigned m0 = (unsigned)__builtin_amdgcn_sbfe((int)W.x, (unsigned)r32a, 1u), m1 = (unsigned)__builtin_amdgcn_sbfe((int)W.y, (unsigned)r32a, 1u);
                const unsigned m2 = (unsigned)__builtin_amdgcn_sbfe((int)W.z, (unsigned)r32a, 1u), m3 = (unsigned)__builtin_amdgcn_sbfe((int)W.w, (unsigned)r32a, 1u);
                u32x4 w;
                w.x = (~m1 & Khi) | ((~m0 & Klo) | ppk0); w.y = (~m3 & Khi) | ((~m2 & Klo) | (pp0 | spkh0[n])); w.z = spkz[n]; w.w = kww;
                kx[n] = __builtin_bit_cast(bf16x8, w);
            }
            f32x16 p0 = f32x16{}, p1 = f32x16{};
#pragma unroll
            for (int d0 = 0; d0 < 4; ++d0) {
                const bf16x8 k0 = *(const ALAS bf16x8*)(lds + LK + slot * 8192 + kfrag_off(r32a, hia, d0));
                const bf16x8 k1 = *(const ALAS bf16x8*)(lds + LK + slot * 8192 + kfrag_off(r32a, hia, d0) + 4096);
                p0 = __builtin_amdgcn_mfma_f32_32x32x16_bf16(k0, qr[d0], p0, 0, 0, 0);
                p1 = __builtin_amdgcn_mfma_f32_32x32x16_bf16(k1, qr[d0], p1, 0, 0, 0);
            }
            p0 = __builtin_amdgcn_mfma_f32_32x32x16_bf16(kx[0], qx, p0, 0, 0, 0);
            p1 = __builtin_amdgcn_mfma_f32_32x32x16_bf16(kx[1], qx, p1, 0, 0, 0);
            if (need) {
            const float rm = rowmax(p0, p1);
            const bool first = (jj == 0);
            const float dl = first ? __builtin_fmaxf(rm, -2048.f) : (rm > THR ? rm : 0.f);
            if (first || __any(dl != 0.f)) {
                const float f = first ? 1.f : __builtin_amdgcn_exp2f(-dl);
                mhat += dl;
#pragma unroll
                for (int r = 0; r < 16; ++r) { p0[r] -= dl; p1[r] -= dl; }
                { const unsigned x0 = __float_as_uint(-mhat), t1 = x0 & 0xffff0000u; const float r1 = __uint_as_float(x0) - __uint_as_float(t1); const unsigned t2 = __float_as_uint(r1) & 0xffff0000u;
                  const float r2 = r1 - __uint_as_float(t2); const unsigned t3 = __float_as_uint(r2) & 0xffff0000u;
                  u32x4 w = __builtin_bit_cast(u32x4, qx); w.z = hia ? ((t1 >> 16) | t2) : w.z; w.w = hia ? (t3 >> 16) : w.w; qx = __builtin_bit_cast(bf16x8, w); }
                if (hia == 0) wsf[r32a] = f;
                asm volatile("s_waitcnt lgkmcnt(0)" ::: "memory");
#pragma unroll
                for (int r = 0; r < 16; ++r) { const float fr_ = wsf[crow(r, hia)]; o[0][r] *= fr_; o[1][r] *= fr_; ol[r] *= fr_; }
            }
            need = !fastok || __any(mhat <= -2047.f);
            }
            const lptr vb = lds + LV + slot * VSLOT + ((laneA >> 4) & 1) * 32 + (laneA & 3) * 8 + (4 * hia + ((laneA & 15) >> 2)) * 64;
#pragma unroll
            for (int half = 0; half < 2; ++half) {
                f32x16& ph = half ? p1 : p0;
#pragma unroll
                for (int r = 0; r < 16; ++r) ph[r] = __builtin_amdgcn_exp2f(ph[r]);
                u32x4 pw[2];
#pragma unroll
                for (int q = 0; q < 4; ++q) { pw[0][q] = cvtpk_s(ph[2 * q], ph[2 * q + 1]); pw[1][q] = cvtpk_s(ph[8 + 2 * q], ph[8 + 2 * q + 1]); }
#pragma unroll
                for (int kk = 0; kk < 2; ++kk) {
                    const int ks = 2 * half + kk;
#pragma unroll
                    for (int d0 = 0; d0 < 2; ++d0) {
                        const s16x4 lo = vtr(vb + d0 * VDH + ks * 1024), hh = vtr(vb + d0 * VDH + ks * 1024 + 512);
                        const bf16x8 vf = (bf16x8){lo[0], lo[1], lo[2], lo[3], hh[0], hh[1], hh[2], hh[3]};
                        o[d0] = __builtin_amdgcn_mfma_f32_32x32x16_bf16(__builtin_bit_cast(bf16x8, pw[kk]), vf, o[d0], 0, 0, 0);
                    }
                    ol = __builtin_amdgcn_mfma_f32_32x32x16_bf16(__builtin_bit_cast(bf16x8, pw[kk]), ones8, ol, 0, 0, 0);
                }
                if (half == 0) __builtin_amdgcn_sched_barrier(0);
            }
            if (u == 1) __syncthreads();
            }
          }
        }
        __syncthreads();
    }
    unit_prefetch(pf, has_next ? nb : b, has_next ? nqb : qb, T, wave_s, lds, has_next);
    ALAS unsigned char* stg = lds + LOST + wid * 4096;
#pragma unroll
    for (int r = 0; r < 16; ++r) {
        const int orow = crow(r, hia); const float rl = __builtin_amdgcn_rcpf(ol[r]);
#pragma unroll
        for (int d0 = 0; d0 < 2; ++d0) { const float ov = o[d0][r] * rl; stg[orow * 64 + d0 * 32 + r32a] = (unsigned char)(__builtin_amdgcn_cvt_pk_fp8_f32(ov, ov, 0u, false) & 0xffu); }
    }
    asm volatile("s_waitcnt lgkmcnt(0)" ::: "memory");
    int laneE = laneA; asm volatile("" : "+v"(laneE));
#pragma unroll
    for (int i = 0; i < 2; ++i) {
        const int row = i * 16 + (laneE >> 2), ch = laneE & 3;
        const u32x4 v = *(const ALAS u32x4*)(stg + row * 64 + ch * 16);
        *(u32x4*)(T.AP + (rowbase + t0 + 4 * wid + (row >> 3)) * 1024 + (row & 7) * 64 + ch * 16) = v;
    }
    __syncthreads();
}
#undef KEY
#undef MX3
}

constexpr int NWAVES = 8;
constexpr int D = 1024, NB = 16, SEQ = 2048, TOK = NB * SEQ, FF = 2816, DIN = 3784, N1 = 3840, N5 = 5632;
constexpr int OQ = 0, OKK = 512, OV = 576, OQI = 640, OKI = 1152, OWI = 1216, OU = 1224, OG = 1736;
constexpr float EPS = 1e-6f;
constexpr size_t MiB = 1u << 20;
constexpr size_t WS_CTL = 0, CTL_ZERO_BYTES = 64 * 1024;
constexpr size_t WS_W1T = 2 * MiB, WS_W3T = 10 * MiB, WS_W4T = 12 * MiB, WS_W5T = 14 * MiB, WS_W6T = 26 * MiB, WS_WP = 32 * MiB;
constexpr size_t WS_RSTD = 34 * MiB, WS_WI = 35 * MiB, WS_SSQ = 36 * MiB, WS_K = 38 * MiB, WS_V = 42 * MiB, WS_KI = 46 * MiB;
constexpr size_t WS_R = 52 * MiB, WS_SP = 116 * MiB, WS_AP = 180 * MiB, WS_XB = 244 * MiB, WS_Q = 308 * MiB, WS_QI = 340 * MiB, WS_U = 372 * MiB, WS_H2 = 436 * MiB, WS_END = 500 * MiB;
constexpr size_t WS_MG = WS_U;
constexpr size_t WS_ACT = WS_R;
constexpr size_t WS_XF8 = WS_AP;
constexpr size_t WS_W1T8 = WS_W1T + 4 * MiB;
constexpr size_t WS_H2F8 = WS_AP;
static_assert(WS_ACT + (size_t)TOK * 4096 <= WS_AP, "act overlay");
constexpr int CW_BAR = 1024;
constexpr int RING_BYTES = 131072, LDSCTL_OFF = RING_BYTES, MISC_OFF = LDSCTL_OFF + 320, LDS_BYTES = 147456;
static_assert(att::LBYTES <= RING_BYTES, "attention scratch inside the ring region");

#define LAS __attribute__((address_space(3)))
#define GAS __attribute__((address_space(1)))
typedef unsigned short bf16;
typedef unsigned v4u __attribute__((ext_vector_type(4)));
typedef float f32x4 __attribute__((ext_vector_type(4)));
#define LDS_WAIT() asm volatile("s_waitcnt lgkmcnt(0)" ::: "memory")
__device__ __forceinline__ unsigned pk2(float lo, float hi) { return pg8::cvt_pk_bf16(lo, hi); }
__device__ __forceinline__ float wave_sum(float v) {
#pragma unroll
    for (int o = 1; o < 64; o <<= 1) v += __shfl_xor(v, o);
    return v;
}

#define XB_TMO      128
#define XB_XCNT(j)  (256  + 64 * (j))
#define XB_XSUB(j)  (1280 + 64 * (j))
#define XB_XGEN(j)  (2304 + 64 * (j))
#define XB_TOP      3328
#define XB_TOPGEN   3392
#define XCD_BAR_WORDS 3456
#define XB_GM(g)    (3520 + 64 * (g))
#define XB_SPIN_CAP (1u << 18)

__device__ __forceinline__ unsigned xb_ld(unsigned* p)              { return __hip_atomic_load(p, __ATOMIC_RELAXED, __HIP_MEMORY_SCOPE_AGENT); }
__device__ __forceinline__ unsigned xb_add(unsigned* p, unsigned v) { return __hip_atomic_fetch_add(p, v, __ATOMIC_RELAXED, __HIP_MEMORY_SCOPE_AGENT); }
__device__ __forceinline__ unsigned xb_xcc_id() { return (unsigned)__builtin_amdgcn_s_getreg((3 << 11) | 20) & 0xFu; }
#define XB_SPIN(cond, bar) do { unsigned _sp = 0; while (cond) { __builtin_amdgcn_s_sleep(1); \
    if ((++_sp & 255u) == 0u) { if (xb_ld(&(bar)[XB_TMO])) break; if (_sp > XB_SPIN_CAP) { atomicAdd(&(bar)[XB_TMO], 1u); break; } } } } while (0)

struct XcdBarrier {
    unsigned* bar; unsigned x;
    int lead;
    volatile LAS unsigned* st;
};

__device__ __forceinline__ XcdBarrier xcd_barrier_post(unsigned* bar, volatile LAS unsigned* st, const int wave_s) {
    XcdBarrier b; b.bar = bar; b.x = xb_xcc_id(); b.st = st; b.lead = (wave_s == 0) ? 1 : 0;
    if (b.lead && mk_lane() == 0) { (void)__hip_atomic_fetch_or(&bar[XB_GM(blockIdx.x & 7u)], 1u << b.x, __ATOMIC_RELAXED, __HIP_MEMORY_SCOPE_AGENT); (void)xb_add(&bar[XB_XCNT(b.x)], 1u); }
    return b;
}
__device__ __forceinline__ void xcd_barrier_complete(unsigned* bar, unsigned x, unsigned& nloc, unsigned& nx) {
    const unsigned G = gridDim.x * gridDim.y * gridDim.z;
    unsigned sum, cnt, mine, sp = 0u;
    for (;;) {
        sum = 0u; cnt = 0u; mine = 0u;
#pragma unroll
        for (unsigned j = 0; j < 16; ++j) { const unsigned c = xb_ld(&bar[XB_XCNT(j)]); sum += c; cnt += (c > 0u) ? 1u : 0u; mine = (j == x) ? c : mine; }
        if (sum == G) break;
        __builtin_amdgcn_s_sleep(1);
        if ((++sp & 255u) == 0u) { if (xb_ld(&bar[XB_TMO])) break; if (sp > XB_SPIN_CAP) { atomicAdd(&bar[XB_TMO], 1u); break; } }
    }
    nloc = mine > 0u ? mine : 1u; nx = cnt > 0u ? cnt : 1u;
}

__device__ __forceinline__ void xcd_barrier(const XcdBarrier& b, const bool want_local) {
    asm volatile("s_waitcnt vmcnt(0)" ::: "memory");
    __syncthreads();
    if (b.lead && mk_lane() == 0) {
        unsigned* bar = b.bar;
        __builtin_amdgcn_s_waitcnt(0);
        unsigned nloc = b.st[0], nx = b.st[1];
        if (nloc == 0u) { xcd_barrier_complete(bar, b.x, nloc, nx); b.st[0] = nloc; b.st[1] = nx; }
        const unsigned old = xb_add(&bar[XB_XSUB(b.x)], 1u);
        const unsigned gen = old / nloc;
        const bool local = want_local && (b.st[2] == 1u);
        if (old + 1u == (gen + 1u) * nloc && local) {
            __builtin_amdgcn_fence(__ATOMIC_ACQUIRE, "agent");
            xb_add(&bar[XB_XGEN(b.x)], 1u);
            asm volatile("s_waitcnt vmcnt(0)" ::: "memory");
        } else if (old + 1u == (gen + 1u) * nloc) {
            __builtin_amdgcn_fence(__ATOMIC_RELEASE, "agent");
            asm volatile("s_waitcnt vmcnt(0)" ::: "memory");
            const unsigned og = xb_add(&bar[XB_TOP], 1u);
            const unsigned tg = og / nx;
            if (og + 1u == (tg + 1u) * nx) xb_add(&bar[XB_TOPGEN], 1u);
            else XB_SPIN(xb_ld(&bar[XB_TOPGEN]) == tg, bar);
            __builtin_amdgcn_fence(__ATOMIC_ACQUIRE, "agent");
            xb_add(&bar[XB_XGEN(b.x)], 1u);
            asm volatile("s_waitcnt vmcnt(0)" ::: "memory");
        } else {
            XB_SPIN(xb_ld(&bar[XB_XGEN(b.x)]) == gen, bar);
            __builtin_amdgcn_fence(__ATOMIC_ACQUIRE, "agent");
            asm volatile("s_waitcnt vmcnt(0)" ::: "memory");
        }
        if (b.st[2] == 0u) {
            unsigned all = 0u; bool ok = (gridDim.x == 256u);
#pragma unroll
            for (unsigned g = 0; g < 8; ++g) { const unsigned m = xb_ld(&bar[XB_GM(g)]); ok = ok && (m != 0u) && ((m & (m - 1u)) == 0u) && ((all & m) == 0u); all |= m; }
            b.st[2] = ok ? 1u : 2u;
        }
    }
    __syncthreads();
}

struct Args { const float* in[14]; float* out; unsigned char* ws; int ph_lo, ph_hi; };

template <int FMT>
__device__ __forceinline__ void tr_item(const float* W, int ldw, int k0, int c0, int nvalid, const float* gain, float scale, void* WTv, int ldt, int drow0, int dk0, LAS float* scr, int lane) {
    const int j = lane & 31;
    float tv[32];
#pragma unroll
    for (int i = 0; i < 32; ++i) { const int kk = 2 * i + (lane >> 5); tv[i] = (j < nvalid) ? W[(size_t)(k0 + kk) * ldw + c0 + j] : 0.f; }
#pragma unroll
    for (int i = 0; i < 32; ++i) { const int kk = 2 * i + (lane >> 5); float v = tv[i] * scale; if (gain) v *= gain[k0 + kk]; scr[kk * 33 + j] = v; }
    LDS_WAIT(); asm volatile("" ::: "memory");
    if (FMT == 2) {
        unsigned char* WT = (unsigned char*)WTv; const int c = lane & 3;
#pragma unroll
        for (int jj = 0; jj < 2; ++jj) { const int n = (lane >> 2) + 16 * jj; const LAS float* s = scr + (16 * c) * 33 + n;
            v4u o; o.x = pg8::pk4_fp8(s[0 * 33], s[1 * 33], s[2 * 33], s[3 * 33]); o.y = pg8::pk4_fp8(s[4 * 33], s[5 * 33], s[6 * 33], s[7 * 33]);
            o.z = pg8::pk4_fp8(s[8 * 33], s[9 * 33], s[10 * 33], s[11 * 33]); o.w = pg8::pk4_fp8(s[12 * 33], s[13 * 33], s[14 * 33], s[15 * 33]);
            *(v4u*)(WT + (size_t)(drow0 + n) * ldt + dk0 + k0 + 16 * c) = o; }
    } else {
        bf16* WT = (bf16*)WTv; const int c = lane & 7;
#pragma unroll
        for (int jj = 0; jj < 4; ++jj) { const int n = (lane >> 3) + 8 * jj; const LAS float* s = scr + (8 * c) * 33 + n;
            v4u o;
            if (FMT == 1) { o.x = pg8::cvt_pk_f16(s[0 * 33], s[1 * 33]); o.y = pg8::cvt_pk_f16(s[2 * 33], s[3 * 33]); o.z = pg8::cvt_pk_f16(s[4 * 33], s[5 * 33]); o.w = pg8::cvt_pk_f16(s[6 * 33], s[7 * 33]); }
            else { o.x = pk2(s[0 * 33], s[1 * 33]); o.y = pk2(s[2 * 33], s[3 * 33]); o.z = pk2(s[4 * 33], s[5 * 33]); o.w = pk2(s[6 * 33], s[7 * 33]); }
            *(v4u*)(WT + (size_t)(drow0 + n) * ldt + dk0 + k0 + 8 * c) = o; }
    }
    LDS_WAIT(); asm volatile("" ::: "memory");
}
__device__ __forceinline__ void w1_map(int rg, int& c0, int& nvalid) {
    const int n0 = rg * 32, pn = n0 >> 8, c = n0 & 255, bj = c >> 7, wc = (c & 127) >> 5; nvalid = 32;
    if (pn < 2) c0 = OQ + (pn * 4 + wc) * 64 + 32 * bj;
    else if (pn == 2) { if (wc == 0) c0 = OKK + 32 * bj; else if (wc == 1) c0 = OV + 32 * bj; else if (wc == 2) c0 = OKI + 32 * bj; else { c0 = OWI; nvalid = bj == 0 ? 8 : 0; } }
    else if (pn < 5) c0 = OQI + ((pn - 3) * 4 + wc) * 64 + 32 * bj;
    else if (pn < 7) c0 = OU + (pn - 5) * 256 + c;
    else c0 = OG + bj * 1024 + (pn - 7) * 128 + (c & 127);
}

__device__ __forceinline__ unsigned unit_tab(int s) {
    unsigned r = 0x0c132c2fu;
    r = (s == 1) ? 0x031d293au : r;
    r = (s == 2) ? 0x0e1c2628u : r;
    r = (s == 3) ? 0x12212224u : r;
    r = (s == 4) ? 0x090d2e36u : r;
    r = (s == 5) ? 0x041e2b35u : r;
    r = (s == 6) ? 0x0b10253bu : r;
    r = (s == 7) ? 0x14161f30u : r;
    r = (s == 8) ? 0x07202338u : r;
    r = (s == 9) ? 0x02173139u : r;
    r = (s == 10) ? 0x08191b3eu : r;
    r = (s == 11) ? 0x0111333fu : r;
    r = (s == 12) ? 0x00183237u : r;
    r = (s == 13) ? 0x060a343du : r;
    r = (s == 14) ? 0x0f1a272au : r;
    r = (s == 15) ? 0x05152d3cu : r;
    return r;
}

template <int W>
__device__ __forceinline__ void pool_win(const bf16* Ub, unsigned char* AP, int tb, int tin, int c0) {
    v4u rows[W + 15];
#pragma unroll
    for (int r = 0; r < W + 15; ++r) { const int rel = r - (W - 1); rows[r] = (tin + rel >= 0) ? *(const v4u*)(Ub + (size_t)(tb + rel) * 512 + c0) : (v4u){0u, 0u, 0u, 0u}; }
    float sum[8];
#pragma unroll
    for (int e = 0; e < 8; ++e) sum[e] = 0.f;
#pragma unroll
    for (int r = 0; r < W - 1; ++r) { f32x4 a, b_; pg8::unpack8(rows[r], a, b_);
#pragma unroll
        for (int e = 0; e < 4; ++e) { sum[e] += a[e]; sum[4 + e] += b_[e]; } }
#pragma unroll
    for (int tt = 0; tt < 16; ++tt) {
        const int t = tin + tt; f32x4 a, b_; pg8::unpack8(rows[W - 1 + tt], a, b_);
#pragma unroll
        for (int e = 0; e < 4; ++e) { sum[e] += a[e]; sum[4 + e] += b_[e]; }
        if (tt > 0) { f32x4 a2, b2; pg8::unpack8(rows[tt - 1], a2, b2);
#pragma unroll
            for (int e = 0; e < 4; ++e) { sum[e] -= a2[e]; sum[4 + e] -= b2[e]; } }
        const float inv = 1.0f / (float)((t + 1 < W) ? t + 1 : W);
        f32x4 d0, d1;
#pragma unroll
        for (int e = 0; e < 4; ++e) { d0[e] = sum[e] * inv - a[e]; d1[e] = sum[4 + e] * inv - b_[e]; }
        *(unsigned long long*)(AP + (size_t)(tb + tt) * 1024 + 512 + c0) = pg8::pack8_fp8(d0, d1);
    }
}

__global__ void __launch_bounds__(NWAVES * 64, 2) mk_fwd(Args args) {
    extern __shared__ __attribute__((aligned(16))) unsigned char lds_raw[];
    LAS unsigned char* lds = (LAS unsigned char*)lds_raw;
    volatile LAS unsigned* MISC = (volatile LAS unsigned*)(lds + MISC_OFF);
    const int wave = __builtin_amdgcn_readfirstlane(threadIdx.x >> 6);
    const int G = gridDim.x; const int bx = blockIdx.x; const int vcu = (G % 8 == 0) ? (bx % 8) * (G / 8) + bx / 8 : bx;
    unsigned char* ws = args.ws;
    for (int u = wave * 64 + mk_lane(); u < (LDS_BYTES - LDSCTL_OFF) / 4; u += NWAVES * 64) ((LAS unsigned*)(lds + LDSCTL_OFF))[u] = 0u;
    __syncthreads();
    XcdBarrier bar; bar.bar = (unsigned*)(ws + WS_CTL) + CW_BAR; bar.x = 0; bar.st = nullptr; bar.lead = 0;
    if (!MK_PER_PHASE) bar = xcd_barrier_post((unsigned*)(ws + WS_CTL) + CW_BAR, MISC + 8, wave);
#define GRID_BAR() do { if (!MK_PER_PHASE) xcd_barrier(bar, false); } while (0)
#define GRID_BAR_L() do { if (!MK_PER_PHASE) xcd_barrier(bar, true); } while (0)
    const int lo = args.ph_lo, hi_ = args.ph_hi;
#define IN(k) (lo <= (k) && (k) < hi_)
#define BOTH(k) (IN(k) && IN((k) + 1))
    const int gw = vcu * NWAVES + wave, NGW = G * NWAVES;

    if (IN(0)) {
        const float* x = args.in[0]; const float* norm_mix = args.in[1]; const float* w_in = args.in[2]; const float* w_pg = args.in[5]; const float* pool_scale = args.in[6];
        const float* w_ba = args.in[7]; const float* w_bp = args.in[8]; const float* w_out = args.in[9]; const float* norm_ffn = args.in[10]; const float* w_g = args.in[11]; const float* w_u = args.in[12]; const float* w_d = args.in[13];
        bf16* W1T = (bf16*)(ws + WS_W1T); unsigned char* W3T = ws + WS_W3T; unsigned char* W4T = ws + WS_W4T; unsigned char* W5T = ws + WS_W5T; unsigned char* W6T = ws + WS_W6T;
        float* RSTD = (float*)(ws + WS_RSTD); bf16* XB = (bf16*)(ws + WS_XB); unsigned char* W1T8 = ws + WS_W1T8; unsigned char* XF8 = ws + WS_XF8;
        const int lane = mk_lane();
        LAS float* scr = (LAS float*)(lds + wave * 16384);
        constexpr int I1 = (N1 / 32) * (D / 64), I3 = (D / 32) * (512 / 64), I4 = (D / 32) * (D / 64), I5 = (N5 / 32) * (D / 64), I6 = (D / 32) * (FF / 64);
        constexpr int NITEMS = I1 + I3 + I4 + I5 + I6;
        for (int it = gw; it < NITEMS; it += NGW) {
            int r = it;
            if (r < I1) { const int rg = r / (D / 64), kb = r % (D / 64); int c0, nv; w1_map(rg, c0, nv); if (rg < 40) tr_item<1>(w_in, DIN, 64 * kb, c0, nv, norm_mix, 1.0f, W1T, D, rg * 32, 0, scr, lane); else tr_item<2>(w_in, DIN, 64 * kb, c0, nv, norm_mix, pg8::K_WSC, W1T8, D, rg * 32 - 1280, 0, scr, lane); continue; } r -= I1;
            if (r < I3) { const int rg = r / 8, kb = r % 8; tr_item<2>(w_ba, D, 64 * kb, rg * 32, 32, nullptr, pg8::K_WSC, W3T, D, rg * 32, 0, scr, lane); continue; } r -= I3;
            if (r < I4) { const int rg = r / 16, kb = r % 16; tr_item<2>(w_out, D, 64 * kb, rg * 32, 32, nullptr, pg8::K_WSC, W4T, D, rg * 32, 0, scr, lane); continue; } r -= I4;
            if (r < I5) { const int rg = r / 16, kb = r % 16; const int n0 = rg * 32, pn = n0 >> 8, c = n0 & 255; const float* src = (c >> 7) ? w_u : w_g;
                          tr_item<MK_FP8 ? 2 : 0>(src, FF, 64 * kb, pn * 128 + (c & 127), 32, norm_ffn, MK_FP8 ? pg8::K_WSC : 1.0f, W5T, D, rg * 32, 0, scr, lane); continue; } r -= I5;
            { const int rg = r / (FF / 64), kb = r % (FF / 64); tr_item<MK_FP8 ? 2 : 0>(w_d, D, 64 * kb, rg * 32, 32, nullptr, MK_FP8 ? pg8::K_WSC : 1.0f, W6T, FF, rg * 32, 0, scr, lane); }
        }
        for (int it = gw; it < 32 * 64; it += NGW) {
            const int i0 = (it >> 6) * 16, n0 = (it & 63) * 16, g = i0 >> 7, nl = lane & 15, q = lane >> 4;
#pragma unroll
            for (int k = 0; k < 8; ++k) { const int e = 4 * (lane + 64 * k), r = e >> 7, j = e & 127;
                const f32x4 a = *(const f32x4*)(w_pg + (size_t)i0 * 128 + e), c = *(const f32x4*)(pool_scale + g * 128 + j);
#pragma unroll
                for (int t = 0; t < 4; ++t) scr[(j + t) * 16 + r] = a[t] * c[t]; }
            float s0 = 0.f, s1 = 0.f, s2 = 0.f, s3 = 0.f;
            const float* bcol = w_bp + (size_t)(g * 128) * D + n0 + nl;
#pragma unroll
            for (int hb = 0; hb < 2; ++hb) {
                float bv[64];
#pragma unroll
                for (int j = 0; j < 64; ++j) bv[j] = bcol[(size_t)(hb * 64 + j) * D];
                LDS_WAIT(); asm volatile("" ::: "memory");
#pragma unroll
                for (int j = 0; j < 64; ++j) { const f32x4 a = *(const LAS f32x4*)(scr + (hb * 64 + j) * 16 + 4 * q);
                    s0 = __builtin_fmaf(a[0], bv[j], s0); s1 = __builtin_fmaf(a[1], bv[j], s1); s2 = __builtin_fmaf(a[2], bv[j], s2); s3 = __builtin_fmaf(a[3], bv[j], s3); }
            }
            LAS unsigned* ob = (LAS unsigned*)(scr + 2048);
            ob[nl * 4 + q] = pg8::pk4_fp8(s0 * pg8::K_WSC, s1 * pg8::K_WSC, s2 * pg8::K_WSC, s3 * pg8::K_WSC);
            LDS_WAIT(); asm volatile("" ::: "memory");
            if (lane < 16) *(v4u*)(W3T + (size_t)(n0 + lane) * D + 512 + i0) = *(const LAS v4u*)(ob + lane * 4);
            LDS_WAIT(); asm volatile("" ::: "memory");
        }
        for (int m0 = gw * 4; m0 < TOK; m0 += NGW * 4) {
            const int m = m0 + (lane >> 4), sub = lane & 15;
            const f32x4* xr = (const f32x4*)(x + (size_t)m * D) + sub; f32x4 v[16]; float s = 0.f;
#pragma unroll
            for (int j = 0; j < 16; ++j) v[j] = xr[16 * j];
#pragma unroll
            for (int j = 0; j < 16; ++j) s += (v[j].x * v[j].x + v[j].y * v[j].y) + (v[j].z * v[j].z + v[j].w * v[j].w);
            s += __shfl_xor(s, 1); s += __shfl_xor(s, 2); s += __shfl_xor(s, 4); s += __shfl_xor(s, 8);
            if (sub == 0) RSTD[m] = 1.0f / sqrtf(s * (1.0f / D) + EPS);
            unsigned long long* o8 = (unsigned long long*)(XB + (size_t)m * D) + sub;
#pragma unroll
            for (int j = 0; j < 16; ++j) o8[16 * j] = (unsigned long long)pg8::cvt_pk_f16(v[j].x, v[j].y) | ((unsigned long long)pg8::cvt_pk_f16(v[j].z, v[j].w) << 32);
            unsigned* o4 = (unsigned*)(XF8 + (size_t)m * D) + sub;
#pragma unroll
            for (int j = 0; j < 16; ++j) o4[16 * j] = pg8::pk4_fp8(v[j].x, v[j].y, v[j].z, v[j].w);
        }
        if (BOTH(0)) GRID_BAR();
    }
    if (IN(1)) {
        const float* q_norm = args.in[3]; const float* k_norm = args.in[4];
        bf16* W1T = (bf16*)(ws + WS_W1T); float* RSTD = (float*)(ws + WS_RSTD); float* WIb = (float*)(ws + WS_WI); bf16* XB = (bf16*)(ws + WS_XB);
        bf16* Kb = (bf16*)(ws + WS_K); bf16* Vb = (bf16*)(ws + WS_V); bf16* KIb = (bf16*)(ws + WS_KI); bf16* Rb = (bf16*)(ws + WS_R); bf16* SPb = (bf16*)(ws + WS_R) + 1024;
        bf16* Qb = (bf16*)(ws + WS_Q); bf16* QIb = (bf16*)(ws + WS_QI); bf16* Ub = (bf16*)(ws + WS_U);
        const bool p1swap = (G == 256) && ((bx & 1) != 0);
#pragma unroll 1
        for (int pass = 0; pass < 2; ++pass) {
            if ((pass == 0) != p1swap) {
                pg8::Gemm g{XB, W1T, TOK, 1280, D}; pg8::ListOrder S; S.init(TOK, 1280, G, bx); S.mode = 0;
                pg8::Epi1 E{RSTD, q_norm, k_norm, Qb, Kb, Vb, QIb, KIb, Ub, Rb, SPb, WIb, 0, 1.0f};
                pg8::gemm_phase<pg8::Epi1, pg8::ListOrder, true, true, 1>(lds, g, S, E, wave);
            } else {
                unsigned char* W1T8 = ws + WS_W1T8; unsigned char* XF8 = ws + WS_XF8;
                pg8::Gemm g{(const bf16*)XF8, (const bf16*)W1T8, TOK, 2560, D}; pg8::ListOrder S; S.init(TOK, 2560, G, bx); S.mode = 1;
                pg8::Epi1 E{RSTD, q_norm, k_norm, Qb, Kb, Vb, QIb, KIb, Ub, Rb, SPb, WIb, 5, pg8::K_WSCI};
                pg8::gemm_phase<pg8::Epi1, pg8::ListOrder, true, true, 2>(lds, g, S, E, wave);
            }
        }
        if (BOTH(1)) GRID_BAR_L();
    }
    if (IN(2)) {
        float* WIb = (float*)(ws + WS_WI);
        bf16* Kb = (bf16*)(ws + WS_K); bf16* Vb = (bf16*)(ws + WS_V); bf16* KIb = (bf16*)(ws + WS_KI); unsigned char* AP = ws + WS_AP;
        bf16* Qb = (bf16*)(ws + WS_Q); bf16* QIb = (bf16*)(ws + WS_QI); bf16* Ub = (bf16*)(ws + WS_U);
        const int ptask0 = (G == 256) ? (((vcu >> 4) * 32 + (((vcu & 15) * 8 + wave) >> 2)) * 4 + (wave & 3)) : gw, ptstep = (G == 256) ? TOK : NGW;
        for (int task = ptask0; task < TOK / 16; task += ptstep) {
            const int ln = mk_lane(); const int g = task & 3, tb = (task >> 2) * 64 + (ln >> 4) * 16, tin = tb & (SEQ - 1), c0 = g * 128 + (ln & 15) * 8;
            if (g == 0) pool_win<2>(Ub, AP, tb, tin, c0); else if (g == 1) pool_win<4>(Ub, AP, tb, tin, c0); else if (g == 2) pool_win<8>(Ub, AP, tb, tin, c0); else pool_win<16>(Ub, AP, tb, tin, c0);
        }
        __syncthreads();
        float qk2_;
        { const float* q_norm = args.in[3]; const float* k_norm = args.in[4]; const int lq = mk_lane() & 63; float gq = __builtin_fabsf(q_norm[lq]), gk = __builtin_fabsf(k_norm[lq]);
#pragma unroll
          for (int o_ = 1; o_ < 64; o_ <<= 1) { gq = __builtin_fmaxf(gq, __shfl_xor(gq, o_)); gk = __builtin_fmaxf(gk, __shfl_xor(gk, o_)); }
          qk2_ = __builtin_bit_cast(float, __builtin_amdgcn_readfirstlane(__builtin_bit_cast(int, 2.0f * 11.6f * gq * gk))); }
        const att::Tensors AT{Qb, Kb, Vb, QIb, KIb, WIb, AP, qk2_};
        const int nun = (G == 256) ? 4 : (NB * 64 - vcu + G - 1) / G;
#define UNIT_OF(i, b_, q_) do { if (G == 256) { const int s_ = vcu & 15; b_ = vcu >> 4; q_ = (int)((unit_tab(s_) >> (8 * (i))) & 0xffu); } \
                                else { const int un_ = vcu + (i) * G; b_ = un_ >> 6; q_ = un_ & 63; } } while (0)
        att::UnitPF pf;
        if (nun > 0) { int b0, q0; UNIT_OF(0, b0, q0); att::unit_prefetch(pf, b0, q0, AT, wave, lds, true); }
#pragma unroll 1
        for (int i = 0; i < nun; ++i) {
            int b, qb, nb = 0, nqb = 0; UNIT_OF(i, b, qb);
            const bool has_next = (i + 1 < nun); if (has_next) UNIT_OF(i + 1, nb, nqb);
            att::attn_unit(b, qb, AT, lds, pf, has_next, nb, nqb, wave);
        }
#undef UNIT_OF
        if (BOTH(2)) GRID_BAR_L();
    }
    if (IN(3)) {
        unsigned char* W3T = ws + WS_W3T; bf16* Rb = (bf16*)(ws + WS_R); bf16* SPb = (bf16*)(ws + WS_R) + 1024; unsigned char* AP = ws + WS_AP; unsigned char* MG = ws + WS_MG;
        pg8::Gemm g{(const bf16*)AP, (const bf16*)W3T, TOK, D, D}; pg8::StaticOrder S; S.init(TOK, D, G, bx);
        pg8::Epi3 E{Rb, SPb, MG};
        pg8::gemm_phase<pg8::Epi3, pg8::StaticOrder, true, true, 2>(lds, g, S, E, wave);
        if (BOTH(3)) GRID_BAR_L();
    }
    if (IN(4)) {
        bf16* XB = (bf16*)(ws + WS_XB); unsigned char* W4T = ws + WS_W4T; unsigned char* MG = ws + WS_MG; bf16* H2 = (bf16*)(ws + WS_H2); unsigned char* H2F8 = ws + WS_H2F8; float* SSQ = (float*)(ws + WS_SSQ);
        pg8::Gemm g{(const bf16*)MG, (const bf16*)W4T, TOK, D, D}; pg8::StaticOrder S; S.init(TOK, D, G, bx);
        pg8::Epi4 E{XB, H2, H2F8, SSQ};
        pg8::gemm_phase<pg8::Epi4, pg8::StaticOrder, true, true, 2>(lds, g, S, E, wave);
        if (BOTH(4)) GRID_BAR_L();
    }
    if (IN(5)) {
        unsigned char* W5T = ws + WS_W5T; unsigned char* H2F8 = ws + WS_H2F8; float* SSQ = (float*)(ws + WS_SSQ); unsigned char* ACT = ws + WS_ACT;
        bf16* H2 = (bf16*)(ws + WS_H2);
        pg8::Gemm g{MK_FP8 ? (const bf16*)H2F8 : (const bf16*)H2, (const bf16*)W5T, TOK, N5, D}; pg8::StaticOrder S; S.init(TOK, N5, G, bx);
        pg8::Epi5 E{SSQ, ACT};
        pg8::gemm_phase<pg8::Epi5, pg8::StaticOrder, true, true, MK_FP8 ? 2 : 0>(lds, g, S, E, wave);
        if (BOTH(5)) GRID_BAR_L();
    }
    if (IN(6)) {
        float* out = args.out; unsigned char* W6T = ws + WS_W6T; unsigned char* ACT = ws + WS_ACT; bf16* H2 = (bf16*)(ws + WS_H2);
        pg8::Gemm g{(const bf16*)ACT, (const bf16*)W6T, TOK, D, FF, 4096}; pg8::StaticOrder S; S.init(TOK, D, G, bx);
        pg8::Epi6 E{H2, out};
        pg8::gemm_phase<pg8::Epi6, pg8::StaticOrder, true, true, MK_FP8 ? 2 : 0>(lds, g, S, E, wave);
    }
#undef IN
#undef BOTH
#undef GRID_BAR
#undef GRID_BAR_L
}

extern "C" void kernel_launch(void* const* d_in, const int* in_sizes, int n_in, void* d_out, int out_size, void* d_ws, size_t ws_size, hipStream_t stream) {
    static int grid = 0;
    if (grid == 0) {
        if (n_in != 14 || in_sizes[0] != TOK * D || out_size != TOK * D || ws_size < WS_END) { fprintf(stderr, "kernel_launch: unexpected shapes (n_in %d, in0 %d, out %d, ws %zu)\n", n_in, n_in > 0 ? in_sizes[0] : -1, out_size, ws_size); grid = -1; return; }
        int dev = 0, cus = 0, per_cu = 0;
        if (hipGetDevice(&dev) != hipSuccess || hipDeviceGetAttribute(&cus, hipDeviceAttributeMultiprocessorCount, dev) != hipSuccess) { grid = -1; return; }
        if (hipFuncSetAttribute((const void*)mk_fwd, hipFuncAttributeMaxDynamicSharedMemorySize, LDS_BYTES) != hipSuccess) { fprintf(stderr, "kernel_launch: hipFuncSetAttribute failed\n"); grid = -1; return; }
        if (hipOccupancyMaxActiveBlocksPerMultiprocessor(&per_cu, (const void*)mk_fwd, NWAVES * 64, LDS_BYTES) != hipSuccess || per_cu < 1) fprintf(stderr, "kernel_launch: occupancy query says %d\n", per_cu);
        (void)hipGetLastError();
        grid = cus;
    }
    if (grid < 0) return;
    (void)hipMemsetAsync((char*)d_ws + WS_CTL, 0, CTL_ZERO_BYTES, stream);
    Args a{};
    for (int i = 0; i < 14; ++i) a.in[i] = (const float*)d_in[i];
    a.out = (float*)d_out; a.ws = (unsigned char*)d_ws;
#if MK_PER_PHASE
    for (int p = 0; p < 7; ++p) { a.ph_lo = p; a.ph_hi = p + 1; hipLaunchKernelGGL(mk_fwd, dim3(grid), dim3(NWAVES * 64), LDS_BYTES, stream, a);
#ifdef MK_REPEAT
        if (p == MK_REPEAT) hipLaunchKernelGGL(mk_fwd, dim3(grid), dim3(NWAVES * 64), LDS_BYTES, stream, a);
#endif
    }
#else
    a.ph_lo = 0; a.ph_hi = 7; hipLaunchKernelGGL(mk_fwd, dim3(grid), dim3(NWAVES * 64), LDS_BYTES, stream, a);
#endif
}
```

```cpp
#include <hip/hip_runtime.h>
#include <cstdio>
#include <cstdint>

#ifndef MK_PER_PHASE
#define MK_PER_PHASE 0
#endif
#ifndef MK_FP8
#define MK_FP8 1
#endif

__device__ __forceinline__ int mk_lane() { int l; asm volatile("v_mbcnt_lo_u32_b32 %0, -1, 0\n\tv_mbcnt_hi_u32_b32 %0, -1, %0" : "=v"(l)); return l; }
namespace pg8 {
#define PG8_LAS __attribute__((address_space(3)))
typedef unsigned short bf16_t;
typedef short bf16x8 __attribute__((ext_vector_type(8)));
typedef float f32x4 __attribute__((ext_vector_type(4)));
typedef unsigned u32x4 __attribute__((ext_vector_type(4)));
constexpr int BM = 256, BK = 64, HALF = 128, HTB = HALF * BK * 2  , STAGE_BYTES = 8 * HTB, NXCD = 8, WGM = 8;

__host__ __device__ __forceinline__ int lds_byte(int r, int c) { const int st = (r >> 4) * 2 + (c >> 5), rr = r & 15, cc = c & 31, ob = rr * 64 + cc * 2; return st * 1024 + (ob ^ (((ob >> 9) & 1) << 5)); }
__host__ __device__ __forceinline__ void stage_rc(int b, int& R, int& C) { const int st = b / 1024, sb = b % 1024, swz = sb ^ (((sb >> 9) & 1) << 5); R = (st >> 1) * 16 + swz / 64; C = (st & 1) * 32 + (swz % 64) / 2; }
__host__ __device__ __forceinline__ int perm32(int rho) { const int n = rho >> 4, i = rho & 15; return 8 * (i >> 2) + 4 * n + (i & 3); }

struct Unit { int pm, pn; };
struct Gemm { const bf16_t* A; const bf16_t* Bt; int M, N, K; int lda = 0; };

struct StaticOrder {
    int nM, nN, nwg, G, c;
    __host__ __device__ void init(int M, int N, int G_, int c_) { nM = M / BM; nN = N / BM; nwg = nM * nN; G = G_; c = c_; }
    __host__ __device__ bool next(int i, Unit& u) const {
        const long L = (long)i * G + c; if (L >= nwg) return false;
        int wgid = (int)L; const int rot = ((int)(L % NXCD) * nN) / NXCD; { const int q = nwg / NXCD, r = nwg % NXCD, xcd = wgid % NXCD, off = wgid / NXCD; wgid = (xcd < r ? xcd * (q + 1) : r * (q + 1) + (xcd - r) * q) + off; }
        const int nig = WGM * nN, gid = wgid / nig, fm = gid * WGM, gsz = (nM - fm) < WGM ? (nM - fm) : WGM;
        u.pm = fm + ((wgid % nig) % gsz); u.pn = ((wgid % nig) / gsz + rot) % nN; return true;
    }
    __device__ __forceinline__ void a_ready(const Unit&) const {}
    __device__ __forceinline__ void done(const Unit&) const {}
};


template <bool FP8> __host__ __device__ __forceinline__ int lds_xor(int rr) { return FP8 ? (((rr >> 1) & 1) | (rr & 4)) : rr; }
template <bool FP8> __host__ __device__ __forceinline__ int lds_byte2(int r, int ch) { const int rr = r & 7; return (r >> 3) * 1024 + rr * 128 + ((ch ^ lds_xor<FP8>(rr)) << 4); }
template <bool FP8> __host__ __device__ __forceinline__ void stage_rc2(int b, int& R, int& CB) { const int st = b >> 10, i = (b & 1023) >> 4, rr = i >> 3, chp = i & 7; R = st * 8 + rr; CB = (chp ^ lds_xor<FP8>(rr)) << 4; }

struct ListOrder : StaticOrder {
    int mode;
    __host__ __device__ bool next(int i, Unit& u) const {
        long L;
        if (G != 256) { L = (long)i * G + c; }
        else if (mode == 0) { if (i >= 3 || (i == 2 && c >= 128)) return false; L = 256 * i + c; }
        else { if (c < 128) { if (i >= 4) return false; L = c + 128 * i; } else { if (i >= 6) return false; L = 512 + (c - 128) + 128 * i; } }
        if (L >= nwg) return false;
        int wgid = (int)L; const int rot = ((int)(L % NXCD) * nN) / NXCD; { const int q = nwg / NXCD, r = nwg % NXCD, xcd = wgid % NXCD, off = wgid / NXCD; wgid = (xcd < r ? xcd * (q + 1) : r * (q + 1) + (xcd - r) * q) + off; }
        const int nig = WGM * nN, gid = wgid / nig, fm = gid * WGM, gsz = (nM - fm) < WGM ? (nM - fm) : WGM;
        u.pm = fm + ((wgid % nig) % gsz); u.pn = ((wgid % nig) / gsz + rot) % nN; return true;
    }
};


typedef float f32x2 __attribute__((ext_vector_type(2)));
typedef __bf16 bf16x2_t __attribute__((ext_vector_type(2)));
__device__ __forceinline__ unsigned cvt_pk_bf16(float lo, float hi) { f32x2 v = {lo, hi}; bf16x2_t b = __builtin_convertvector(v, bf16x2_t); return __builtin_bit_cast(unsigned, b); }
__device__ __forceinline__ u32x4 pack8(f32x4 a, f32x4 b) { u32x4 w; w.x = cvt_pk_bf16(a[0], a[1]); w.y = cvt_pk_bf16(a[2], a[3]); w.z = cvt_pk_bf16(b[0], b[1]); w.w = cvt_pk_bf16(b[2], b[3]); return w; }
typedef _Float16 f16x2_t __attribute__((ext_vector_type(2)));
__device__ __forceinline__ unsigned cvt_pk_f16(float lo, float hi) { f32x2 v = {lo, hi}; f16x2_t h = __builtin_convertvector(v, f16x2_t); return __builtin_bit_cast(unsigned, h); }
__device__ __forceinline__ u32x4 pack8h(f32x4 a, f32x4 b) { u32x4 w; w.x = cvt_pk_f16(a[0], a[1]); w.y = cvt_pk_f16(a[2], a[3]); w.z = cvt_pk_f16(b[0], b[1]); w.w = cvt_pk_f16(b[2], b[3]); return w; }
__device__ __forceinline__ void unpack8(u32x4 w, f32x4& a, f32x4& b) {
    a[0] = __uint_as_float(w.x << 16); a[1] = __uint_as_float(w.x & 0xffff0000u); a[2] = __uint_as_float(w.y << 16); a[3] = __uint_as_float(w.y & 0xffff0000u);
    b[0] = __uint_as_float(w.z << 16); b[1] = __uint_as_float(w.z & 0xffff0000u); b[2] = __uint_as_float(w.w << 16); b[3] = __uint_as_float(w.w & 0xffff0000u); }
__device__ __forceinline__ float h2f(unsigned h) { return (float)__builtin_bit_cast(_Float16, (unsigned short)h); }
__device__ __forceinline__ void unpack8h(u32x4 w, f32x4& a, f32x4& b) {
    a[0] = h2f(w.x & 0xffffu); a[1] = h2f(w.x >> 16); a[2] = h2f(w.y & 0xffffu); a[3] = h2f(w.y >> 16);
    b[0] = h2f(w.z & 0xffffu); b[1] = h2f(w.z >> 16); b[2] = h2f(w.w & 0xffffu); b[3] = h2f(w.w >> 16); }
__device__ __forceinline__ unsigned pk4_fp8(float a, float b, float c, float d) { unsigned r = __builtin_amdgcn_cvt_pk_fp8_f32(a, b, 0u, false); return (unsigned)__builtin_amdgcn_cvt_pk_fp8_f32(c, d, r, true); }
__device__ __forceinline__ unsigned long long pack8_fp8(f32x4 a, f32x4 b) { return (unsigned long long)pk4_fp8(a[0], a[1], a[2], a[3]) | ((unsigned long long)pk4_fp8(b[0], b[1], b[2], b[3]) << 32); }
constexpr float K_WSC = 64.0f, K_WSCI = 1.0f / 64.0f;
__device__ __forceinline__ float sum_fq(float s) {
    auto r16 = __builtin_amdgcn_permlane16_swap(__float_as_uint(s), __float_as_uint(s), false, false); s = __uint_as_float(r16[0]) + __uint_as_float(r16[1]);
    auto r32 = __builtin_amdgcn_permlane32_swap(__float_as_uint(s), __float_as_uint(s), false, false); return __uint_as_float(r32[0]) + __uint_as_float(r32[1]); }
__device__ __forceinline__ float fexp(float x) { return __builtin_amdgcn_exp2f(x * 1.4426950408889634f); }
__device__ __forceinline__ float frcp(float x) { return __builtin_amdgcn_rcpf(x); }

constexpr float K_EPS = 1e-6f, K_C2 = 0.125f * 1.4426950408889634f, K_IDXS = 0.04419417382415922f;

struct Epi1 {
    static constexpr bool PERM = true, AFTER_DRAIN = false, MID = false;
    const float* rstd; const float* qn; const float* kn;
    bf16_t *Q, *K, *V, *QI, *KI, *U, *R, *SP; float* WI; int pn_off; float wsc; mutable int cpm = -1; mutable float crs[2][4] = {};
    __device__ __forceinline__ void mid(f32x4 (&)[2][2][4][2], const Unit&, int, int, int, int) const {}
    template <bool NORM, bool F16 = false>
    __device__ __forceinline__ void head_tile(const f32x4 (&acc)[2][2][4][2], const float (&rsr)[2][4], int row0, int fq, bf16_t* dst, int pitch, int colbase, const float* gain, float scale) const {
        f32x4 g[2][2];
#pragma unroll
        for (int bj = 0; bj < 2; ++bj)
#pragma unroll
            for (int n = 0; n < 2; ++n) g[bj][n] = NORM ? *(const f32x4*)(gain + 32 * bj + 8 * fq + 4 * n) : (f32x4){1.f, 1.f, 1.f, 1.f};
#pragma unroll
        for (int ai = 0; ai < 2; ++ai)
#pragma unroll
            for (int m = 0; m < 4; ++m) {
                const int row = row0 + ai * HALF + m * 16; const float rs = rsr[ai][m];
                f32x4 v[2][2]; float ss = 0.f;
#pragma unroll
                for (int bj = 0; bj < 2; ++bj)
#pragma unroll
                    for (int n = 0; n < 2; ++n) { v[bj][n] = acc[ai][bj][m][n] * rs; const f32x4 q = v[bj][n] * v[bj][n]; ss += (q[0] + q[1]) + (q[2] + q[3]); }
                float mul = scale;
                if (NORM) { ss = sum_fq(ss); mul = __builtin_amdgcn_rsqf(ss * (1.0f / 64.0f) + K_EPS) * scale; }
#pragma unroll
                for (int bj = 0; bj < 2; ++bj) {
                    const f32x4 o0 = v[bj][0] * g[bj][0] * mul, o1 = v[bj][1] * g[bj][1] * mul;
                    *(u32x4*)(dst + (size_t)row * pitch + colbase + 32 * bj + 8 * fq) = F16 ? pack8h(o0, o1) : pack8(o0, o1);
                }
            }
    }
    __device__ __forceinline__ void operator()(const f32x4 (&acc)[2][2][4][2], const Unit& u, int wr, int wc, int fr, int fq) const {
        asm volatile("" : "+v"(fr), "+v"(fq));
        const int row0 = u.pm * BM + wr * 64 + fr; const int pn = u.pn + pn_off;
        float rsr[2][4];
        if (u.pm != cpm) {
#pragma unroll
            for (int ai = 0; ai < 2; ++ai)
#pragma unroll
                for (int m = 0; m < 4; ++m) crs[ai][m] = rstd[row0 + ai * HALF + m * 16];
            cpm = u.pm;
        }
#pragma unroll
        for (int ai = 0; ai < 2; ++ai)
#pragma unroll
            for (int m = 0; m < 4; ++m) rsr[ai][m] = crs[ai][m];
        if (pn >= 7) {
            const int cb = (pn - 7) * 128 + wc * 32 + 8 * fq;
#pragma unroll
            for (int ai = 0; ai < 2; ++ai)
#pragma unroll
                for (int m = 0; m < 4; ++m) {
                    const int row = row0 + ai * HALF + m * 16; const float rs = rsr[ai][m] * wsc;
                    f32x4 r[2], s[2];
#pragma unroll
                    for (int n = 0; n < 2; ++n)
#pragma unroll
                        for (int i = 0; i < 4; ++i) {
                            const float ea = fminf(fexp(-acc[ai][0][m][n][i] * rs), 1e30f), ep = fminf(fexp(-acc[ai][1][m][n][i] * rs), 1e30f);
                            const float sp = frcp(1.f + ep); s[n][i] = sp; r[n][i] = (1.f + ep) * frcp(1.f + ea);
                        }
                    *(u32x4*)(R + (size_t)row * 2048 + cb) = pack8(r[0], r[1]);
                    *(u32x4*)(SP + (size_t)row * 2048 + cb) = pack8(s[0], s[1]);
                }
        } else if (pn >= 5) {
#pragma unroll
            for (int ai = 0; ai < 2; ++ai)
#pragma unroll
                for (int m = 0; m < 4; ++m) {
                    const int row = row0 + ai * HALF + m * 16; const float rs = rsr[ai][m] * wsc;
#pragma unroll
                    for (int bj = 0; bj < 2; ++bj)
                        *(u32x4*)(U + (size_t)row * 512 + (pn - 5) * 256 + bj * HALF + wc * 32 + 8 * fq) = pack8(acc[ai][bj][m][0] * rs, acc[ai][bj][m][1] * rs);
                }
        } else if (pn == 2) {
            if (wc == 0) head_tile<true>(acc, rsr, row0, fq, K, 64, 0, kn, 1.0f);
            else if (wc == 1) head_tile<false>(acc, rsr, row0, fq, V, 64, 0, nullptr, 1.0f);
            else if (wc == 2) head_tile<false, true>(acc, rsr, row0, fq, KI, 64, 0, nullptr, 1.0f);
            else {
                if (fq == 0) {
#pragma unroll
                    for (int ai = 0; ai < 2; ++ai)
#pragma unroll
                        for (int m = 0; m < 4; ++m) {
                            const int row = row0 + ai * HALF + m * 16; const float rs = rsr[ai][m] * K_IDXS;
                            *(f32x4*)(WI + (size_t)row * 8) = acc[ai][0][m][0] * rs; *(f32x4*)(WI + (size_t)row * 8 + 4) = acc[ai][0][m][1] * rs;
                        }
                }
            }
        } else if (pn < 2) head_tile<true>(acc, rsr, row0, fq, Q, 512, (pn * 4 + wc) * 64, qn, K_C2);
        else head_tile<false, true>(acc, rsr, row0, fq, QI, 512, ((pn - 3) * 4 + wc) * 64, nullptr, 1.0f);
    }
};

struct Epi3 {
    static constexpr bool PERM = true, AFTER_DRAIN = false, MID = true;
    const bf16_t* R; const bf16_t* SP; unsigned char* MG;
    __device__ __forceinline__ void scale_by(f32x4 (&acc)[2][2][4][2], const bf16_t* Sc, const Unit& u, int wr, int wc, int fr, int fq) const {
        asm volatile("" : "+v"(fr), "+v"(fq));
        const int row0 = u.pm * BM + wr * 64 + fr, col0 = u.pn * BM + wc * 32 + 8 * fq;
#pragma unroll
        for (int ai = 0; ai < 2; ++ai) {
            u32x4 w[4][2];
#pragma unroll
            for (int m = 0; m < 4; ++m)
#pragma unroll
                for (int bj = 0; bj < 2; ++bj) w[m][bj] = *(const u32x4*)(Sc + (size_t)(row0 + ai * HALF + m * 16) * 2048 + col0 + bj * HALF);
#pragma unroll
            for (int m = 0; m < 4; ++m)
#pragma unroll
                for (int bj = 0; bj < 2; ++bj) { f32x4 a, b; unpack8(w[m][bj], a, b); acc[ai][bj][m][0] *= a; acc[ai][bj][m][1] *= b; }
        }
    }
    __device__ __forceinline__ void mid(f32x4 (&acc)[2][2][4][2], const Unit& u, int wr, int wc, int fr, int fq) const { scale_by(acc, R, u, wr, wc, fr, fq); }
    __device__ __forceinline__ void operator()(const f32x4 (&acc)[2][2][4][2], const Unit& u, int wr, int wc, int fr, int fq) const {
        asm volatile("" : "+v"(fr), "+v"(fq));
        const int row0 = u.pm * BM + wr * 64 + fr, col0 = u.pn * BM + wc * 32 + 8 * fq;
#pragma unroll
        for (int ai = 0; ai < 2; ++ai) {
            u32x4 w[4][2];
#pragma unroll
            for (int m = 0; m < 4; ++m)
#pragma unroll
                for (int bj = 0; bj < 2; ++bj) w[m][bj] = *(const u32x4*)(SP + (size_t)(row0 + ai * HALF + m * 16) * 2048 + col0 + bj * HALF);
#pragma unroll
            for (int m = 0; m < 4; ++m)
#pragma unroll
                for (int bj = 0; bj < 2; ++bj) {
                    const size_t off = (size_t)(row0 + ai * HALF + m * 16) * 1024 + col0 + bj * HALF;
                    f32x4 a, b; unpack8(w[m][bj], a, b);
                    *(unsigned long long*)(MG + off) = pack8_fp8(acc[ai][bj][m][0] * a * (8.0f * K_WSCI), acc[ai][bj][m][1] * b * (8.0f * K_WSCI));
                }
        }
    }
};

struct Epi4 {
    static constexpr bool PERM = true, AFTER_DRAIN = false, MID = false;
    const bf16_t* XB; bf16_t* H2; unsigned char* H2F8; float* SSQ;
    __device__ __forceinline__ void mid(f32x4 (&)[2][2][4][2], const Unit&, int, int, int, int) const {}
    __device__ __forceinline__ void operator()(const f32x4 (&acc)[2][2][4][2], const Unit& u, int wr, int wc, int fr, int fq) const {
        asm volatile("" : "+v"(fr), "+v"(fq));
        const int row0 = u.pm * BM + wr * 64 + fr, col0 = u.pn * BM + wc * 32 + 8 * fq;
#pragma unroll
        for (int ai = 0; ai < 2; ++ai) {
            u32x4 xw[4][2];
#pragma unroll
            for (int m = 0; m < 4; ++m)
#pragma unroll
                for (int bj = 0; bj < 2; ++bj) xw[m][bj] = *(const u32x4*)(XB + (size_t)(row0 + ai * HALF + m * 16) * 1024 + col0 + bj * HALF);
#pragma unroll
            for (int m = 0; m < 4; ++m) {
                const int row = row0 + ai * HALF + m * 16; float ss = 0.f;
#pragma unroll
                for (int bj = 0; bj < 2; ++bj) {
                    const size_t off = (size_t)row * 1024 + col0 + bj * HALF;
                    f32x4 a, b; unpack8h(xw[m][bj], a, b);
                    a += acc[ai][bj][m][0] * (K_WSCI * 0.125f); b += acc[ai][bj][m][1] * (K_WSCI * 0.125f);
                    const f32x4 q = a * a + b * b; ss += (q[0] + q[1]) + (q[2] + q[3]);
                    *(u32x4*)(H2 + off) = pack8(a, b);
                    *(unsigned long long*)(H2F8 + off) = pack8_fp8(a, b);
                }
                ss = sum_fq(ss);
                if (fq == 0) SSQ[(size_t)row * 16 + u.pn * 4 + wc] = ss;
            }
        }
    }
};

struct Epi5 {
    static constexpr bool PERM = true, AFTER_DRAIN = false, MID = false;
    const float* SSQ; unsigned char* ACT;
    mutable int cpm = -1; mutable float crs[2][4] = {};
    __device__ __forceinline__ void mid(f32x4 (&)[2][2][4][2], const Unit&, int, int, int, int) const {}
    __device__ __forceinline__ void operator()(const f32x4 (&acc)[2][2][4][2], const Unit& u, int wr, int wc, int fr, int fq) const {
        asm volatile("" : "+v"(fr), "+v"(fq));
        const int row0 = u.pm * BM + wr * 64 + fr, col0 = u.pn * 128 + wc * 32 + 8 * fq;
        float rsv[2][4];
        if (u.pm != cpm) { f32x4 part[2][4];
#pragma unroll
          for (int ai = 0; ai < 2; ++ai)
#pragma unroll
              for (int m = 0; m < 4; ++m) part[ai][m] = *(const f32x4*)(SSQ + (size_t)(row0 + ai * HALF + m * 16) * 16 + 4 * fq);
#pragma unroll
          for (int ai = 0; ai < 2; ++ai)
#pragma unroll
              for (int m = 0; m < 4; ++m) { float s = (part[ai][m][0] + part[ai][m][1]) + (part[ai][m][2] + part[ai][m][3]); s = sum_fq(s);
                  crs[ai][m] = __builtin_amdgcn_rsqf(s * (1.0f / 1024.0f) + K_EPS) * (MK_FP8 ? K_WSCI : 1.0f); }
          cpm = u.pm; }
#pragma unroll
        for (int ai = 0; ai < 2; ++ai)
#pragma unroll
            for (int m = 0; m < 4; ++m) rsv[ai][m] = crs[ai][m];
#pragma unroll
        for (int ai = 0; ai < 2; ++ai)
#pragma unroll
            for (int m = 0; m < 4; ++m) {
                const int row = row0 + ai * HALF + m * 16; const float rs = rsv[ai][m];
                const float k1 = -rs * 1.4426950408889634f, rs2 = rs * rs;
                f32x4 o[2];
#pragma unroll
                for (int n = 0; n < 2; ++n) {
                    const f32x4 ag = acc[ai][0][m][n], au = acc[ai][1][m][n];
                    const f32x4 t = ag * k1; f32x4 e;
#pragma unroll
                    for (int i = 0; i < 4; ++i) e[i] = __builtin_amdgcn_exp2f(t[i]);
                    const f32x4 d = e + 1.0f; f32x4 r;
#pragma unroll
                    for (int i = 0; i < 4; ++i) r[i] = __builtin_amdgcn_rcpf(d[i]);
                    o[n] = (ag * au) * (r * rs2);
                }
                if (MK_FP8) *(unsigned long long*)(ACT + (size_t)row * 4096 + col0) = pack8_fp8(o[0], o[1]); else *(u32x4*)((bf16_t*)ACT + (size_t)row * 2816 + col0) = pack8(o[0], o[1]);
            }
    }
};

struct Epi6 {
    static constexpr bool PERM = false, AFTER_DRAIN = false, MID = false;
    const bf16_t* H2; float* OUT;
    __device__ __forceinline__ void mid(f32x4 (&)[2][2][4][2], const Unit&, int, int, int, int) const {}
    __device__ __forceinline__ void operator()(const f32x4 (&acc)[2][2][4][2], const Unit& u, int wr, int wc, int fr, int fq) const {
        asm volatile("" : "+v"(fr), "+v"(fq));
        const int row0 = u.pm * BM + wr * 64 + fr, col0 = u.pn * BM + wc * 32 + 4 * fq;
#pragma unroll
        for (int ai = 0; ai < 2; ++ai) {
            unsigned long long hw[4][2][2];
#pragma unroll
            for (int m = 0; m < 4; ++m)
#pragma unroll
                for (int bj = 0; bj < 2; ++bj)
#pragma unroll
                    for (int n = 0; n < 2; ++n) hw[m][bj][n] = *(const unsigned long long*)(H2 + (size_t)(row0 + ai * HALF + m * 16) * 1024 + col0 + bj * HALF + n * 16);
#pragma unroll
            for (int m = 0; m < 4; ++m)
#pragma unroll
                for (int bj = 0; bj < 2; ++bj)
#pragma unroll
                    for (int n = 0; n < 2; ++n) {
                        const size_t off = (size_t)(row0 + ai * HALF + m * 16) * 1024 + col0 + bj * HALF + n * 16;
                        const unsigned long long w = hw[m][bj][n];
                        f32x4 r; r[0] = __uint_as_float((unsigned)w << 16); r[1] = __uint_as_float((unsigned)w & 0xffff0000u); r[2] = __uint_as_float((unsigned)(w >> 32) << 16); r[3] = __uint_as_float((unsigned)(w >> 32) & 0xffff0000u);
                        *(f32x4*)(OUT + off) = r + acc[ai][bj][m][n] * (MK_FP8 ? K_WSCI : 1.0f);
                    }
        }
    }
};

typedef int v8i_t __attribute__((ext_vector_type(8)));
typedef _Float16 f16x8_t __attribute__((ext_vector_type(8)));
typedef int v4i_t __attribute__((ext_vector_type(4)));
template <class Epi, class Sched, bool ALIGN_EPI = false, bool SP2 = false, int DT = 0>
__device__ __forceinline__ void gemm_phase(PG8_LAS unsigned char* lds, const Gemm g, const Sched& S, const Epi& E, const int wave_s) {
    const int wid = wave_s, lane = mk_lane(), tid = wid * 64 + lane, wr = wid >> 2, wc = wid & 3, fr = lane & 15, fq = lane >> 4;
    constexpr int ES = (DT == 2) ? 1 : 2, KST = (DT == 2) ? 16 : 1024;
    const int K = g.K, nt = K * ES / 128;
    const int rowA = g.lda ? g.lda : K * ES;
    unsigned voffA[2], voffB[2];
#pragma unroll
    for (int i = 0; i < 2; ++i) { int R, CB; stage_rc2<DT == 2>(tid * 16 + i * 8192, R, CB); const int Rb = Epi::PERM ? ((R & ~31) + perm32(R & 31)) : R;
        voffA[i] = (unsigned)(R * rowA + CB); voffB[i] = (unsigned)(Rb * K * ES + CB); }
    const size_t kstep = (size_t)(BK * 2);
    const size_t hstep = (size_t)HALF * K * ES;
    const size_t tstep = 2 * hstep;
    const size_t hstepA = (size_t)HALF * rowA, tstepA = 2 * hstepA;
    const unsigned ldsw = (unsigned)wid * 1024u;
    const int aoff = lds_byte2<DT == 2>(wr * 64 + fr, (DT == 2) ? 2 * fq : fq), boff = lds_byte2<DT == 2>(wc * 32 + fr, (DT == 2) ? 2 * fq : fq);
    const int aoff1 = aoff ^ ((DT == 2) ? 16 : 64), boff1 = boff ^ ((DT == 2) ? 16 : 64);
#define PG8_SA(b, h) (((b) * 2 + (h)) * HTB)
#define PG8_SB(b, h) ((4 + (b) * 2 + (h)) * HTB)
#define PG8_STAGE(bufoff, gbase, voff) do { _Pragma("unroll") for (int _i = 0; _i < 2; ++_i) \
        __builtin_amdgcn_global_load_lds((const unsigned*)((const char*)(gbase) + (voff)[_i]), (PG8_LAS unsigned*)(lds + (bufoff) + ldsw + _i * 8192), 16, 0, 0); } while (0)
#define PG8_LD8(dstv, ptr0, ptr1) do { const v4i_t lo_ = *(const PG8_LAS v4i_t*)(ptr0); const v4i_t hi_ = *(const PG8_LAS v4i_t*)(ptr1); dstv = __builtin_shufflevector(lo_, hi_, 0, 1, 2, 3, 4, 5, 6, 7); } while (0)
#define PG8_LDA(dst, b, h) do { if constexpr (DT == 2) { _Pragma("unroll") for (int m = 0; m < 4; ++m) PG8_LD8(dst##8[m], lds + PG8_SA(b, h) + aoff + m * 2048, lds + PG8_SA(b, h) + aoff1 + m * 2048); } else { \
        _Pragma("unroll") for (int m = 0; m < 4; ++m) _Pragma("unroll") for (int k = 0; k < 2; ++k) dst[m][k] = *(const PG8_LAS bf16x8*)(lds + PG8_SA(b, h) + (k ? aoff1 : aoff) + m * 2048); } } while (0)
#define PG8_LDB(dst, b, h) do { if constexpr (DT == 2) { _Pragma("unroll") for (int n = 0; n < 2; ++n) PG8_LD8(dst##8[n], lds + PG8_SB(b, h) + boff + n * 2048, lds + PG8_SB(b, h) + boff1 + n * 2048); } else { \
        _Pragma("unroll") for (int n = 0; n < 2; ++n) _Pragma("unroll") for (int k = 0; k < 2; ++k) dst[n][k] = *(const PG8_LAS bf16x8*)(lds + PG8_SB(b, h) + (k ? boff1 : boff) + n * 2048); } } while (0)
#define PG8_MMA(ai, bj, At, Bt) do { __builtin_amdgcn_s_setprio(1); _Pragma("unroll") for (int m = 0; m < 4; ++m) _Pragma("unroll") for (int n = 0; n < 2; ++n) { \
        if constexpr (DT == 2) { if (m == 0 && n == 0) asm volatile("s_nop 1\n\tv_mfma_f32_16x16x128_f8f6f4 %0, %1, %2, %0" : "+v"(acc[ai][bj][m][n]) : "v"(Bt##8[n]), "v"(At##8[m]));   \
            else asm volatile("v_mfma_f32_16x16x128_f8f6f4 %0, %1, %2, %0" : "+v"(acc[ai][bj][m][n]) : "v"(Bt##8[n]), "v"(At##8[m])); } \
        else if constexpr (DT == 1) { _Pragma("unroll") for (int k = 0; k < 2; ++k) acc[ai][bj][m][n] = __builtin_amdgcn_mfma_f32_16x16x32_f16(__builtin_bit_cast(f16x8_t, Bt[n][k]), __builtin_bit_cast(f16x8_t, At[m][k]), acc[ai][bj][m][n], 0, 0, 0); } \
        else { _Pragma("unroll") for (int k = 0; k < 2; ++k) acc[ai][bj][m][n] = __builtin_amdgcn_mfma_f32_16x16x32_bf16(Bt[n][k], At[m][k], acc[ai][bj][m][n], 0, 0, 0); } } \
        __builtin_amdgcn_s_setprio(0); } while (0)
#define PG8_WAIT_V(n) asm volatile("s_waitcnt vmcnt(" #n ")" ::: "memory")
#define PG8_WAIT_L(n) asm volatile("s_waitcnt lgkmcnt(" #n ")" ::: "memory")
#define PG8_BAR __builtin_amdgcn_s_barrier()
#define PG8_SCHED __builtin_amdgcn_sched_barrier(0)
    Unit cur, nxt; int ui = 0;
    if (!S.next(0, cur)) return;
    f32x4 acc[2][2][4][2];
#pragma unroll
    for (int a = 0; a < 2; ++a)
#pragma unroll
        for (int b = 0; b < 2; ++b)
#pragma unroll
            for (int m = 0; m < 4; ++m)
#pragma unroll
                for (int n = 0; n < 2; ++n) acc[a][b][m][n] = (f32x4){0.f, 0.f, 0.f, 0.f};
    bf16x8 At[4][2], B0[2][2], B1[2][2]; v8i_t At8[4], B08[2], B18[2];
    const char* cA = (const char*)g.A + (size_t)cur.pm * tstepA; const char* cB = (const char*)g.Bt + (size_t)cur.pn * tstep;
    S.a_ready(cur);
    if constexpr (SP2) {
        PG8_STAGE(PG8_SB(0, 0), cB, voffB); PG8_STAGE(PG8_SB(0, 1), cB + hstep, voffB); PG8_STAGE(PG8_SA(0, 0), cA, voffA); PG8_STAGE(PG8_SA(0, 1), cA + hstepA, voffA);
        if (wr == 1) PG8_BAR;
        PG8_WAIT_V(2); PG8_BAR;
        PG8_STAGE(PG8_SB(1, 0), cB + kstep, voffB); PG8_STAGE(PG8_SA(1, 0), cA + kstep, voffA); PG8_STAGE(PG8_SB(1, 1), cB + hstep + kstep, voffB);
        PG8_WAIT_V(6); PG8_BAR;
    } else {
        PG8_STAGE(PG8_SB(0, 0), cB, voffB); PG8_STAGE(PG8_SA(0, 0), cA, voffA); PG8_STAGE(PG8_SB(0, 1), cB + hstep, voffB); PG8_STAGE(PG8_SA(0, 1), cA + hstepA, voffA);
        if (wr == 1) PG8_BAR;
        PG8_WAIT_V(4); PG8_BAR;
        PG8_STAGE(PG8_SB(1, 0), cB + kstep, voffB); PG8_STAGE(PG8_SA(1, 0), cA + kstep, voffA); PG8_STAGE(PG8_SB(1, 1), cB + hstep + kstep, voffB);
        PG8_WAIT_V(6); PG8_BAR;
    }
    for (;;) {
        const bool has_next = S.next(ui + 1, nxt);
        const char* nA = has_next ? (const char*)g.A + (size_t)nxt.pm * tstepA : cA; const char* nB = has_next ? (const char*)g.Bt + (size_t)nxt.pn * tstep : cB;
#pragma unroll 1
        for (int t = 0; t < nt; t += 2) {
            if constexpr (Epi::MID) { if (t == (nt >> 1)) { if constexpr (DT == 2) asm volatile("s_nop 15\n\ts_nop 15" ::: "memory"); __builtin_amdgcn_sched_barrier(0); E.mid(acc, cur, wr, wc, fr, fq); if constexpr (DT == 2) { __builtin_amdgcn_sched_barrier(0); asm volatile("s_nop 4" ::: "memory"); } } }
            asm volatile("" : "+v"(voffA[0]), "+v"(voffA[1]), "+v"(voffB[0]), "+v"(voffB[1]));
            const bool last = (t == nt - 2);
            const char* a1 = cA + (size_t)(t + 1) * kstep;
            const char* a2 = last ? nA : cA + (size_t)(t + 2) * kstep; const char* b2 = last ? nB : cB + (size_t)(t + 2) * kstep;
            const char* a3 = a2 + kstep; const char* b3 = b2 + kstep;
            if (last && has_next) S.a_ready(nxt);
            if constexpr (SP2) {
            PG8_LDB(B0, 0, 0); PG8_LDB(B1, 0, 1); PG8_SCHED; PG8_LDA(At, 0, 0); PG8_STAGE(PG8_SA(1, 1), a1 + hstepA, voffA);
            PG8_WAIT_V(8); PG8_WAIT_L(0); PG8_BAR; PG8_MMA(0, 0, At, B0); PG8_MMA(0, 1, At, B1); PG8_BAR; PG8_SCHED;
            PG8_LDA(At, 0, 1); PG8_STAGE(PG8_SB(0, 0), b2, voffB); PG8_STAGE(PG8_SB(0, 1), b2 + hstep, voffB); PG8_STAGE(PG8_SA(0, 0), a2, voffA);
            PG8_WAIT_V(8); PG8_WAIT_L(0); PG8_BAR; PG8_MMA(1, 0, At, B0); PG8_MMA(1, 1, At, B1); PG8_BAR; PG8_SCHED;
            PG8_LDB(B0, 1, 0); PG8_LDB(B1, 1, 1); PG8_SCHED; PG8_LDA(At, 1, 0); PG8_STAGE(PG8_SA(0, 1), a2 + hstepA, voffA);
            PG8_WAIT_V(8); PG8_WAIT_L(0); PG8_BAR; PG8_MMA(0, 0, At, B0); PG8_MMA(0, 1, At, B1); PG8_BAR; PG8_SCHED;
            PG8_LDA(At, 1, 1); PG8_STAGE(PG8_SB(1, 0), b3, voffB); PG8_STAGE(PG8_SB(1, 1), b3 + hstep, voffB); PG8_STAGE(PG8_SA(1, 0), a3, voffA);
            PG8_WAIT_V(8); PG8_WAIT_L(0); PG8_BAR; PG8_MMA(1, 0, At, B0); PG8_MMA(1, 1, At, B1); PG8_BAR; PG8_SCHED;
            } else {
            PG8_LDB(B0, 0, 0); PG8_SCHED; PG8_LDA(At, 0, 0); PG8_STAGE(PG8_SA(1, 1), a1 + hstepA, voffA);
            PG8_WAIT_L(8); PG8_BAR; PG8_WAIT_L(0); PG8_MMA(0, 0, At, B0); PG8_BAR; PG8_SCHED;
            PG8_LDB(B1, 0, 1); PG8_STAGE(PG8_SB(0, 0), b2, voffB);
            PG8_BAR; PG8_WAIT_L(0); PG8_MMA(0, 1, At, B1); PG8_BAR;
            PG8_LDA(At, 0, 1); PG8_STAGE(PG8_SA(0, 0), a2, voffA);
            PG8_BAR; PG8_WAIT_L(0); PG8_MMA(1, 0, At, B0); PG8_BAR; PG8_SCHED;
            PG8_STAGE(PG8_SB(0, 1), b2 + hstep, voffB);
            PG8_WAIT_V(6); PG8_BAR; PG8_MMA(1, 1, At, B1); PG8_BAR;
            PG8_LDB(B0, 1, 0); PG8_SCHED; PG8_LDA(At, 1, 0); PG8_STAGE(PG8_SA(0, 1), a2 + hstepA, voffA);
            PG8_WAIT_L(8); PG8_BAR; PG8_WAIT_L(0); PG8_MMA(0, 0, At, B0); PG8_BAR; PG8_SCHED;
            PG8_LDB(B1, 1, 1); PG8_STAGE(PG8_SB(1, 0), b3, voffB);
            PG8_BAR; PG8_WAIT_L(0); PG8_MMA(0, 1, At, B1); PG8_BAR;
            PG8_LDA(At, 1, 1); PG8_STAGE(PG8_SA(1, 0), a3, voffA);
            PG8_BAR; PG8_WAIT_L(0); PG8_MMA(1, 0, At, B0); PG8_BAR; PG8_SCHED;
            PG8_STAGE(PG8_SB(1, 1), b3 + hstep, voffB);
            PG8_WAIT_V(6); PG8_BAR; PG8_MMA(1, 1, At, B1); PG8_BAR;
            }
        }
        if constexpr (DT == 2) { asm volatile("s_nop 15\n\ts_nop 15" ::: "memory"); __builtin_amdgcn_sched_barrier(0); }
        if constexpr (ALIGN_EPI) { if (wr == 0) PG8_BAR; }
        if constexpr (!Epi::AFTER_DRAIN) { E(acc, cur, wr, wc, fr, fq); S.done(cur); }
        if (!has_next) break;
#pragma unroll
        for (int a = 0; a < 2; ++a)
#pragma unroll
            for (int b = 0; b < 2; ++b)
#pragma unroll
                for (int m = 0; m < 4; ++m)
#pragma unroll
                    for (int n = 0; n < 2; ++n) acc[a][b][m][n] = (f32x4){0.f, 0.f, 0.f, 0.f};
        cur = nxt; cA = nA; cB = nB; ++ui;
        if constexpr (ALIGN_EPI) { if (wr == 1) PG8_BAR; }
    }
    PG8_WAIT_V(0);
    if constexpr (!ALIGN_EPI) { if (wr == 0) PG8_BAR; }
    PG8_BAR;
    if constexpr (Epi::AFTER_DRAIN) { E.fused(acc, cur, wr, wc, fr, fq, lds, wid, lane); S.done(cur); }
#undef PG8_SA
#undef PG8_SB
#undef PG8_STAGE
#undef PG8_LD8
#undef PG8_LDA
#undef PG8_LDB
#undef PG8_MMA
#undef PG8_WAIT_V
#undef PG8_WAIT_L
#undef PG8_BAR
#undef PG8_SCHED
}
}

namespace att {
typedef unsigned short bf16_t;
typedef short bf16x8 __attribute__((ext_vector_type(8)));
typedef short s16x4 __attribute__((ext_vector_type(4)));
typedef _Float16 f16x8 __attribute__((ext_vector_type(8)));
typedef short v4i16_t __attribute__((ext_vector_type(4)));
typedef float f32x16 __attribute__((ext_vector_type(16)));
typedef float f32x32 __attribute__((ext_vector_type(32)));
typedef float f32x4 __attribute__((ext_vector_type(4)));
typedef float f32x2_t __attribute__((ext_vector_type(2)));
typedef __bf16 bf16x2_t __attribute__((ext_vector_type(2)));
typedef unsigned u32x4 __attribute__((ext_vector_type(4)));
#define ALAS __attribute__((address_space(3)))
typedef ALAS unsigned char* lptr;
constexpr int SEQ = 2048;
constexpr int LK = 0, LV = 32768, VSLOT = 8320, VDH = 4160, LBM = 66048, LWS = 74240, LOST = 76288, LBYTES = 109056;
constexpr float LOG2E = 1.4426950408889634f;
constexpr float THR = 8.0f;

__device__ __forceinline__ int crow(int r, int hi) { return (r & 3) + 8 * (r >> 2) + 4 * hi; }
__device__ __forceinline__ unsigned cvtpk_s(float lo, float hi) { f32x2_t v = {lo, hi}; bf16x2_t b = __builtin_convertvector(v, bf16x2_t); return __builtin_bit_cast(unsigned, b); }
__device__ __forceinline__ s16x4 vtr(lptr p) { return __builtin_bit_cast(s16x4, __builtin_amdgcn_ds_read_tr16_b64_v4i16((ALAS v4i16_t*)p)); }
__device__ __forceinline__ float bf_round(float f) { unsigned u = __float_as_uint(f); u = (u + 0x7fffu + ((u >> 16) & 1u)) & 0xffff0000u; return __uint_as_float(u); }
__device__ __forceinline__ unsigned fkey(float f) { const unsigned u = __float_as_uint(f); return u ^ ((unsigned)((int)u >> 31) | 0x80000000u); }
__device__ __forceinline__ int half_sum(int v) {
    v += __builtin_amdgcn_update_dpp(0, v, 0xB1, 0xF, 0xF, true);
    v += __builtin_amdgcn_update_dpp(0, v, 0x4E, 0xF, 0xF, true);
    v += __builtin_amdgcn_update_dpp(0, v, 0x141, 0xF, 0xF, true);
    v += __builtin_amdgcn_update_dpp(0, v, 0x140, 0xF, 0xF, true);
    auto rr = __builtin_amdgcn_permlane16_swap((unsigned)v, (unsigned)v, false, false);
    return (int)rr[0] + (int)rr[1];
}
__device__ __forceinline__ float relu1(float x) { const int i = __float_as_int(x); return __int_as_float(i > 0 ? i : 0); }
__device__ __forceinline__ void cnt4(int& c0, int& c1, float k0, float k1, float k2, float k3, float cand) {
    asm volatile("v_cmp_le_f32_e32 vcc, %6, %2\n\tv_addc_co_u32_e32 %0, vcc, 0, %0, vcc\n\tv_cmp_le_f32_e32 vcc, %6, %3\n\tv_addc_co_u32_e32 %1, vcc, 0, %1, vcc\n\t"
                 "v_cmp_le_f32_e32 vcc, %6, %4\n\tv_addc_co_u32_e32 %0, vcc, 0, %0, vcc\n\tv_cmp_le_f32_e32 vcc, %6, %5\n\tv_addc_co_u32_e32 %1, vcc, 0, %1, vcc"
                 : "+v"(c0), "+v"(c1) : "v"(k0), "v"(k1), "v"(k2), "v"(k3), "v"(cand) : "vcc");
}
__device__ __forceinline__ float dppf(float v, int ctl) { return ctl == 0 ? __uint_as_float(__builtin_amdgcn_update_dpp(0u, __float_as_uint(v), 0xB1, 0xF, 0xF, true)) : ctl == 1 ? __uint_as_float(__builtin_amdgcn_update_dpp(0u, __float_as_uint(v), 0x4E, 0xF, 0xF, true))
                                                        : ctl == 2 ? __uint_as_float(__builtin_amdgcn_update_dpp(0u, __float_as_uint(v), 0x141, 0xF, 0xF, true)) : __uint_as_float(__builtin_amdgcn_update_dpp(0u, __float_as_uint(v), 0x140, 0xF, 0xF, true)); }
__device__ __forceinline__ float half_max(float v) { v = __builtin_fmaxf(v, dppf(v, 0)); v = __builtin_fmaxf(v, dppf(v, 1)); v = __builtin_fmaxf(v, dppf(v, 2)); v = __builtin_fmaxf(v, dppf(v, 3));
    auto rr = __builtin_amdgcn_permlane16_swap(__float_as_uint(v), __float_as_uint(v), false, false); return __builtin_fmaxf(__uint_as_float(rr[0]), __uint_as_float(rr[1])); }
__device__ __forceinline__ float half_min(float v) { v = __builtin_fminf(v, dppf(v, 0)); v = __builtin_fminf(v, dppf(v, 1)); v = __builtin_fminf(v, dppf(v, 2)); v = __builtin_fminf(v, dppf(v, 3));
    auto rr = __builtin_amdgcn_permlane16_swap(__float_as_uint(v), __float_as_uint(v), false, false); return __builtin_fminf(__uint_as_float(rr[0]), __uint_as_float(rr[1])); }
#define MX3(a, b, c) __builtin_fmaxf(__builtin_fmaxf((a), (b)), (c))
__device__ __forceinline__ float rowmax(const f32x16& p0, const f32x16& p1) {
    float a = MX3(p0[0], p0[1], p1[0]), b = MX3(p0[2], p0[3], p1[1]); a = MX3(a, p1[2], p1[3]);
#pragma unroll
    for (int r = 4; r < 16; r += 4) { a = MX3(a, p0[r], p0[r + 1]); b = MX3(b, p0[r + 2], p0[r + 3]); a = MX3(a, p1[r], p1[r + 1]); b = MX3(b, p1[r + 2], p1[r + 3]); }
    float m = __builtin_fmaxf(a, b); auto rr = __builtin_amdgcn_permlane32_swap(__float_as_uint(m), __float_as_uint(m), false, false);
    return __builtin_fmaxf(__uint_as_float(rr[0]), __uint_as_float(rr[1])); }

struct Tensors { const bf16_t* Q; const bf16_t* K; const bf16_t* V; const bf16_t* QI; const bf16_t* KI; const float* WI; unsigned char* AP; float qk2; };

__device__ __forceinline__ u32x4 tile_ld(const bf16_t* base, long row0, int tid) { const unsigned voff = (unsigned)((tid >> 3) * 128 + (tid & 7) * 16); return *(const u32x4*)((const char*)(base + row0 * 64) + voff); }
__device__ __forceinline__ void kimg_st(lptr lds, int slot, int tid, u32x4 v) { const int row = tid >> 3, ch = tid & 7; *(ALAS u32x4*)(lds + LK + slot * 8192 + row * 128 + ((ch ^ ((row >> 1) & 7)) << 4)) = v; }
__device__ __forceinline__ void kimg_dma(lptr lds, int slot, int wid, int lane, const bf16_t* base, long row0) {
    const int row = 8 * wid + (lane >> 3), ch = (lane & 7) ^ ((row >> 1) & 7);
    __builtin_amdgcn_global_load_lds((const unsigned*)((const char*)(base + row0 * 64) + row * 128 + ch * 16), (ALAS unsigned*)(lds + LK + slot * 8192 + wid * 1024), 16, 0, 0);
}
__device__ __forceinline__ int kfrag_off(int r32, int hi, int d0) { return r32 * 128 + (((2 * d0 + hi) ^ ((r32 >> 1) & 7)) << 4); }
__device__ __forceinline__ void vimg_st(lptr lds, int slot, int tid, u32x4 v) { *(ALAS u32x4*)(lds + LV + slot * VSLOT + ((tid & 7) >> 2) * VDH + (tid >> 3) * 64 + (tid & 3) * 16) = v; }

struct UnitPF { bf16x8 qi[4]; f32x4 wv[4]; };
__device__ __forceinline__ void unit_prefetch(UnitPF& pf, int b, int qb, const Tensors& T, const int wave_s, lptr lds, const bool dma) {
    int tid = threadIdx.x; asm volatile("" : "+v"(tid));
    const int lane = tid & 63, r32 = lane & 31, hi = lane >> 5; const int wid = __builtin_amdgcn_readfirstlane(threadIdx.x >> 6);
    const int t0 = qb * 32, NT = (qb >> 1) + 1; const long rowbase = (long)b * SEQ; const long tq_row = rowbase + t0 + 4 * wid + (r32 >> 3);
#pragma unroll
    for (int d0 = 0; d0 < 4; ++d0) pf.qi[d0] = *(const bf16x8*)(T.QI + tq_row * 512 + (r32 & 7) * 64 + d0 * 16 + hi * 8);
#pragma unroll
    for (int g = 0; g < 4; ++g) pf.wv[g] = *(const f32x4*)(T.WI + (rowbase + t0 + 4 * wid + g) * 8 + 4 * hi);
    if (dma) {
#pragma unroll
        for (int t = 0; t < 4; ++t) if (t < NT) kimg_dma(lds, t, wid, lane, T.KI, rowbase + 64 * t);
    }
}
__device__ __forceinline__ void attn_unit(int b, int qb, const Tensors& T, lptr lds, UnitPF& pf, bool has_next, int nb, int nqb, const int wave_s) {
    int tid_ = threadIdx.x; asm volatile("" : "+v"(tid_));
    const int tid = tid_, lane = tid & 63, r32 = lane & 31, hi = lane >> 5; const int wid = __builtin_amdgcn_readfirstlane(threadIdx.x >> 6);
    const int t0 = qb * 32, NT = (qb >> 1) + 1;
    const long rowbase = (long)b * SEQ;
    const int g_row = r32 >> 3, h_row = r32 & 7;
    const long tq_row = rowbase + t0 + 4 * wid + g_row;

    f32x32 keyv[2][2];
#define KEY(j, n, pr) keyv[n][pr][j]
#ifndef REP_IDX
#define REP_IDX 1
#endif
#ifndef REP_SEL
#define REP_SEL 1
#endif
#ifndef REP_ATT
#define REP_ATT 1
#endif
#pragma unroll 1
    for (int rep_i = 0; rep_i < REP_IDX; ++rep_i) {
        bf16x8 qi[4]; f32x4 wv[4];
#pragma unroll
        for (int d0 = 0; d0 < 4; ++d0) { qi[d0] = pf.qi[d0]; wv[d0] = pf.wv[d0]; }
        const int lanev = r32 - hi;
        __syncthreads();
        int kfo0 = kfrag_off(r32, hi, 0); asm volatile("" : "+v"(kfo0));
        bf16x8 F[8];
#pragma unroll
        for (int q = 0; q < 8; ++q) F[q] = *(const ALAS bf16x8*)(lds + LK + (kfo0 ^ ((q >> 1) << 5)) + (q & 1) * 4096);
#pragma unroll
        for (int n = 0; n < 2; ++n) { keyv[n][0] = (f32x32)(__builtin_nanf("")); keyv[n][1] = (f32x32)(__builtin_nanf("")); }
#pragma unroll 1
        for (int jb = 0; jb < NT; jb += 2) {
#pragma unroll
            for (int u = 0; u < 2; ++u) {
                const int j = jb + u;
                if (u == 0 || j < NT) {
                    if (u == 0) {
                        if (j + 4 < NT) kimg_dma(lds, (j + 4) % 6, wid, lane, T.KI, rowbase + 64 * (j + 4));
                        if (j + 5 < NT) kimg_dma(lds, (j + 5) % 6, wid, lane, T.KI, rowbase + 64 * (j + 5));
                    }
                    f32x16 acc0 = {}, acc1 = {};
#pragma unroll
                    for (int d0 = 0; d0 < 4; ++d0) {
                        acc0 = __builtin_amdgcn_mfma_f32_32x32x16_f16(__builtin_bit_cast(f16x8, qi[d0]), __builtin_bit_cast(f16x8, F[2 * d0]), acc0, 0, 0, 0);
                        acc1 = __builtin_amdgcn_mfma_f32_32x32x16_f16(__builtin_bit_cast(f16x8, qi[d0]), __builtin_bit_cast(f16x8, F[2 * d0 + 1]), acc1, 0, 0, 0);
                    }
                    __builtin_amdgcn_sched_barrier(0);
                    if (j + 1 < NT) {
                        const int so = ((j + 1) % 6) * 8192;
#pragma unroll
                        for (int q = 0; q < 8; ++q) F[q] = *(const ALAS bf16x8*)(lds + LK + so + (kfo0 ^ ((q >> 1) << 5)) + (q & 1) * 4096);
                    }
                    __builtin_amdgcn_sched_barrier(0);
#pragma unroll
                    for (int n = 0; n < 2; ++n) {
                        const f32x16& acc = n ? acc1 : acc0;
                        float part[4];
#pragma unroll
                        for (int g = 0; g < 4; ++g) {
                            float s = wv[g][0] * relu1(acc[4 * g]);
                            s = __builtin_fmaf(wv[g][1], relu1(acc[4 * g + 1]), s);
                            s = __builtin_fmaf(wv[g][2], relu1(acc[4 * g + 2]), s);
                            s = __builtin_fmaf(wv[g][3], relu1(acc[4 * g + 3]), s);
                            part[g] = s;
                        }
#pragma unroll
                        for (int pr = 0; pr < 2; ++pr) {
                            auto rr = __builtin_amdgcn_permlane32_swap(__float_as_uint(part[2 * pr]), __float_as_uint(part[2 * pr + 1]), false, false);
                            const float v = __uint_as_float(rr[0]) + __uint_as_float(rr[1]);
                            const int urel = t0 + 4 * wid + 2 * pr - 64 * j - 32 * n;
                            KEY(j, n, pr) = (lanev <= urel) ? v : __builtin_nanf("");
                        }
                    }
                    if (u == 1) __syncthreads();
                }
            }
        }
        __syncthreads();
    }
    int tidL = tid; asm volatile("" : "+v"(tidL));
    const int lane3 = tidL & 63, r32c = lane3 & 31, hic = lane3 >> 5;
    const long tq_row3 = rowbase + t0 + 4 * wid + (r32c >> 3);
    bf16x8 qr[4];
#pragma unroll
    for (int d0 = 0; d0 < 4; ++d0) qr[d0] = *(const bf16x8*)(T.Q + tq_row3 * 512 + (r32c & 7) * 64 + d0 * 16 + hic * 8);
    u32x4 sk = tile_ld(T.K, rowbase + 64 * (NT - 1), tidL), sv = tile_ld(T.V, rowbase + 64 * (NT - 1), tidL);
    u32x4 sk2 = tile_ld(T.K, rowbase + 64 * (NT > 1 ? NT - 2 : 0), tidL), sv2 = tile_ld(T.V, rowbase + 64 * (NT > 1 ? NT - 2 : 0), tidL);
    u32x4 skA = tile_ld(T.K, rowbase + 64 * (NT > 2 ? NT - 3 : 0), tidL), svA = tile_ld(T.V, rowbase + 64 * (NT > 2 ? NT - 3 : 0), tidL);
    u32x4 skB = tile_ld(T.K, rowbase + 64 * (NT > 3 ? NT - 4 : 0), tidL), svB = tile_ld(T.V, rowbase + 64 * (NT > 3 ? NT - 4 : 0), tidL);
    ALAS unsigned* bm = (ALAS unsigned*)(lds + LBM) + wid * 256;
#pragma unroll 1
    for (int rep_s = 0; rep_s < REP_SEL; ++rep_s) {
        float Tk[2], lo[2], hi2[2], fl[2], fh[2]; bool done[2], conv[2], strad[2]; int nq[2], side[2];
#pragma unroll
        for (int pr = 0; pr < 2; ++pr) {
            nq[pr] = t0 + 4 * wid + 2 * pr + hi + 1;
            Tk[pr] = -__builtin_inff(); done[pr] = (nq[pr] <= 256); conv[pr] = done[pr]; lo[pr] = 0.f; hi2[pr] = 0.f; strad[pr] = false;
            fl[pr] = __builtin_amdgcn_logf((float)nq[pr]) - 8.0028150f; fh[pr] = -9.0028150f; side[pr] = 0;
        }
        if (!__all(done[0] && done[1])) {
#pragma unroll
            for (int pr = 0; pr < 2; ++pr) {
                float vmax = -__builtin_inff(), vmin = __builtin_inff();
#pragma unroll
                for (int jg = 0; jg < 8; ++jg) if (4 * jg < NT) {
#pragma unroll
                    for (int q = 0; q < 4; ++q)
#pragma unroll
                        for (int n = 0; n < 2; ++n) { vmax = __builtin_fmaxf(vmax, KEY(4 * jg + q, n, pr)); vmin = __builtin_fminf(vmin, KEY(4 * jg + q, n, pr)); }
                }
                lo[pr] = half_min(vmin); float h = half_max(vmax);
                { const int hb = __float_as_int(h); h = (h == 0.f) ? 1.4e-45f : __int_as_float(hb + (hb >= 0 ? 1 : -1)); }
                hi2[pr] = h;
                strad[pr] = (lo[pr] < 0.f) & (h > 0.f);
            }
#pragma unroll 1
            for (int it = 0; it < 96; ++it) {
                float mid[2];
#pragma unroll
                for (int pr = 0; pr < 2; ++pr) {
                    float m = lo[pr] + (hi2[pr] - lo[pr]) * (fl[pr] * __builtin_amdgcn_rcpf(fl[pr] - fh[pr]));
                    const float mb = 0.5f * lo[pr] + 0.5f * hi2[pr];
                    const bool in1 = (m > lo[pr]) & (m < hi2[pr]);
                    m = ((it >= 14) | !in1) ? mb : m;
                    if (it == 0) m = strad[pr] ? ((hi2[pr] > 1.4e-45f) ? 1.4e-45f : 0.f) : m;
                    if (it == 1) m = (strad[pr] & (hi2[pr] == 1.4e-45f) & (lo[pr] < 0.f)) ? 0.f : m;
                    const bool in2 = (m > lo[pr]) & (m < hi2[pr]);
                    conv[pr] = conv[pr] | !in2 | done[pr];
                    mid[pr] = m;
                }
                if (__all(conv[0] & conv[1])) break;
                int c0a = 0, c0b = 0, c1a = 0, c1b = 0;
#pragma unroll
                for (int jg = 0; jg < 8; ++jg) if (4 * jg < NT) {
                    cnt4(c0a, c0b, KEY(4 * jg, 0, 0), KEY(4 * jg, 1, 0), KEY(4 * jg + 1, 0, 0), KEY(4 * jg + 1, 1, 0), mid[0]);
                    cnt4(c1a, c1b, KEY(4 * jg, 0, 1), KEY(4 * jg, 1, 1), KEY(4 * jg + 1, 0, 1), KEY(4 * jg + 1, 1, 1), mid[1]);
                    cnt4(c0a, c0b, KEY(4 * jg + 2, 0, 0), KEY(4 * jg + 2, 1, 0), KEY(4 * jg + 3, 0, 0), KEY(4 * jg + 3, 1, 0), mid[0]);
                    cnt4(c1a, c1b, KEY(4 * jg + 2, 0, 1), KEY(4 * jg + 2, 1, 1), KEY(4 * jg + 3, 0, 1), KEY(4 * jg + 3, 1, 1), mid[1]);
                }
                int c[2]; c[0] = half_sum(c0a + c0b); c[1] = half_sum(c1a + c1b);
#pragma unroll
                for (int pr = 0; pr < 2; ++pr) {
                    const bool ge = (c[pr] >= 256), ul = !conv[pr] & ge, uh = !conv[pr] & !ge;
                    const float fc = __builtin_amdgcn_logf((float)c[pr] + (ge ? 0.f : 0.5f)) - 8.0028150f;
                    const float fhn = ul ? ((side[pr] > 0) ? 0.5f * fh[pr] : fh[pr]) : (uh ? fc : fh[pr]), fln = uh ? ((side[pr] < 0) ? 0.5f * fl[pr] : fl[pr]) : (ul ? fc : fl[pr]);
                    fh[pr] = fhn; fl[pr] = fln; side[pr] = ul ? 1 : (uh ? -1 : side[pr]);
                    lo[pr] = ul ? mid[pr] : lo[pr]; hi2[pr] = uh ? mid[pr] : hi2[pr]; done[pr] = done[pr] | (ul & (c[pr] == 256));
                }
            }
#pragma unroll
            for (int pr = 0; pr < 2; ++pr) { Tk[pr] = lo[pr]; if (nq[pr] <= 256) { Tk[pr] = -__builtin_inff(); done[pr] = true; } }
        }
#pragma unroll
        for (int pr = 0; pr < 2; ++pr) {
        if (__all(done[pr])) {
#pragma unroll
            for (int jh = 0; jh < 2; ++jh) if (16 * jh < NT) {
                unsigned wx = 0u;
#pragma unroll
                for (int j = 16 * jh; j < 16 * jh + 16; ++j) if (j < NT) {
#pragma unroll
                    for (int n = 0; n < 2; ++n) {
                        const unsigned long long pb = __ballot(KEY(j, n, pr) >= Tk[pr]);
                        asm volatile("s_nop 1\n\tv_writelane_b32 %0, %1, %3\n\tv_writelane_b32 %0, %2, %4" : "+v"(wx) : "s"((unsigned)pb), "s"((unsigned)(pb >> 32)), "i"(2 * (j & 15) + n), "i"(32 + 2 * (j & 15) + n));
                    }
                }
                bm[(32 * jh + r32) * 4 + 2 * pr + hi] = wx;
            }
        } else {
        int gt = 0;
#pragma unroll
        for (int j = 0; j < 32; ++j) if (j < NT) { gt += (KEY(j, 0, pr) > Tk[pr]) ? 1 : 0; gt += (KEY(j, 1, pr) > Tk[pr]) ? 1 : 0; }
        gt = half_sum(gt);
        const int need = 256 - gt; int seen = 0;
#pragma unroll
        for (int j = 0; j < 32; ++j) if (j < NT) {
#pragma unroll
            for (int n = 0; n < 2; ++n) {
                const float k = KEY(j, n, pr); const bool eq = (k == Tk[pr]);
                const unsigned long long bal = __ballot(eq);
                const unsigned mine = hi ? (unsigned)(bal >> 32) : (unsigned)bal;
                const int before = __popc(mine & ((1u << r32) - 1u));
                const bool pick = (k > Tk[pr]) || (eq && (seen + before < need));
                const unsigned long long pb = __ballot(pick);
                if (r32 == 0) bm[(2 * j + n) * 4 + 2 * pr + hi] = hi ? (unsigned)(pb >> 32) : (unsigned)pb;
                seen += __popc(mine);
            }
        }
        }
        }
    }
    const int laneA = mk_lane() & 63, r32a = laneA & 31, hia = laneA >> 5, tidA = wid * 64 + laneA;
    const int h_c = r32a & 7, g_c = r32a >> 3;
    bf16x8 qx;
    {
        const float c1 = bf_round(LOG2E), c2 = bf_round(LOG2E - c1), c3 = bf_round((LOG2E - c1) - c2), sc = __builtin_amdgcn_exp2f(-(float)(h_c + 1));
        const unsigned a1 = __float_as_uint(c1 * sc) >> 16, a2 = __float_as_uint(c2 * sc) >> 16, a3 = __float_as_uint(c3 * sc) >> 16, one = 0x3F80u;
        u32x4 w;
        w.x = hia ? ((g_c == 0 ? one : 0u) | ((g_c == 1 ? one : 0u) << 16)) : (a1 | (a2 << 16));
        w.y = hia ? ((g_c == 2 ? one : 0u) | ((g_c == 3 ? one : 0u) << 16)) : (a3 | (a1 << 16));
        w.z = hia ? 0u : (a2 | (a3 << 16)); w.w = 0u;
        qx = __builtin_bit_cast(bf16x8, w);
    }
    unsigned spk[2];
#pragma unroll
    for (int n = 0; n < 2; ++n) { const unsigned s = __float_as_uint((float)(32 * n + r32a)) >> 16; spk[n] = s | (s << 16); }
    const unsigned hmc = 0u - (unsigned)hia; unsigned spkz[2];
#pragma unroll
    for (int n = 0; n < 2; ++n) spkz[n] = (spk[n] & ~hmc) | (0x3F803F80u & hmc);
    const unsigned kww = 0x3F80u & hmc;
    const unsigned nhm = ~hmc, Klo = hmc & 0x0000C680u, Khi = hmc & 0xC6800000u;
    unsigned spkh0[2];
#pragma unroll
    for (int n = 0; n < 2; ++n) spkh0[n] = spk[n] & 0xffff0000u & nhm;
    ALAS float* wsf = (ALAS float*)(lds + LWS) + wid * 64;
    const ALAS u32x4* bmw = (const ALAS u32x4*)((ALAS unsigned*)(lds + LBM) + wid * 256);
    float mhat = 0.f; f32x16 o[2]; o[0] = f32x16{}; o[1] = f32x16{};
    const bool fastok = (T.qk2 < 100.f); bool need = true;
    f32x16 ol = f32x16{};
    const bf16x8 ones8 = __builtin_bit_cast(bf16x8, (u32x4){0x3F803F80u, 0x3F803F80u, 0x3F803F80u, 0x3F803F80u});
#pragma unroll 1
    for (int rep_a = 0; rep_a < REP_ATT; ++rep_a) {
        mhat = 0.f; ol = f32x16{}; o[0] = f32x16{}; o[1] = f32x16{}; need = true;
        kimg_st(lds, 0, tidA, sk); vimg_st(lds, 0, tidA, sv);
        if (NT > 1) { kimg_st(lds, 1, tidA, sk2); vimg_st(lds, 1, tidA, sv2); }
        __syncthreads();
#pragma unroll 1
        for (int jb = 0; jb < NT; jb += 2) {
#pragma unroll
          for (int u = 0; u < 2; ++u) {
            const int jj = jb + u;
            if (u == 0 || jj < NT) {
            const int j = NT - 1 - jj, slot = jj & 3;
            if (u == 0) {
                if (jj + 2 < NT) { kimg_st(lds, (jj + 2) & 3, tidA, skA); vimg_st(lds, (jj + 2) & 3, tidA, svA); }
                if (jj + 3 < NT) { kimg_st(lds, (jj + 3) & 3, tidA, skB); vimg_st(lds, (jj + 3) & 3, tidA, svB); }
                int tl = tidA; asm volatile("" : "+v"(tl));
                if (jj + 4 < NT) { skA = tile_ld(T.K, rowbase + 64 * (j - 4), tl); svA = tile_ld(T.V, rowbase + 64 * (j - 4), tl); }
                if (jj + 5 < NT) { skB = tile_ld(T.K, rowbase + 64 * (j - 5), tl); svB = tile_ld(T.V, rowbase + 64 * (j - 5), tl); }
            }
            const unsigned pp = __float_as_uint((float)(-64 * jj)) >> 16, ppk = pp | (pp << 16);
            const unsigned ppk0 = ppk & nhm, pp0 = pp & nhm;
            bf16x8 kx[2];
#pragma unroll
            for (int n = 0; n < 2; ++n) {
                const u32x4 W = bmw[2 * j + n];
                const unsigned m0 = (unsigned)__builtin_amdgcn_sbfe((int)W.x, (unsigned)r32a, 1u), m1 = (unsigned)__builtin_amdgcn_sbfe((int)W.y, (unsigned)r32a, 1u);
                const unsigned m2 = (unsigned)__builtin_amdgcn_sbfe((int)W.z, (unsigned)r32a, 1u), m3 = (unsigned)__builtin_amdgcn_sbfe((int)W.w, (unsigned)r32a, 1u);
                u32x4 w;
                w.x = (~m1 & Khi) | ((~m0 & Klo) | ppk0); w.y = (~m3 & Khi) | ((~m2 & Klo) | (pp0 | spkh0[n])); w.z = spkz[n]; w.w = kww;
                kx[n] = __builtin_bit_cast(bf16x8, w);
            }
            f32x16 p0 = f32x16{}, p1 = f32x16{};
#pragma unroll
            for (int d0 = 0; d0 < 4; ++d0) {
                const bf16x8 k0 = *(const ALAS bf16x8*)(lds + LK + slot * 8192 + kfrag_off(r32a, hia, d0));
                const bf16x8 k1 = *(const ALAS bf16x8*)(lds + LK + slot * 8192 + kfrag_off(r32a, hia, d0) + 4096);
                p0 = __builtin_amdgcn_mfma_f32_32x32x16_bf16(k0, qr[d0], p0, 0, 0, 0);
                p1 = __builtin_amdgcn_mfma_f32_32x32x16_bf16(k1, qr[d0], p1, 0, 0, 0);
            }
            p0 = __builtin_amdgcn_mfma_f32_32x32x16_bf16(kx[0], qx, p0, 0, 0, 0);
            p1 = __builtin_amdgcn_mfma_f32_32x32x16_bf16(kx[1], qx, p1, 0, 0, 0);
            if (need) {
            const float rm = rowmax(p0, p1);
            const bool first = (jj == 0);
            const float dl = first ? __builtin_fmaxf(rm, -2048.f) : (rm > THR ? rm : 0.f);
            if (first || __any(dl != 0.f)) {
                const float f = first ? 1.f : __builtin_amdgcn_exp2f(-dl);
                mhat += dl;
#pragma unroll
                for (int r = 0; r < 16; ++r) { p0[r] -= dl; p1[r] -= dl; }
                { const unsigned x0 = __float_as_uint(-mhat), t1 = x0 & 0xffff0000u; const float r1 = __uint_as_float(x0) - __uint_as_float(t1); const unsigned t2 = __float_as_uint(r1) & 0xffff0000u;
                  const float r2 = r1 - __uint_as_float(t2); const unsigned t3 = __float_as_uint(r2) & 0xffff0000u;
                  u32x4 w = __builtin_bit_cast(u32x4, qx); w.z = hia ? ((t1 >> 16) | t2) : w.z; w.w = hia ? (t3 >> 16) : w.w; qx = __builtin_bit_cast(bf16x8, w); }
                if (hia == 0) wsf[r32a] = f;
                asm volatile("s_waitcnt lgkmcnt(0)" ::: "memory");
#pragma unroll
                for (int r = 0; r < 16; ++r) { const float fr_ = wsf[crow(r, hia)]; o[0][r] *= fr_; o[1][r] *= fr_; ol[r] *= fr_; }
            }
            need = !fastok || __any(mhat <= -2047.f);
            }
            const lptr vb = lds + LV + slot * VSLOT + ((laneA >> 4) & 1) * 32 + (laneA & 3) * 8 + (4 * hia + ((laneA & 15) >> 2)) * 64;
#pragma unroll
            for (int half = 0; half < 2; ++half) {
                f32x16& ph = half ? p1 : p0;
#pragma unroll
                for (int r = 0; r < 16; ++r) ph[r] = __builtin_amdgcn_exp2f(ph[r]);
                u32x4 pw[2];
#pragma unroll
                for (int q = 0; q < 4; ++q) { pw[0][q] = cvtpk_s(ph[2 * q], ph[2 * q + 1]); pw[1][q] = cvtpk_s(ph[8 + 2 * q], ph[8 + 2 * q + 1]); }
#pragma unroll
                for (int kk = 0; kk < 2; ++kk) {
                    const int ks = 2 * half + kk;
#pragma unroll
                    for (int d0 = 0; d0 < 2; ++d0) {
                        const s16x4 lo = vtr(vb + d0 * VDH + ks * 1024), hh = vtr(vb + d0 * VDH + ks * 1024 + 512);
                        const bf16x8 vf = (bf16x8){lo[0], lo[1], lo[2], lo[3], hh[0], hh[1], hh[2], hh[3]};
                        o[d0] = __builtin_amdgcn_mfma_f32_32x32x16_bf16(__builtin_bit_cast(bf16x8, pw[kk]), vf, o[d0], 0, 0, 0);
                    }
                    ol = __builtin_amdgcn_mfma_f32_32x32x16_bf16(__builtin_bit_cast(bf16x8, pw[kk]), ones8, ol, 0, 0, 0);
                }
                if (half == 0) __builtin_amdgcn_sched_barrier(0);
            }
            if (u == 1) __syncthreads();
            }
          }
        }
        __syncthreads();
    }
    unit_prefetch(pf, has_next ? nb : b, has_next ? nqb : qb, T, wave_s, lds, has_next);
    ALAS unsigned char* stg = lds + LOST + wid * 4096;
#pragma unroll
    for (int r = 0; r < 16; ++r) {
        const int orow = crow(r, hia); const float rl = __builtin_amdgcn_rcpf(ol[r]);
#pragma unroll
        for (int d0 = 0; d0 < 2; ++d0) { const float ov = o[d0][r] * rl; stg[orow * 64 + d0 * 32 + r32a] = (unsigned char)(__builtin_amdgcn_cvt_pk_fp8_f32(ov, ov, 0u, false) & 0xffu); }
    }
    asm volatile("s_waitcnt lgkmcnt(0)" ::: "memory");
    int laneE = laneA; asm volatile("" : "+v"(laneE));
#pragma unroll
    for (int i = 0; i < 2; ++i) {
        const int row = i * 16 + (laneE >> 2), ch = laneE & 3;
        const u32x4 v = *(const ALAS u32x4*)(stg + row * 64 + ch * 16);
        *(u32x4*)(T.AP + (rowbase + t0 + 4 * wid + (row >> 3)) * 1024 + (row & 7) * 64 + ch * 16) = v;
    }
    __syncthreads();
}
#undef KEY
#undef MX3
}

constexpr int NWAVES = 8;
constexpr int D = 1024, NB = 16, SEQ = 2048, TOK = NB * SEQ, FF = 2816, DIN = 3784, N1 = 3840, N5 = 5632;
constexpr int OQ = 0, OKK = 512, OV = 576, OQI = 640, OKI = 1152, OWI = 1216, OU = 1224, OG = 1736;
constexpr float EPS = 1e-6f;
constexpr size_t MiB = 1u << 20;
constexpr size_t WS_CTL = 0, CTL_ZERO_BYTES = 64 * 1024;
constexpr size_t WS_W1T = 2 * MiB, WS_W3T = 10 * MiB, WS_W4T = 12 * MiB, WS_W5T = 14 * MiB, WS_W6T = 26 * MiB, WS_WP = 32 * MiB;
constexpr size_t WS_RSTD = 34 * MiB, WS_WI = 35 * MiB, WS_SSQ = 36 * MiB, WS_K = 38 * MiB, WS_V = 42 * MiB, WS_KI = 46 * MiB;
constexpr size_t WS_R = 52 * MiB, WS_SP = 116 * MiB, WS_AP = 180 * MiB, WS_XB = 244 * MiB, WS_Q = 308 * MiB, WS_QI = 340 * MiB, WS_U = 372 * MiB, WS_H2 = 436 * MiB, WS_END = 500 * MiB;
constexpr size_t WS_MG = WS_U;
constexpr size_t WS_ACT = WS_R;
constexpr size_t WS_XF8 = WS_AP;
constexpr size_t WS_W1T8 = WS_W1T + 4 * MiB;
constexpr size_t WS_H2F8 = WS_AP;
static_assert(WS_ACT + (size_t)TOK * 4096 <= WS_AP, "act overlay");
constexpr int CW_BAR = 1024;
constexpr int RING_BYTES = 131072, LDSCTL_OFF = RING_BYTES, MISC_OFF = LDSCTL_OFF + 320, LDS_BYTES = 147456;
static_assert(att::LBYTES <= RING_BYTES, "attention scratch inside the ring region");

#define LAS __attribute__((address_space(3)))
#define GAS __attribute__((address_space(1)))
typedef unsigned short bf16;
typedef unsigned v4u __attribute__((ext_vector_type(4)));
typedef float f32x4 __attribute__((ext_vector_type(4)));
#define LDS_WAIT() asm volatile("s_waitcnt lgkmcnt(0)" ::: "memory")
__device__ __forceinline__ unsigned pk2(float lo, float hi) { return pg8::cvt_pk_bf16(lo, hi); }
__device__ __forceinline__ float wave_sum(float v) {
#pragma unroll
    for (int o = 1; o < 64; o <<= 1) v += __shfl_xor(v, o);
    return v;
}

#define XB_TMO      128
#define XB_XCNT(j)  (256  + 64 * (j))
#define XB_XSUB(j)  (1280 + 64 * (j))
#define XB_XGEN(j)  (2304 + 64 * (j))
#define XB_TOP      3328
#define XB_TOPGEN   3392
#define XCD_BAR_WORDS 3456
#define XB_GM(g)    (3520 + 64 * (g))
#define XB_SPIN_CAP (1u << 18)

__device__ __forceinline__ unsigned xb_ld(unsigned* p)              { return __hip_atomic_load(p, __ATOMIC_RELAXED, __HIP_MEMORY_SCOPE_AGENT); }
__device__ __forceinline__ unsigned xb_add(unsigned* p, unsigned v) { return __hip_atomic_fetch_add(p, v, __ATOMIC_RELAXED, __HIP_MEMORY_SCOPE_AGENT); }
__device__ __forceinline__ unsigned xb_xcc_id() { return (unsigned)__builtin_amdgcn_s_getreg((3 << 11) | 20) & 0xFu; }
#define XB_SPIN(cond, bar) do { unsigned _sp = 0; while (cond) { __builtin_amdgcn_s_sleep(1); \
    if ((++_sp & 255u) == 0u) { if (xb_ld(&(bar)[XB_TMO])) break; if (_sp > XB_SPIN_CAP) { atomicAdd(&(bar)[XB_TMO], 1u); break; } } } } while (0)

struct XcdBarrier {
    unsigned* bar; unsigned x;
    int lead;
    volatile LAS unsigned* st;
};

__device__ __forceinline__ XcdBarrier xcd_barrier_post(unsigned* bar, volatile LAS unsigned* st, const int wave_s) {
    XcdBarrier b; b.bar = bar; b.x = xb_xcc_id(); b.st = st; b.lead = (wave_s == 0) ? 1 : 0;
    if (b.lead && mk_lane() == 0) { (void)__hip_atomic_fetch_or(&bar[XB_GM(blockIdx.x & 7u)], 1u << b.x, __ATOMIC_RELAXED, __HIP_MEMORY_SCOPE_AGENT); (void)xb_add(&bar[XB_XCNT(b.x)], 1u); }
    return b;
}
__device__ __forceinline__ void xcd_barrier_complete(unsigned* bar, unsigned x, unsigned& nloc, unsigned& nx) {
    const unsigned G = gridDim.x * gridDim.y * gridDim.z;
    unsigned sum, cnt, mine, sp = 0u;
    for (;;) {
        sum = 0u; cnt = 0u; mine = 0u;
#pragma unroll
        for (unsigned j = 0; j < 16; ++j) { const unsigned c = xb_ld(&bar[XB_XCNT(j)]); sum += c; cnt += (c > 0u) ? 1u : 0u; mine = (j == x) ? c : mine; }
        if (sum == G) break;
        __builtin_amdgcn_s_sleep(1);
        if ((++sp & 255u) == 0u) { if (xb_ld(&bar[XB_TMO])) break; if (sp > XB_SPIN_CAP) { atomicAdd(&bar[XB_TMO], 1u); break; } }
    }
    nloc = mine > 0u ? mine : 1u; nx = cnt > 0u ? cnt : 1u;
}

__device__ __forceinline__ void xcd_barrier(const XcdBarrier& b, const bool want_local) {
    asm volatile("s_waitcnt vmcnt(0)" ::: "memory");
    __syncthreads();
    if (b.lead && mk_lane() == 0) {
        unsigned* bar = b.bar;
        __builtin_amdgcn_s_waitcnt(0);
        unsigned nloc = b.st[0], nx = b.st[1];
        if (nloc == 0u) { xcd_barrier_complete(bar, b.x, nloc, nx); b.st[0] = nloc; b.st[1] = nx; }
        const unsigned old = xb_add(&bar[XB_XSUB(b.x)], 1u);
        const unsigned gen = old / nloc;
        const bool local = want_local && (b.st[2] == 1u);
        if (old + 1u == (gen + 1u) * nloc && local) {
            __builtin_amdgcn_fence(__ATOMIC_ACQUIRE, "agent");
            xb_add(&bar[XB_XGEN(b.x)], 1u);
            asm volatile("s_waitcnt vmcnt(0)" ::: "memory");
        } else if (old + 1u == (gen + 1u) * nloc) {
            __builtin_amdgcn_fence(__ATOMIC_RELEASE, "agent");
            asm volatile("s_waitcnt vmcnt(0)" ::: "memory");
            const unsigned og = xb_add(&bar[XB_TOP], 1u);
            const unsigned tg = og / nx;
            if (og + 1u == (tg + 1u) * nx) xb_add(&bar[XB_TOPGEN], 1u);
            else XB_SPIN(xb_ld(&bar[XB_TOPGEN]) == tg, bar);
            __builtin_amdgcn_fence(__ATOMIC_ACQUIRE, "agent");
            xb_add(&bar[XB_XGEN(b.x)], 1u);
            asm volatile("s_waitcnt vmcnt(0)" ::: "memory");
        } else {
            XB_SPIN(xb_ld(&bar[XB_XGEN(b.x)]) == gen, bar);
            __builtin_amdgcn_fence(__ATOMIC_ACQUIRE, "agent");
            asm volatile("s_waitcnt vmcnt(0)" ::: "memory");
        }
        if (b.st[2] == 0u) {
            unsigned all = 0u; bool ok = (gridDim.x == 256u);
#pragma unroll
            for (unsigned g = 0; g < 8; ++g) { const unsigned m = xb_ld(&bar[XB_GM(g)]); ok = ok && (m != 0u) && ((m & (m - 1u)) == 0u) && ((all & m) == 0u); all |= m; }
            b.st[2] = ok ? 1u : 2u;
        }
    }
    __syncthreads();
}

struct Args { const float* in[14]; float* out; unsigned char* ws; int ph_lo, ph_hi; };

template <int FMT>
__device__ __forceinline__ void tr_item(const float* W, int ldw, int k0, int c0, int nvalid, const float* gain, float scale, void* WTv, int ldt, int drow0, int dk0, LAS float* scr, int lane) {
    const int j = lane & 31;
    float tv[32];
#pragma unroll
    for (int i = 0; i < 32; ++i) { const int kk = 2 * i + (lane >> 5); tv[i] = (j < nvalid) ? W[(size_t)(k0 + kk) * ldw + c0 + j] : 0.f; }
#pragma unroll
    for (int i = 0; i < 32; ++i) { const int kk = 2 * i + (lane >> 5); float v = tv[i] * scale; if (gain) v *= gain[k0 + kk]; scr[kk * 33 + j] = v; }
    LDS_WAIT(); asm volatile("" ::: "memory");
    if (FMT == 2) {
        unsigned char* WT = (unsigned char*)WTv; const int c = lane & 3;
#pragma unroll
        for (int jj = 0; jj < 2; ++jj) { const int n = (lane >> 2) + 16 * jj; const LAS float* s = scr + (16 * c) * 33 + n;
            v4u o; o.x = pg8::pk4_fp8(s[0 * 33], s[1 * 33], s[2 * 33], s[3 * 33]); o.y = pg8::pk4_fp8(s[4 * 33], s[5 * 33], s[6 * 33], s[7 * 33]);
            o.z = pg8::pk4_fp8(s[8 * 33], s[9 * 33], s[10 * 33], s[11 * 33]); o.w = pg8::pk4_fp8(s[12 * 33], s[13 * 33], s[14 * 33], s[15 * 33]);
            *(v4u*)(WT + (size_t)(drow0 + n) * ldt + dk0 + k0 + 16 * c) = o; }
    } else {
        bf16* WT = (bf16*)WTv; const int c = lane & 7;
#pragma unroll
        for (int jj = 0; jj < 4; ++jj) { const int n = (lane >> 3) + 8 * jj; const LAS float* s = scr + (8 * c) * 33 + n;
            v4u o;
            if (FMT == 1) { o.x = pg8::cvt_pk_f16(s[0 * 33], s[1 * 33]); o.y = pg8::cvt_pk_f16(s[2 * 33], s[3 * 33]); o.z = pg8::cvt_pk_f16(s[4 * 33], s[5 * 33]); o.w = pg8::cvt_pk_f16(s[6 * 33], s[7 * 33]); }
            else { o.x = pk2(s[0 * 33], s[1 * 33]); o.y = pk2(s[2 * 33], s[3 * 33]); o.z = pk2(s[4 * 33], s[5 * 33]); o.w = pk2(s[6 * 33], s[7 * 33]); }
            *(v4u*)(WT + (size_t)(drow0 + n) * ldt + dk0 + k0 + 8 * c) = o; }
    }
    LDS_WAIT(); asm volatile("" ::: "memory");
}
__device__ __forceinline__ void w1_map(int rg, int& c0, int& nvalid) {
    const int n0 = rg * 32, pn = n0 >> 8, c = n0 & 255, bj = c >> 7, wc = (c & 127) >> 5; nvalid = 32;
    if (pn < 2) c0 = OQ + (pn * 4 + wc) * 64 + 32 * bj;
    else if (pn == 2) { if (wc == 0) c0 = OKK + 32 * bj; else if (wc == 1) c0 = OV + 32 * bj; else if (wc == 2) c0 = OKI + 32 * bj; else { c0 = OWI; nvalid = bj == 0 ? 8 : 0; } }
    else if (pn < 5) c0 = OQI + ((pn - 3) * 4 + wc) * 64 + 32 * bj;
    else if (pn < 7) c0 = OU + (pn - 5) * 256 + c;
    else c0 = OG + bj * 1024 + (pn - 7) * 128 + (c & 127);
}

__device__ __forceinline__ unsigned unit_tab(int s) {
    unsigned r = 0x0c132c2fu;
    r = (s == 1) ? 0x031d293au : r;
    r = (s == 2) ? 0x0e1c2628u : r;
    r = (s == 3) ? 0x12212224u : r;
    r = (s == 4) ? 0x090d2e36u : r;
    r = (s == 5) ? 0x041e2b35u : r;
    r = (s == 6) ? 0x0b10253bu : r;
    r = (s == 7) ? 0x14161f30u : r;
    r = (s == 8) ? 0x07202338u : r;
    r = (s == 9) ? 0x02173139u : r;
    r = (s == 10) ? 0x08191b3eu : r;
    r = (s == 11) ? 0x0111333fu : r;
    r = (s == 12) ? 0x00183237u : r;
    r = (s == 13) ? 0x060a343du : r;
    r = (s == 14) ? 0x0f1a272au : r;
    r = (s == 15) ? 0x05152d3cu : r;
    return r;
}

template <int W>
__device__ __forceinline__ void pool_win(const bf16* Ub, unsigned char* AP, int tb, int tin, int c0) {
    v4u rows[W + 15];
#pragma unroll
    for (int r = 0; r < W + 15; ++r) { const int rel = r - (W - 1); rows[r] = (tin + rel >= 0) ? *(const v4u*)(Ub + (size_t)(tb + rel) * 512 + c0) : (v4u){0u, 0u, 0u, 0u}; }
    float sum[8];
#pragma unroll
    for (int e = 0; e < 8; ++e) sum[e] = 0.f;
#pragma unroll
    for (int r = 0; r < W - 1; ++r) { f32x4 a, b_; pg8::unpack8(rows[r], a, b_);
#pragma unroll
        for (int e = 0; e < 4; ++e) { sum[e] += a[e]; sum[4 + e] += b_[e]; } }
#pragma unroll
    for (int tt = 0; tt < 16; ++tt) {
        const int t = tin + tt; f32x4 a, b_; pg8::unpack8(rows[W - 1 + tt], a, b_);
#pragma unroll
        for (int e = 0; e < 4; ++e) { sum[e] += a[e]; sum[4 + e] += b_[e]; }
        if (tt > 0) { f32x4 a2, b2; pg8::unpack8(rows[tt - 1], a2, b2);
#pragma unroll
            for (int e = 0; e < 4; ++e) { sum[e] -= a2[e]; sum[4 + e] -= b2[e]; } }
        const float inv = 1.0f / (float)((t + 1 < W) ? t + 1 : W);
        f32x4 d0, d1;
#pragma unroll
        for (int e = 0; e < 4; ++e) { d0[e] = sum[e] * inv - a[e]; d1[e] = sum[4 + e] * inv - b_[e]; }
        *(unsigned long long*)(AP + (size_t)(tb + tt) * 1024 + 512 + c0) = pg8::pack8_fp8(d0, d1);
    }
}

__global__ void __launch_bounds__(NWAVES * 64, 2) mk_fwd(Args args) {
    extern __shared__ __attribute__((aligned(16))) unsigned char lds_raw[];
    LAS unsigned char* lds = (LAS unsigned char*)lds_raw;
    volatile LAS unsigned* MISC = (volatile LAS unsigned*)(lds + MISC_OFF);
    const int wave = __builtin_amdgcn_readfirstlane(threadIdx.x >> 6);
    const int G = gridDim.x; const int bx = blockIdx.x; const int vcu = (G % 8 == 0) ? (bx % 8) * (G / 8) + bx / 8 : bx;
    unsigned char* ws = args.ws;
    for (int u = wave * 64 + mk_lane(); u < (LDS_BYTES - LDSCTL_OFF) / 4; u += NWAVES * 64) ((LAS unsigned*)(lds + LDSCTL_OFF))[u] = 0u;
    __syncthreads();
    XcdBarrier bar; bar.bar = (unsigned*)(ws + WS_CTL) + CW_BAR; bar.x = 0; bar.st = nullptr; bar.lead = 0;
    if (!MK_PER_PHASE) bar = xcd_barrier_post((unsigned*)(ws + WS_CTL) + CW_BAR, MISC + 8, wave);
#define GRID_BAR() do { if (!MK_PER_PHASE) xcd_barrier(bar, false); } while (0)
#define GRID_BAR_L() do { if (!MK_PER_PHASE) xcd_barrier(bar, true); } while (0)
    const int lo = args.ph_lo, hi_ = args.ph_hi;
#define IN(k) (lo <= (k) && (k) < hi_)
#define BOTH(k) (IN(k) && IN((k) + 1))
    const int gw = vcu * NWAVES + wave, NGW = G * NWAVES;

    if (IN(0)) {
        const float* x = args.in[0]; const float* norm_mix = args.in[1]; const float* w_in = args.in[2]; const float* w_pg = args.in[5]; const float* pool_scale = args.in[6];
        const float* w_ba = args.in[7]; const float* w_bp = args.in[8]; const float* w_out = args.in[9]; const float* norm_ffn = args.in[10]; const float* w_g = args.in[11]; const float* w_u = args.in[12]; const float* w_d = args.in[13];
        bf16* W1T = (bf16*)(ws + WS_W1T); unsigned char* W3T = ws + WS_W3T; unsigned char* W4T = ws + WS_W4T; unsigned char* W5T = ws + WS_W5T; unsigned char* W6T = ws + WS_W6T;
        float* RSTD = (float*)(ws + WS_RSTD); bf16* XB = (bf16*)(ws + WS_XB); unsigned char* W1T8 = ws + WS_W1T8; unsigned char* XF8 = ws + WS_XF8;
        const int lane = mk_lane();
        LAS float* scr = (LAS float*)(lds + wave * 16384);
        constexpr int I1 = (N1 / 32) * (D / 64), I3 = (D / 32) * (512 / 64), I4 = (D / 32) * (D / 64), I5 = (N5 / 32) * (D / 64), I6 = (D / 32) * (FF / 64);
        constexpr int NITEMS = I1 + I3 + I4 + I5 + I6;
        for (int it = gw; it < NITEMS; it += NGW) {
            int r = it;
            if (r < I1) { const int rg = r / (D / 64), kb = r % (D / 64); int c0, nv; w1_map(rg, c0, nv); if (rg < 40) tr_item<1>(w_in, DIN, 64 * kb, c0, nv, norm_mix, 1.0f, W1T, D, rg * 32, 0, scr, lane); else tr_item<2>(w_in, DIN, 64 * kb, c0, nv, norm_mix, pg8::K_WSC, W1T8, D, rg * 32 - 1280, 0, scr, lane); continue; } r -= I1;
            if (r < I3) { const int rg = r / 8, kb = r % 8; tr_item<2>(w_ba, D, 64 * kb, rg * 32, 32, nullptr, pg8::K_WSC, W3T, D, rg * 32, 0, scr, lane); continue; } r -= I3;
            if (r < I4) { const int rg = r / 16, kb = r % 16; tr_item<2>(w_out, D, 64 * kb, rg * 32, 32, nullptr, pg8::K_WSC, W4T, D, rg * 32, 0, scr, lane); continue; } r -= I4;
            if (r < I5) { const int rg = r / 16, kb = r % 16; const int n0 = rg * 32, pn = n0 >> 8, c = n0 & 255; const float* src = (c >> 7) ? w_u : w_g;
                          tr_item<MK_FP8 ? 2 : 0>(src, FF, 64 * kb, pn * 128 + (c & 127), 32, norm_ffn, MK_FP8 ? pg8::K_WSC : 1.0f, W5T, D, rg * 32, 0, scr, lane); continue; } r -= I5;
            { const int rg = r / (FF / 64), kb = r % (FF / 64); tr_item<MK_FP8 ? 2 : 0>(w_d, D, 64 * kb, rg * 32, 32, nullptr, MK_FP8 ? pg8::K_WSC : 1.0f, W6T, FF, rg * 32, 0, scr, lane); }
        }
        for (int it = gw; it < 32 * 64; it += NGW) {
            const int i0 = (it >> 6) * 16, n0 = (it & 63) * 16, g = i0 >> 7, nl = lane & 15, q = lane >> 4;
#pragma unroll
            for (int k = 0; k < 8; ++k) { const int e = 4 * (lane + 64 * k), r = e >> 7, j = e & 127;
                const f32x4 a = *(const f32x4*)(w_pg + (size_t)i0 * 128 + e), c = *(const f32x4*)(pool_scale + g * 128 + j);
#pragma unroll
                for (int t = 0; t < 4; ++t) scr[(j + t) * 16 + r] = a[t] * c[t]; }
            float s0 = 0.f, s1 = 0.f, s2 = 0.f, s3 = 0.f;
            const float* bcol = w_bp + (size_t)(g * 128) * D + n0 + nl;
#pragma unroll
            for (int hb = 0; hb < 2; ++hb) {
                float bv[64];
#pragma unroll
                for (int j = 0; j < 64; ++j) bv[j] = bcol[(size_t)(hb * 64 + j) * D];
                LDS_WAIT(); asm volatile("" ::: "memory");
#pragma unroll
                for (int j = 0; j < 64; ++j) { const f32x4 a = *(const LAS f32x4*)(scr + (hb * 64 + j) * 16 + 4 * q);
                    s0 = __builtin_fmaf(a[0], bv[j], s0); s1 = __builtin_fmaf(a[1], bv[j], s1); s2 = __builtin_fmaf(a[2], bv[j], s2); s3 = __builtin_fmaf(a[3], bv[j], s3); }
            }
            LAS unsigned* ob = (LAS unsigned*)(scr + 2048);
            ob[nl * 4 + q] = pg8::pk4_fp8(s0 * pg8::K_WSC, s1 * pg8::K_WSC, s2 * pg8::K_WSC, s3 * pg8::K_WSC);
            LDS_WAIT(); asm volatile("" ::: "memory");
            if (lane < 16) *(v4u*)(W3T + (size_t)(n0 + lane) * D + 512 + i0) = *(const LAS v4u*)(ob + lane * 4);
            LDS_WAIT(); asm volatile("" ::: "memory");
        }
        for (int m0 = gw * 4; m0 < TOK; m0 += NGW * 4) {
            const int m = m0 + (lane >> 4), sub = lane & 15;
            const f32x4* xr = (const f32x4*)(x + (size_t)m * D) + sub; f32x4 v[16]; float s = 0.f;
#pragma unroll
            for (int j = 0; j < 16; ++j) v[j] = xr[16 * j];
#pragma unroll
            for (int j = 0; j < 16; ++j) s += (v[j].x * v[j].x + v[j].y * v[j].y) + (v[j].z * v[j].z + v[j].w * v[j].w);
            s += __shfl_xor(s, 1); s += __shfl_xor(s, 2); s += __shfl_xor(s, 4); s += __shfl_xor(s, 8);
            if (sub == 0) RSTD[m] = 1.0f / sqrtf(s * (1.0f / D) + EPS);
            unsigned long long* o8 = (unsigned long long*)(XB + (size_t)m * D) + sub;
#pragma unroll
            for (int j = 0; j < 16; ++j) o8[16 * j] = (unsigned long long)pg8::cvt_pk_f16(v[j].x, v[j].y) | ((unsigned long long)pg8::cvt_pk_f16(v[j].z, v[j].w) << 32);
            unsigned* o4 = (unsigned*)(XF8 + (size_t)m * D) + sub;
#pragma unroll
            for (int j = 0; j < 16; ++j) o4[16 * j] = pg8::pk4_fp8(v[j].x, v[j].y, v[j].z, v[j].w);
        }
        if (BOTH(0)) GRID_BAR();
    }
    if (IN(1)) {
        const float* q_norm = args.in[3]; const float* k_norm = args.in[4];
        bf16* W1T = (bf16*)(ws + WS_W1T); float* RSTD = (float*)(ws + WS_RSTD); float* WIb = (float*)(ws + WS_WI); bf16* XB = (bf16*)(ws + WS_XB);
        bf16* Kb = (bf16*)(ws + WS_K); bf16* Vb = (bf16*)(ws + WS_V); bf16* KIb = (bf16*)(ws + WS_KI); bf16* Rb = (bf16*)(ws + WS_R); bf16* SPb = (bf16*)(ws + WS_R) + 1024;
        bf16* Qb = (bf16*)(ws + WS_Q); bf16* QIb = (bf16*)(ws + WS_QI); bf16* Ub = (bf16*)(ws + WS_U);
        const bool p1swap = (G == 256) && ((bx & 1) != 0);
#pragma unroll 1
        for (int pass = 0; pass < 2; ++pass) {
            if ((pass == 0) != p1swap) {
                pg8::Gemm g{XB, W1T, TOK, 1280, D}; pg8::ListOrder S; S.init(TOK, 1280, G, bx); S.mode = 0;
                pg8::Epi1 E{RSTD, q_norm, k_norm, Qb, Kb, Vb, QIb, KIb, Ub, Rb, SPb, WIb, 0, 1.0f};
                pg8::gemm_phase<pg8::Epi1, pg8::ListOrder, true, true, 1>(lds, g, S, E, wave);
            } else {
                unsigned char* W1T8 = ws + WS_W1T8; unsigned char* XF8 = ws + WS_XF8;
                pg8::Gemm g{(const bf16*)XF8, (const bf16*)W1T8, TOK, 2560, D}; pg8::ListOrder S; S.init(TOK, 2560, G, bx); S.mode = 1;
                pg8::Epi1 E{RSTD, q_norm, k_norm, Qb, Kb, Vb, QIb, KIb, Ub, Rb, SPb, WIb, 5, pg8::K_WSCI};
                pg8::gemm_phase<pg8::Epi1, pg8::ListOrder, true, true, 2>(lds, g, S, E, wave);
            }
        }
        if (BOTH(1)) GRID_BAR_L();
    }
    if (IN(2)) {
        float* WIb = (float*)(ws + WS_WI);
        bf16* Kb = (bf16*)(ws + WS_K); bf16* Vb = (bf16*)(ws + WS_V); bf16* KIb = (bf16*)(ws + WS_KI); unsigned char* AP = ws + WS_AP;
        bf16* Qb = (bf16*)(ws + WS_Q); bf16* QIb = (bf16*)(ws + WS_QI); bf16* Ub = (bf16*)(ws + WS_U);
        const int ptask0 = (G == 256) ? (((vcu >> 4) * 32 + (((vcu & 15) * 8 + wave) >> 2)) * 4 + (wave & 3)) : gw, ptstep = (G == 256) ? TOK : NGW;
        for (int task = ptask0; task < TOK / 16; task += ptstep) {
            const int ln = mk_lane(); const int g = task & 3, tb = (task >> 2) * 64 + (ln >> 4) * 16, tin = tb & (SEQ - 1), c0 = g * 128 + (ln & 15) * 8;
            if (g == 0) pool_win<2>(Ub, AP, tb, tin, c0); else if (g == 1) pool_win<4>(Ub, AP, tb, tin, c0); else if (g == 2) pool_win<8>(Ub, AP, tb, tin, c0); else pool_win<16>(Ub, AP, tb, tin, c0);
        }
        __syncthreads();
        float qk2_;
        { const float* q_norm = args.in[3]; const float* k_norm = args.in[4]; const int lq = mk_lane() & 63; float gq = __builtin_fabsf(q_norm[lq]), gk = __builtin_fabsf(k_norm[lq]);
#pragma unroll
          for (int o_ = 1; o_ < 64; o_ <<= 1) { gq = __builtin_fmaxf(gq, __shfl_xor(gq, o_)); gk = __builtin_fmaxf(gk, __shfl_xor(gk, o_)); }
          qk2_ = __builtin_bit_cast(float, __builtin_amdgcn_readfirstlane(__builtin_bit_cast(int, 2.0f * 11.6f * gq * gk))); }
        const att::Tensors AT{Qb, Kb, Vb, QIb, KIb, WIb, AP, qk2_};
        const int nun = (G == 256) ? 4 : (NB * 64 - vcu + G - 1) / G;
#define UNIT_OF(i, b_, q_) do { if (G == 256) { const int s_ = vcu & 15; b_ = vcu >> 4; q_ = (int)((unit_tab(s_) >> (8 * (i))) & 0xffu); } \
                                else { const int un_ = vcu + (i) * G; b_ = un_ >> 6; q_ = un_ & 63; } } while (0)
        att::UnitPF pf;
        if (nun > 0) { int b0, q0; UNIT_OF(0, b0, q0); att::unit_prefetch(pf, b0, q0, AT, wave, lds, true); }
#pragma unroll 1
        for (int i = 0; i < nun; ++i) {
            int b, qb, nb = 0, nqb = 0; UNIT_OF(i, b, qb);
            const bool has_next = (i + 1 < nun); if (has_next) UNIT_OF(i + 1, nb, nqb);
            att::attn_unit(b, qb, AT, lds, pf, has_next, nb, nqb, wave);
        }
#undef UNIT_OF
        if (BOTH(2)) GRID_BAR_L();
    }
    if (IN(3)) {
        unsigned char* W3T = ws + WS_W3T; bf16* Rb = (bf16*)(ws + WS_R); bf16* SPb = (bf16*)(ws + WS_R) + 1024; unsigned char* AP = ws + WS_AP; unsigned char* MG = ws + WS_MG;
        pg8::Gemm g{(const bf16*)AP, (const bf16*)W3T, TOK, D, D}; pg8::StaticOrder S; S.init(TOK, D, G, bx);
        pg8::Epi3 E{Rb, SPb, MG};
        pg8::gemm_phase<pg8::Epi3, pg8::StaticOrder, true, true, 2>(lds, g, S, E, wave);
        if (BOTH(3)) GRID_BAR_L();
    }
    if (IN(4)) {
        bf16* XB = (bf16*)(ws + WS_XB); unsigned char* W4T = ws + WS_W4T; unsigned char* MG = ws + WS_MG; bf16* H2 = (bf16*)(ws + WS_H2); unsigned char* H2F8 = ws + WS_H2F8; float* SSQ = (float*)(ws + WS_SSQ);
        pg8::Gemm g{(const bf16*)MG, (const bf16*)W4T, TOK, D, D}; pg8::StaticOrder S; S.init(TOK, D, G, bx);
        pg8::Epi4 E{XB, H2, H2F8, SSQ};
        pg8::gemm_phase<pg8::Epi4, pg8::StaticOrder, true, true, 2>(lds, g, S, E, wave);
        if (BOTH(4)) GRID_BAR_L();
    }
    if (IN(5)) {
        unsigned char* W5T = ws + WS_W5T; unsigned char* H2F8 = ws + WS_H2F8; float* SSQ = (float*)(ws + WS_SSQ); unsigned char* ACT = ws + WS_ACT;
        bf16* H2 = (bf16*)(ws + WS_H2);
        pg8::Gemm g{MK_FP8 ? (const bf16*)H2F8 : (const bf16*)H2, (const bf16*)W5T, TOK, N5, D}; pg8::StaticOrder S; S.init(TOK, N5, G, bx);
        pg8::Epi5 E{SSQ, ACT};
        pg8::gemm_phase<pg8::Epi5, pg8::StaticOrder, true, true, MK_FP8 ? 2 : 0>(lds, g, S, E, wave);
        if (BOTH(5)) GRID_BAR_L();
    }
    if (IN(6)) {
        float* out = args.out; unsigned char* W6T = ws + WS_W6T; unsigned char* ACT = ws + WS_ACT; bf16* H2 = (bf16*)(ws + WS_H2);
        pg8::Gemm g{(const bf16*)ACT, (const bf16*)W6T, TOK, D, FF, 4096}; pg8::StaticOrder S; S.init(TOK, D, G, bx);
        pg8::Epi6 E{H2, out};
        pg8::gemm_phase<pg8::Epi6, pg8::StaticOrder, true, true, MK_FP8 ? 2 : 0>(lds, g, S, E, wave);
    }
#undef IN
#undef BOTH
#undef GRID_BAR
#undef GRID_BAR_L
}

extern "C" void kernel_launch(void* const* d_in, const int* in_sizes, int n_in, void* d_out, int out_size, void* d_ws, size_t ws_size, hipStream_t stream) {
    static int grid = 0;
    if (grid == 0) {
        if (n_in != 14 || in_sizes[0] != TOK * D || out_size != TOK * D || ws_size < WS_END) { fprintf(stderr, "kernel_launch: unexpected shapes (n_in %d, in0 %d, out %d, ws %zu)\n", n_in, n_in > 0 ? in_sizes[0] : -1, out_size, ws_size); grid = -1; return; }
        int dev = 0, cus = 0, per_cu = 0;
        if (hipGetDevice(&dev) != hipSuccess || hipDeviceGetAttribute(&cus, hipDeviceAttributeMultiprocessorCount, dev) != hipSuccess) { grid = -1; return; }
        if (hipFuncSetAttribute((const void*)mk_fwd, hipFuncAttributeMaxDynamicSharedMemorySize, LDS_BYTES) != hipSuccess) { fprintf(stderr, "kernel_launch: hipFuncSetAttribute failed\n"); grid = -1; return; }
        if (hipOccupancyMaxActiveBlocksPerMultiprocessor(&per_cu, (const void*)mk_fwd, NWAVES * 64, LDS_BYTES) != hipSuccess || per_cu < 1) fprintf(stderr, "kernel_launch: occupancy query says %d\n", per_cu);
        (void)hipGetLastError();
        grid = cus;
    }
    if (grid < 0) return;
    (void)hipMemsetAsync((char*)d_ws + WS_CTL, 0, CTL_ZERO_BYTES, stream);
    Args a{};
    for (int i = 0; i < 14; ++i) a.in[i] = (const float*)d_in[i];
    a.out = (float*)d_out; a.ws = (unsigned char*)d_ws;
#if MK_PER_PHASE
    for (int p = 0; p < 7; ++p) { a.ph_lo = p; a.ph_hi = p + 1; hipLaunchKernelGGL(mk_fwd, dim3(grid), dim3(NWAVES * 64), LDS_BYTES, stream, a);
#ifdef MK_REPEAT
        if (p == MK_REPEAT) hipLaunchKernelGGL(mk_fwd, dim3(grid), dim3(NWAVES * 64), LDS_BYTES, stream, a);
#endif
    }
#else
    a.ph_lo = 0; a.ph_hi = 7; hipLaunchKernelGGL(mk_fwd, dim3(grid), dim3(NWAVES * 64), LDS_BYTES, stream, a);
#endif
}
```

```cpp
#include <hip/hip_runtime.h>
#include <cstdio>
#include <cstdint>

#ifndef MK_PER_PHASE
#define MK_PER_PHASE 0
#endif
#ifndef MK_FP8
#define MK_FP8 1
#endif

__device__ __forceinline__ int mk_lane() { int l; asm volatile("v_mbcnt_lo_u32_b32 %0, -1, 0\n\tv_mbcnt_hi_u32_b32 %0, -1, %0" : "=v"(l)); return l; }
namespace pg8 {
#define PG8_LAS __attribute__((address_space(3)))
typedef unsigned short bf16_t;
typedef short bf16x8 __attribute__((ext_vector_type(8)));
typedef float f32x4 __attribute__((ext_vector_type(4)));
typedef unsigned u32x4 __attribute__((ext_vector_type(4)));
constexpr int BM = 256, BK = 64, HALF = 128, HTB = HALF * BK * 2  , STAGE_BYTES = 8 * HTB, NXCD = 8, WGM = 8;

__host__ __device__ __forceinline__ int lds_byte(int r, int c) { const int st = (r >> 4) * 2 + (c >> 5), rr = r & 15, cc = c & 31, ob = rr * 64 + cc * 2; return st * 1024 + (ob ^ (((ob >> 9) & 1) << 5)); }
__host__ __device__ __forceinline__ void stage_rc(int b, int& R, int& C) { const int st = b / 1024, sb = b % 1024, swz = sb ^ (((sb >> 9) & 1) << 5); R = (st >> 1) * 16 + swz / 64; C = (st & 1) * 32 + (swz % 64) / 2; }
__host__ __device__ __forceinline__ int perm32(int rho) { const int n = rho >> 4, i = rho & 15; return 8 * (i >> 2) + 4 * n + (i & 3); }

struct Unit { int pm, pn; };
struct Gemm { const bf16_t* A; const bf16_t* Bt; int M, N, K; int lda = 0; };

struct StaticOrder {
    int nM, nN, nwg, G, c;
    __host__ __device__ void init(int M, int N, int G_, int c_) { nM = M / BM; nN = N / BM; nwg = nM * nN; G = G_; c = c_; }
    __host__ __device__ bool next(int i, Unit& u) const {
        const long L = (long)i * G + c; if (L >= nwg) return false;
        int wgid = (int)L; const int rot = ((int)(L % NXCD) * nN) / NXCD; { const int q = nwg / NXCD, r = nwg % NXCD, xcd = wgid % NXCD, off = wgid / NXCD; wgid = (xcd < r ? xcd * (q + 1) : r * (q + 1) + (xcd - r) * q) + off; }
        const int nig = WGM * nN, gid = wgid / nig, fm = gid * WGM, gsz = (nM - fm) < WGM ? (nM - fm) : WGM;
        u.pm = fm + ((wgid % nig) % gsz); u.pn = ((wgid % nig) / gsz + rot) % nN; return true;
    }
    __device__ __forceinline__ void a_ready(const Unit&) const {}
    __device__ __forceinline__ void done(const Unit&) const {}
};


template <bool FP8> __host__ __device__ __forceinline__ int lds_xor(int rr) { return FP8 ? (((rr >> 1) & 1) | (rr & 4)) : rr; }
template <bool FP8> __host__ __device__ __forceinline__ int lds_byte2(int r, int ch) { const int rr = r & 7; return (r >> 3) * 1024 + rr * 128 + ((ch ^ lds_xor<FP8>(rr)) << 4); }
template <bool FP8> __host__ __device__ __forceinline__ void stage_rc2(int b, int& R, int& CB) { const int st = b >> 10, i = (b & 1023) >> 4, rr = i >> 3, chp = i & 7; R = st * 8 + rr; CB = (chp ^ lds_xor<FP8>(rr)) << 4; }

struct ListOrder : StaticOrder {
    int mode;
    __host__ __device__ bool next(int i, Unit& u) const {
        long L;
        if (G != 256) { L = (long)i * G + c; }
        else if (mode == 0) { if (i >= 3 || (i == 2 && c >= 128)) return false; L = 256 * i + c; }
        else { if (c < 128) { if (i >= 4) return false; L = c + 128 * i; } else { if (i >= 6) return false; L = 512 + (c - 128) + 128 * i; } }
        if (L >= nwg) return false;
        int wgid = (int)L; const int rot = ((int)(L % NXCD) * nN) / NXCD; { const int q = nwg / NXCD, r = nwg % NXCD, xcd = wgid % NXCD, off = wgid / NXCD; wgid = (xcd < r ? xcd * (q + 1) : r * (q + 1) + (xcd - r) * q) + off; }
        const int nig = WGM * nN, gid = wgid / nig, fm = gid * WGM, gsz = (nM - fm) < WGM ? (nM - fm) : WGM;
        u.pm = fm + ((wgid % nig) % gsz); u.pn = ((wgid % nig) / gsz + rot) % nN; return true;
    }
};


typedef float f32x2 __attribute__((ext_vector_type(2)));
typedef __bf16 bf16x2_t __attribute__((ext_vector_type(2)));
__device__ __forceinline__ unsigned cvt_pk_bf16(float lo, float hi) { f32x2 v = {lo, hi}; bf16x2_t b = __builtin_convertvector(v, bf16x2_t); return __builtin_bit_cast(unsigned, b); }
__device__ __forceinline__ u32x4 pack8(f32x4 a, f32x4 b) { u32x4 w; w.x = cvt_pk_bf16(a[0], a[1]); w.y = cvt_pk_bf16(a[2], a[3]); w.z = cvt_pk_bf16(b[0], b[1]); w.w = cvt_pk_bf16(b[2], b[3]); return w; }
typedef _Float16 f16x2_t __attribute__((ext_vector_type(2)));
__device__ __forceinline__ unsigned cvt_pk_f16(float lo, float hi) { f32x2 v = {lo, hi}; f16x2_t h = __builtin_convertvector(v, f16x2_t); return __builtin_bit_cast(unsigned, h); }
__device__ __forceinline__ u32x4 pack8h(f32x4 a, f32x4 b) { u32x4 w; w.x = cvt_pk_f16(a[0], a[1]); w.y = cvt_pk_f16(a[2], a[3]); w.z = cvt_pk_f16(b[0], b[1]); w.w = cvt_pk_f16(b[2], b[3]); return w; }
__device__ __forceinline__ void unpack8(u32x4 w, f32x4& a, f32x4& b) {
    a[0] = __uint_as_float(w.x << 16); a[1] = __uint_as_float(w.x & 0xffff0000u); a[2] = __uint_as_float(w.y << 16); a[3] = __uint_as_float(w.y & 0xffff0000u);
    b[0] = __uint_as_float(w.z << 16); b[1] = __uint_as_float(w.z & 0xffff0000u); b[2] = __uint_as_float(w.w << 16); b[3] = __uint_as_float(w.w & 0xffff0000u); }
__device__ __forceinline__ float h2f(unsigned h) { return (float)__builtin_bit_cast(_Float16, (unsigned short)h); }
__device__ __forceinline__ void unpack8h(u32x4 w, f32x4& a, f32x4& b) {
    a[0] = h2f(w.x & 0xffffu); a[1] = h2f(w.x >> 16); a[2] = h2f(w.y & 0xffffu); a[3] = h2f(w.y >> 16);
    b[0] = h2f(w.z & 0xffffu); b[1] = h2f(w.z >> 16); b[2] = h2f(w.w & 0xffffu); b[3] = h2f(w.w >> 16); }
__device__ __forceinline__ unsigned pk4_fp8(float a, float b, float c, float d) { unsigned r = __builtin_amdgcn_cvt_pk_fp8_f32(a, b, 0u, false); return (unsigned)__builtin_amdgcn_cvt_pk_fp8_f32(c, d, r, true); }
__device__ __forceinline__ unsigned long long pack8_fp8(f32x4 a, f32x4 b) { return (unsigned long long)pk4_fp8(a[0], a[1], a[2], a[3]) | ((unsigned long long)pk4_fp8(b[0], b[1], b[2], b[3]) << 32); }
__device__ __forceinline__ void unpack8_fp8(unsigned long long w, f32x4& a, f32x4& b) {
    const unsigned lo = (unsigned)w, hi = (unsigned)(w >> 32);
    const auto p0 = __builtin_amdgcn_cvt_pk_f32_fp8(lo, false), p1 = __builtin_amdgcn_cvt_pk_f32_fp8(lo, true), p2 = __builtin_amdgcn_cvt_pk_f32_fp8(hi, false), p3 = __builtin_amdgcn_cvt_pk_f32_fp8(hi, true);
    a = (f32x4){p0[0], p0[1], p1[0], p1[1]}; b = (f32x4){p2[0], p2[1], p3[0], p3[1]}; }
constexpr size_t ACT_PITCH = 4096, GATE_SP_OFF = 4u << 20;
__host__ __device__ __forceinline__ size_t gate_block(int pm, int cblk) { return (size_t)(pm >> 4) * (4096 * ACT_PITCH) + ((size_t)((pm & 15) * 8 + cblk) << 15); }
__device__ __forceinline__ u32x4 pair16(unsigned long long A, unsigned long long B) {
    const auto s0 = __builtin_amdgcn_permlane16_swap((unsigned)A, (unsigned)B, false, false);
    const auto s1 = __builtin_amdgcn_permlane16_swap((unsigned)(A >> 32), (unsigned)(B >> 32), false, false);
    u32x4 w; w.x = s0[0]; w.y = s1[0]; w.z = s0[1]; w.w = s1[1]; return w; }
constexpr float K_WSC = 64.0f, K_WSCI = 1.0f / 64.0f;
__device__ __forceinline__ float sum_fq(float s) {
    auto r16 = __builtin_amdgcn_permlane16_swap(__float_as_uint(s), __float_as_uint(s), false, false); s = __uint_as_float(r16[0]) + __uint_as_float(r16[1]);
    auto r32 = __builtin_amdgcn_permlane32_swap(__float_as_uint(s), __float_as_uint(s), false, false); return __uint_as_float(r32[0]) + __uint_as_float(r32[1]); }
__device__ __forceinline__ float fexp(float x) { return __builtin_amdgcn_exp2f(x * 1.4426950408889634f); }
__device__ __forceinline__ float frcp(float x) { return __builtin_amdgcn_rcpf(x); }

constexpr float K_EPS = 1e-6f, K_C2 = 0.125f * 1.4426950408889634f, K_IDXS = 0.04419417382415922f;

struct Epi1 {
    static constexpr bool PERM = true, AFTER_DRAIN = false, MID = false;
    const float* rstd; const float* qn; const float* kn;
    bf16_t *Q, *K, *V, *QI, *KI, *U, *R, *SP; float* WI; int pn_off; float wsc; mutable int cpm = -1; mutable float crs[2][4] = {};
    __device__ __forceinline__ void mid(f32x4 (&)[2][2][4][2], const Unit&, int, int, int, int) const {}
    template <bool NORM, bool F16 = false>
    __device__ __forceinline__ void head_tile(const f32x4 (&acc)[2][2][4][2], const float (&rsr)[2][4], int row0, int fq, bf16_t* dst, int pitch, int colbase, const float* gain, float scale) const {
        f32x4 g[2][2];
#pragma unroll
        for (int bj = 0; bj < 2; ++bj)
#pragma unroll
            for (int n = 0; n < 2; ++n) g[bj][n] = NORM ? *(const f32x4*)(gain + 32 * bj + 8 * fq + 4 * n) : (f32x4){1.f, 1.f, 1.f, 1.f};
#pragma unroll
        for (int ai = 0; ai < 2; ++ai)
#pragma unroll
            for (int m = 0; m < 4; ++m) {
                const int row = row0 + ai * HALF + m * 16; const float rs = rsr[ai][m];
                f32x4 v[2][2]; float ss = 0.f;
#pragma unroll
                for (int bj = 0; bj < 2; ++bj)
#pragma unroll
                    for (int n = 0; n < 2; ++n) { v[bj][n] = acc[ai][bj][m][n] * rs; const f32x4 q = v[bj][n] * v[bj][n]; ss += (q[0] + q[1]) + (q[2] + q[3]); }
                float mul = scale;
                if (NORM) { ss = sum_fq(ss); mul = __builtin_amdgcn_rsqf(ss * (1.0f / 64.0f) + K_EPS) * scale; }
#pragma unroll
                for (int bj = 0; bj < 2; ++bj) {
                    const f32x4 o0 = v[bj][0] * g[bj][0] * mul, o1 = v[bj][1] * g[bj][1] * mul;
                    *(u32x4*)(dst + (size_t)row * pitch + colbase + 32 * bj + 8 * fq) = F16 ? pack8h(o0, o1) : pack8(o0, o1);
                }
            }
    }
    __device__ __forceinline__ void operator()(const f32x4 (&acc)[2][2][4][2], const Unit& u, int wr, int wc, int fr, int fq) const {
        asm volatile("" : "+v"(fr), "+v"(fq));
        const int row0 = u.pm * BM + wr * 64 + fr; const int pn = u.pn + pn_off;
        float rsr[2][4];
        if (u.pm != cpm) {
#pragma unroll
            for (int ai = 0; ai < 2; ++ai)
#pragma unroll
                for (int m = 0; m < 4; ++m) crs[ai][m] = rstd[row0 + ai * HALF + m * 16];
            cpm = u.pm;
        }
#pragma unroll
        for (int ai = 0; ai < 2; ++ai)
#pragma unroll
            for (int m = 0; m < 4; ++m) rsr[ai][m] = crs[ai][m];
        if (pn >= 7) {
            const int cb = (pn - 7) * 128 + wc * 32 + 8 * fq;
#pragma unroll
            for (int ai = 0; ai < 2; ++ai)
#pragma unroll
                for (int m = 0; m < 4; ++m) {
                    const int row = row0 + ai * HALF + m * 16; const float rs = rsr[ai][m] * wsc;
                    f32x4 r[2], s[2];
#pragma unroll
                    for (int n = 0; n < 2; ++n)
#pragma unroll
                        for (int i = 0; i < 4; ++i) {
                            const float ea = fminf(fexp(-acc[ai][0][m][n][i] * rs), 1e30f), ep = fminf(fexp(-acc[ai][1][m][n][i] * rs), 1e30f);
                            const float sp = frcp(1.f + ep); s[n][i] = sp; r[n][i] = fminf((1.f + ep) * frcp(1.f + ea), 448.f);
                        }
                    const size_t go = gate_block(u.pm, pn - 7) + (size_t)((((wr * 4 + wc) * 2 + ai) * 4 + m) * 512 + (fr * 4 + fq) * 8);
                    *(unsigned long long*)((unsigned char*)R + go) = pack8_fp8(r[0], r[1]);
                    *(unsigned long long*)((unsigned char*)R + GATE_SP_OFF + go) = pack8_fp8(s[0], s[1]);
                }
        } else if (pn >= 5) {
            unsigned long long pku[2][2] = {};
#pragma unroll
            for (int ai = 0; ai < 2; ++ai)
#pragma unroll
                for (int m = 0; m < 4; ++m) {
                    const int row = row0 + ai * HALF + m * 16; const float rs = rsr[ai][m] * wsc;
#pragma unroll
                    for (int bj = 0; bj < 2; ++bj) pku[bj][m & 1] = pack8_fp8(acc[ai][bj][m][0] * rs, acc[ai][bj][m][1] * rs);
                    if (m & 1) { const int odd = fq & 1;
#pragma unroll
                        for (int bj = 0; bj < 2; ++bj) *(u32x4*)((unsigned char*)U + (size_t)(row - 16 + 16 * odd) * 512 + (pn - 5) * 256 + bj * HALF + wc * 32 + 8 * fq - 8 * odd) = pair16(pku[bj][0], pku[bj][1]); }
                }
        } else if (pn == 2) {
            if (wc == 0) head_tile<true>(acc, rsr, row0, fq, K, 64, 0, kn, 1.0f);
            else if (wc == 1) head_tile<false>(acc, rsr, row0, fq, V, 64, 0, nullptr, 1.0f);
            else if (wc == 2) head_tile<false, true>(acc, rsr, row0, fq, KI, 64, 0, nullptr, 1.0f);
            else {
                if (fq == 0) {
#pragma unroll
                    for (int ai = 0; ai < 2; ++ai)
#pragma unroll
                        for (int m = 0; m < 4; ++m) {
                            const int row = row0 + ai * HALF + m * 16; const float rs = rsr[ai][m] * K_IDXS;
                            *(f32x4*)(WI + (size_t)row * 8) = acc[ai][0][m][0] * rs; *(f32x4*)(WI + (size_t)row * 8 + 4) = acc[ai][0][m][1] * rs;
                        }
                }
            }
        } else if (pn < 2) head_tile<true>(acc, rsr, row0, fq, Q, 512, (pn * 4 + wc) * 64, qn, K_C2);
        else head_tile<false, true>(acc, rsr, row0, fq, QI, 512, ((pn - 3) * 4 + wc) * 64, nullptr, 1.0f);
    }
};

struct Epi3 {
    static constexpr bool PERM = true, AFTER_DRAIN = false, MID = true;
    const unsigned char* R; const unsigned char* SP; unsigned char* MG;
    mutable unsigned long long pw[2][4][2] = {};
    __device__ __forceinline__ void pre(const unsigned char* Sc, const Unit& u, int wr, int wc, int fr, int fq) const {
        asm volatile("" : "+v"(fr), "+v"(fq));
        const int row0 = u.pm * BM + wr * 64 + fr, col0 = u.pn * BM + wc * 32 + 8 * fq;
#pragma unroll
        for (int ai = 0; ai < 2; ++ai)
#pragma unroll
            for (int m = 0; m < 4; ++m)
#pragma unroll
                for (int bj = 0; bj < 2; ++bj) pw[ai][m][bj] = *(const unsigned long long*)(Sc + gate_block(u.pm, u.pn * 2 + bj) + (size_t)((((wr * 4 + wc) * 2 + ai) * 4 + m) * 512 + (fr * 4 + fq) * 8));
    }
    __device__ __forceinline__ void scale_by(f32x4 (&acc)[2][2][4][2], const unsigned char* Sc, const Unit& u, int wr, int wc, int fr, int fq) const {
        asm volatile("" : "+v"(fr), "+v"(fq));
        const int row0 = u.pm * BM + wr * 64 + fr, col0 = u.pn * BM + wc * 32 + 8 * fq;
#pragma unroll
        for (int ai = 0; ai < 2; ++ai) {
#pragma unroll
            for (int m = 0; m < 4; ++m)
#pragma unroll
                for (int bj = 0; bj < 2; ++bj) { f32x4 a, b; unpack8_fp8(pw[ai][m][bj], a, b); acc[ai][bj][m][0] *= a; acc[ai][bj][m][1] *= b; }
        }
    }
    __device__ __forceinline__ void mid(f32x4 (&acc)[2][2][4][2], const Unit& u, int wr, int wc, int fr, int fq) const { scale_by(acc, R, u, wr, wc, fr, fq); }
    __device__ __forceinline__ void operator()(const f32x4 (&acc)[2][2][4][2], const Unit& u, int wr, int wc, int fr, int fq) const {
        asm volatile("" : "+v"(fr), "+v"(fq));
        const int row0 = u.pm * BM + wr * 64 + fr, col0 = u.pn * BM + wc * 32 + 8 * fq;
        const int odd = fq & 1;
#pragma unroll
        for (int ai = 0; ai < 2; ++ai) {
#pragma unroll
            for (int mp = 0; mp < 2; ++mp)
#pragma unroll
                for (int bj = 0; bj < 2; ++bj) {
                    unsigned long long pk[2];
#pragma unroll
                    for (int h = 0; h < 2; ++h) { const int m = 2 * mp + h; f32x4 a, b; unpack8_fp8(pw[ai][m][bj], a, b);
                        pk[h] = pack8_fp8(acc[ai][bj][m][0] * a * (8.0f * K_WSCI), acc[ai][bj][m][1] * b * (8.0f * K_WSCI)); }
                    *(u32x4*)(MG + (size_t)(row0 + ai * HALF + (2 * mp + odd) * 16) * 1024 + col0 + bj * HALF - 8 * odd) = pair16(pk[0], pk[1]);
                }
        }
    }
};

struct Epi4 {
    static constexpr bool PERM = true, AFTER_DRAIN = false, MID = false;
    const bf16_t* XB; bf16_t* H2; unsigned char* H2F8; float* SSQ;
    __device__ __forceinline__ void mid(f32x4 (&)[2][2][4][2], const Unit&, int, int, int, int) const {}
    __device__ __forceinline__ void operator()(const f32x4 (&acc)[2][2][4][2], const Unit& u, int wr, int wc, int fr, int fq) const {
        asm volatile("" : "+v"(fr), "+v"(fq));
        const int row0 = u.pm * BM + wr * 64 + fr, col0 = u.pn * BM + wc * 32 + 8 * fq;
        unsigned long long pk8[2][2] = {};
#pragma unroll
        for (int ai = 0; ai < 2; ++ai) {
            u32x4 xw[4][2];
#pragma unroll
            for (int m = 0; m < 4; ++m)
#pragma unroll
                for (int bj = 0; bj < 2; ++bj) xw[m][bj] = *(const u32x4*)(XB + (size_t)(row0 + ai * HALF + m * 16) * 1024 + col0 + bj * HALF);
#pragma unroll
            for (int m = 0; m < 4; ++m) {
                const int row = row0 + ai * HALF + m * 16; float ss = 0.f;
#pragma unroll
                for (int bj = 0; bj < 2; ++bj) {
                    const size_t off = (size_t)row * 1024 + col0 + bj * HALF;
                    f32x4 a, b; unpack8h(xw[m][bj], a, b);
                    a += acc[ai][bj][m][0] * (K_WSCI * 0.125f); b += acc[ai][bj][m][1] * (K_WSCI * 0.125f);
                    const f32x4 q = a * a + b * b; ss += (q[0] + q[1]) + (q[2] + q[3]);
                    *(u32x4*)((unsigned char*)H2 + ((size_t)(u.pm * 4 + u.pn) << 17) + (size_t)((((((wr * 4 + wc) * 2 + ai) * 4 + m) * 2 + bj) << 10) + (fr * 4 + fq) * 16)) = pack8(a, b);
                    pk8[bj][m & 1] = pack8_fp8(a, b);
                }
                if (m & 1) { const int odd = fq & 1;
#pragma unroll
                    for (int bj = 0; bj < 2; ++bj) *(u32x4*)(H2F8 + (size_t)(row - 16 + 16 * odd) * 1024 + col0 + bj * HALF - 8 * odd) = pair16(pk8[bj][0], pk8[bj][1]); }
                ss = sum_fq(ss);
                if (fq == 0) SSQ[(size_t)row * 16 + u.pn * 4 + wc] = ss;
            }
        }
    }
};

struct Epi5 {
    static constexpr bool PERM = true, AFTER_DRAIN = false, MID = false;
    const float* SSQ; unsigned char* ACT;
    mutable int cpm = -1; mutable float crs[2][4] = {};
    __device__ __forceinline__ void mid(f32x4 (&)[2][2][4][2], const Unit&, int, int, int, int) const {}
    __device__ __forceinline__ void operator()(const f32x4 (&acc)[2][2][4][2], const Unit& u, int wr, int wc, int fr, int fq) const {
        asm volatile("" : "+v"(fr), "+v"(fq));
        const int row0 = u.pm * BM + wr * 64 + fr, col0 = u.pn * 128 + wc * 32 + 8 * fq;
        float rsv[2][4];
        if (u.pm != cpm) { f32x4 part[2][4];
#pragma unroll
          for (int ai = 0; ai < 2; ++ai)
#pragma unroll
              for (int m = 0; m < 4; ++m) part[ai][m] = *(const f32x4*)(SSQ + (size_t)(row0 + ai * HALF + m * 16) * 16 + 4 * fq);
#pragma unroll
          for (int ai = 0; ai < 2; ++ai)
#pragma unroll
              for (int m = 0; m < 4; ++m) { float s = (part[ai][m][0] + part[ai][m][1]) + (part[ai][m][2] + part[ai][m][3]); s = sum_fq(s);
                  crs[ai][m] = __builtin_amdgcn_rsqf(s * (1.0f / 1024.0f) + K_EPS) * (MK_FP8 ? K_WSCI : 1.0f); }
          cpm = u.pm; }
#pragma unroll
        for (int ai = 0; ai < 2; ++ai)
#pragma unroll
            for (int m = 0; m < 4; ++m) rsv[ai][m] = crs[ai][m];
        unsigned long long pk[2] = {0ull, 0ull};
#pragma unroll
        for (int ai = 0; ai < 2; ++ai)
#pragma unroll
            for (int m = 0; m < 4; ++m) {
                const int row = row0 + ai * HALF + m * 16; const float rs = rsv[ai][m];
                const float k1 = -rs * 1.4426950408889634f, rs2 = rs * rs;
                f32x4 o[2];
#pragma unroll
                for (int n = 0; n < 2; ++n) {
                    const f32x4 ag = acc[ai][0][m][n], au = acc[ai][1][m][n];
                    const f32x4 t = ag * k1; f32x4 e;
#pragma unroll
                    for (int i = 0; i < 4; ++i) e[i] = __builtin_amdgcn_exp2f(t[i]);
                    const f32x4 d = e + 1.0f; f32x4 r;
#pragma unroll
                    for (int i = 0; i < 4; ++i) r[i] = __builtin_amdgcn_rcpf(d[i]);
                    o[n] = (ag * au) * (r * rs2);
                }
                if (MK_FP8) { pk[m & 1] = pack8_fp8(o[0], o[1]);
                    if (m & 1) { const int odd = fq & 1;
                        *(u32x4*)(ACT + (size_t)(row - 16 + 16 * odd) * ACT_PITCH + col0 - 8 * odd) = pair16(pk[0], pk[1]); } }
                else *(u32x4*)((bf16_t*)ACT + (size_t)row * 2816 + col0) = pack8(o[0], o[1]);
            }
    }
};

struct Epi6 {
    static constexpr bool PERM = true, AFTER_DRAIN = false, MID = false;
    const bf16_t* H2; float* OUT;
    __device__ __forceinline__ void mid(f32x4 (&)[2][2][4][2], const Unit&, int, int, int, int) const {}
    __device__ __forceinline__ void operator()(const f32x4 (&acc)[2][2][4][2], const Unit& u, int wr, int wc, int fr, int fq) const {
        asm volatile("" : "+v"(fr), "+v"(fq));
        const int row0 = u.pm * BM + wr * 64 + fr, col0 = u.pn * BM + wc * 32 + 8 * fq;
        const unsigned char* hb = (const unsigned char*)H2 + ((size_t)(u.pm * 4 + u.pn) << 17) + (size_t)(((wr * 4 + wc) << 14) + (fr * 4 + fq) * 16);
#pragma unroll
        for (int ai = 0; ai < 2; ++ai) {
            u32x4 hw[4][2];
#pragma unroll
            for (int m = 0; m < 4; ++m)
#pragma unroll
                for (int bj = 0; bj < 2; ++bj) hw[m][bj] = *(const u32x4*)(hb + (((ai * 4 + m) * 2 + bj) << 10));
#pragma unroll
            for (int m = 0; m < 4; ++m)
#pragma unroll
                for (int bj = 0; bj < 2; ++bj) {
                    const size_t off = (size_t)(row0 + ai * HALF + m * 16) * 1024 + col0 + bj * HALF;
                    f32x4 a, b; unpack8(hw[m][bj], a, b);
                    *(f32x4*)(OUT + off) = a + acc[ai][bj][m][0] * (MK_FP8 ? K_WSCI : 1.0f);
                    *(f32x4*)(OUT + off + 4) = b + acc[ai][bj][m][1] * (MK_FP8 ? K_WSCI : 1.0f);
                }
        }
    }
};

typedef int v8i_t __attribute__((ext_vector_type(8)));
typedef _Float16 f16x8_t __attribute__((ext_vector_type(8)));
typedef int v4i_t __attribute__((ext_vector_type(4)));
template <class Epi, class Sched, bool ALIGN_EPI = false, bool SP2 = false, int DT = 0>
__device__ __forceinline__ void gemm_phase(PG8_LAS unsigned char* lds, const Gemm g, const Sched& S, const Epi& E, const int wave_s) {
    const int wid = wave_s, lane = mk_lane(), tid = wid * 64 + lane, wr = wid >> 2, wc = wid & 3, fr = lane & 15, fq = lane >> 4;
    constexpr int ES = (DT == 2) ? 1 : 2, KST = (DT == 2) ? 16 : 1024;
    const int K = g.K, nt = K * ES / 128;
    const int rowA = g.lda ? g.lda : K * ES;
    unsigned voffA[2], voffB[2];
#pragma unroll
    for (int i = 0; i < 2; ++i) { int R, CB; stage_rc2<DT == 2>(tid * 16 + i * 8192, R, CB); const int Rb = Epi::PERM ? ((R & ~31) + perm32(R & 31)) : R;
        voffA[i] = (unsigned)(R * rowA + CB); voffB[i] = (unsigned)(Rb * K * ES + CB); }
    const size_t kstep = (size_t)(BK * 2);
    const size_t hstep = (size_t)HALF * K * ES;
    const size_t tstep = 2 * hstep;
    const size_t hstepA = (size_t)HALF * rowA, tstepA = 2 * hstepA;
    const unsigned ldsw = (unsigned)wid * 1024u;
    const int aoff = lds_byte2<DT == 2>(wr * 64 + fr, (DT == 2) ? 2 * fq : fq), boff = lds_byte2<DT == 2>(wc * 32 + fr, (DT == 2) ? 2 * fq : fq);
    const int aoff1 = aoff ^ ((DT == 2) ? 16 : 64), boff1 = boff ^ ((DT == 2) ? 16 : 64);
#define PG8_SA(b, h) (((b) * 2 + (h)) * HTB)
#define PG8_SB(b, h) ((4 + (b) * 2 + (h)) * HTB)
#define PG8_STAGE(bufoff, gbase, voff) do { _Pragma("unroll") for (int _i = 0; _i < 2; ++_i) \
        __builtin_amdgcn_global_load_lds((const unsigned*)((const char*)(gbase) + (voff)[_i]), (PG8_LAS unsigned*)(lds + (bufoff) + ldsw + _i * 8192), 16, 0, 0); } while (0)
#define PG8_LD8(dstv, ptr0, ptr1) do { const v4i_t lo_ = *(const PG8_LAS v4i_t*)(ptr0); const v4i_t hi_ = *(const PG8_LAS v4i_t*)(ptr1); dstv = __builtin_shufflevector(lo_, hi_, 0, 1, 2, 3, 4, 5, 6, 7); } while (0)
#define PG8_LDA(dst, b, h) do { if constexpr (DT == 2) { _Pragma("unroll") for (int m = 0; m < 4; ++m) PG8_LD8(dst##8[m], lds + PG8_SA(b, h) + aoff + m * 2048, lds + PG8_SA(b, h) + aoff1 + m * 2048); } else { \
        _Pragma("unroll") for (int m = 0; m < 4; ++m) _Pragma("unroll") for (int k = 0; k < 2; ++k) dst[m][k] = *(const PG8_LAS bf16x8*)(lds + PG8_SA(b, h) + (k ? aoff1 : aoff) + m * 2048); } } while (0)
#define PG8_LDB(dst, b, h) do { if constexpr (DT == 2) { _Pragma("unroll") for (int n = 0; n < 2; ++n) PG8_LD8(dst##8[n], lds + PG8_SB(b, h) + boff + n * 2048, lds + PG8_SB(b, h) + boff1 + n * 2048); } else { \
        _Pragma("unroll") for (int n = 0; n < 2; ++n) _Pragma("unroll") for (int k = 0; k < 2; ++k) dst[n][k] = *(const PG8_LAS bf16x8*)(lds + PG8_SB(b, h) + (k ? boff1 : boff) + n * 2048); } } while (0)
#define PG8_MMA(ai, bj, At, Bt) do { __builtin_amdgcn_s_setprio(1); _Pragma("unroll") for (int m = 0; m < 4; ++m) _Pragma("unroll") for (int n = 0; n < 2; ++n) { \
        if constexpr (DT == 2) { if (m == 0 && n == 0) asm volatile("s_nop 1\n\tv_mfma_f32_16x16x128_f8f6f4 %0, %1, %2, %0" : "+v"(acc[ai][bj][m][n]) : "v"(Bt##8[n]), "v"(At##8[m]));   \
            else asm volatile("v_mfma_f32_16x16x128_f8f6f4 %0, %1, %2, %0" : "+v"(acc[ai][bj][m][n]) : "v"(Bt##8[n]), "v"(At##8[m])); } \
        else if constexpr (DT == 1) { _Pragma("unroll") for (int k = 0; k < 2; ++k) acc[ai][bj][m][n] = __builtin_amdgcn_mfma_f32_16x16x32_f16(__builtin_bit_cast(f16x8_t, Bt[n][k]), __builtin_bit_cast(f16x8_t, At[m][k]), acc[ai][bj][m][n], 0, 0, 0); } \
        else { _Pragma("unroll") for (int k = 0; k < 2; ++k) acc[ai][bj][m][n] = __builtin_amdgcn_mfma_f32_16x16x32_bf16(Bt[n][k], At[m][k], acc[ai][bj][m][n], 0, 0, 0); } } \
        __builtin_amdgcn_s_setprio(0); } while (0)
#define PG8_WAIT_V(n) asm volatile("s_waitcnt vmcnt(" #n ")" ::: "memory")
#define PG8_WAIT_L(n) asm volatile("s_waitcnt lgkmcnt(" #n ")" ::: "memory")
#define PG8_BAR __builtin_amdgcn_s_barrier()
#define PG8_SCHED __builtin_amdgcn_sched_barrier(0)
    Unit cur, nxt; int ui = 0;
    if (!S.next(0, cur)) return;
    f32x4 acc[2][2][4][2];
#pragma unroll
    for (int a = 0; a < 2; ++a)
#pragma unroll
        for (int b = 0; b < 2; ++b)
#pragma unroll
            for (int m = 0; m < 4; ++m)
#pragma unroll
                for (int n = 0; n < 2; ++n) acc[a][b][m][n] = (f32x4){0.f, 0.f, 0.f, 0.f};
    bf16x8 At[4][2], B0[2][2], B1[2][2]; v8i_t At8[4], B08[2], B18[2];
    const char* cA = (const char*)g.A + (size_t)cur.pm * tstepA; const char* cB = (const char*)g.Bt + (size_t)cur.pn * tstep;
    S.a_ready(cur);
    if constexpr (SP2) {
        PG8_STAGE(PG8_SB(0, 0), cB, voffB); PG8_STAGE(PG8_SB(0, 1), cB + hstep, voffB); PG8_STAGE(PG8_SA(0, 0), cA, voffA); PG8_STAGE(PG8_SA(0, 1), cA + hstepA, voffA);
        if (wr == 1) PG8_BAR;
        PG8_WAIT_V(2); PG8_BAR;
        PG8_STAGE(PG8_SB(1, 0), cB + kstep, voffB); PG8_STAGE(PG8_SA(1, 0), cA + kstep, voffA); PG8_STAGE(PG8_SB(1, 1), cB + hstep + kstep, voffB);
        PG8_WAIT_V(6); PG8_BAR;
    } else {
        PG8_STAGE(PG8_SB(0, 0), cB, voffB); PG8_STAGE(PG8_SA(0, 0), cA, voffA); PG8_STAGE(PG8_SB(0, 1), cB + hstep, voffB); PG8_STAGE(PG8_SA(0, 1), cA + hstepA, voffA);
        if (wr == 1) PG8_BAR;
        PG8_WAIT_V(4); PG8_BAR;
        PG8_STAGE(PG8_SB(1, 0), cB + kstep, voffB); PG8_STAGE(PG8_SA(1, 0), cA + kstep, voffA); PG8_STAGE(PG8_SB(1, 1), cB + hstep + kstep, voffB);
        PG8_WAIT_V(6); PG8_BAR;
    }
    for (;;) {
        const bool has_next = S.next(ui + 1, nxt);
        const char* nA = has_next ? (const char*)g.A + (size_t)nxt.pm * tstepA : cA; const char* nB = has_next ? (const char*)g.Bt + (size_t)nxt.pn * tstep : cB;
#pragma unroll 1
        for (int t = 0; t < nt; t += 2) {
            if constexpr (Epi::MID) { if (t == (nt >> 1) - 2) E.pre(E.R, cur, wr, wc, fr, fq); if (t == nt - 2) E.pre(E.SP, cur, wr, wc, fr, fq); }
            if constexpr (Epi::MID) { if (t == (nt >> 1)) { if constexpr (DT == 2) asm volatile("s_nop 15\n\ts_nop 15" ::: "memory"); __builtin_amdgcn_sched_barrier(0); E.mid(acc, cur, wr, wc, fr, fq); if constexpr (DT == 2) { __builtin_amdgcn_sched_barrier(0); asm volatile("s_nop 4" ::: "memory"); } } }
            asm volatile("" : "+v"(voffA[0]), "+v"(voffA[1]), "+v"(voffB[0]), "+v"(voffB[1]));
            const bool last = (t == nt - 2);
            const char* a1 = cA + (size_t)(t + 1) * kstep;
            const char* a2 = last ? nA : cA + (size_t)(t + 2) * kstep; const char* b2 = last ? nB : cB + (size_t)(t + 2) * kstep;
            const char* a3 = a2 + kstep; const char* b3 = b2 + kstep;
            if (last && has_next) S.a_ready(nxt);
            if constexpr (SP2) {
            PG8_LDB(B0, 0, 0); PG8_LDB(B1, 0, 1); PG8_SCHED; PG8_LDA(At, 0, 0); PG8_STAGE(PG8_SA(1, 1), a1 + hstepA, voffA);
            PG8_WAIT_V(8); PG8_WAIT_L(0); PG8_BAR; PG8_MMA(0, 0, At, B0); PG8_MMA(0, 1, At, B1); PG8_BAR; PG8_SCHED;
            PG8_LDA(At, 0, 1); PG8_STAGE(PG8_SB(0, 0), b2, voffB); PG8_STAGE(PG8_SB(0, 1), b2 + hstep, voffB); PG8_STAGE(PG8_SA(0, 0), a2, voffA);
            PG8_WAIT_V(8); PG8_WAIT_L(0); PG8_BAR; PG8_MMA(1, 0, At, B0); PG8_MMA(1, 1, At, B1); PG8_BAR; PG8_SCHED;
            PG8_LDB(B0, 1, 0); PG8_LDB(B1, 1, 1); PG8_SCHED; PG8_LDA(At, 1, 0); PG8_STAGE(PG8_SA(0, 1), a2 + hstepA, voffA);
            PG8_WAIT_V(8); PG8_WAIT_L(0); PG8_BAR; PG8_MMA(0, 0, At, B0); PG8_MMA(0, 1, At, B1); PG8_BAR; PG8_SCHED;
            PG8_LDA(At, 1, 1); PG8_STAGE(PG8_SB(1, 0), b3, voffB); PG8_STAGE(PG8_SB(1, 1), b3 + hstep, voffB); PG8_STAGE(PG8_SA(1, 0), a3, voffA);
            PG8_WAIT_V(8); PG8_WAIT_L(0); PG8_BAR; PG8_MMA(1, 0, At, B0); PG8_MMA(1, 1, At, B1); PG8_BAR; PG8_SCHED;
            } else {
            PG8_LDB(B0, 0, 0); PG8_SCHED; PG8_LDA(At, 0, 0); PG8_STAGE(PG8_SA(1, 1), a1 + hstepA, voffA);
            PG8_WAIT_L(8); PG8_BAR; PG8_WAIT_L(0); PG8_MMA(0, 0, At, B0); PG8_BAR; PG8_SCHED;
            PG8_LDB(B1, 0, 1); PG8_STAGE(PG8_SB(0, 0), b2, voffB);
            PG8_BAR; PG8_WAIT_L(0); PG8_MMA(0, 1, At, B1); PG8_BAR;
            PG8_LDA(At, 0, 1); PG8_STAGE(PG8_SA(0, 0), a2, voffA);
            PG8_BAR; PG8_WAIT_L(0); PG8_MMA(1, 0, At, B0); PG8_BAR; PG8_SCHED;
            PG8_STAGE(PG8_SB(0, 1), b2 + hstep, voffB);
            PG8_WAIT_V(6); PG8_BAR; PG8_MMA(1, 1, At, B1); PG8_BAR;
            PG8_LDB(B0, 1, 0); PG8_SCHED; PG8_LDA(At, 1, 0); PG8_STAGE(PG8_SA(0, 1), a2 + hstepA, voffA);
            PG8_WAIT_L(8); PG8_BAR; PG8_WAIT_L(0); PG8_MMA(0, 0, At, B0); PG8_BAR; PG8_SCHED;
            PG8_LDB(B1, 1, 1); PG8_STAGE(PG8_SB(1, 0), b3, voffB);
            PG8_BAR; PG8_WAIT_L(0); PG8_MMA(0, 1, At, B1); PG8_BAR;
            PG8_LDA(At, 1, 1); PG8_STAGE(PG8_SA(1, 0), a3, voffA);
            PG8_BAR; PG8_WAIT_L(0); PG8_MMA(1, 0, At, B0); PG8_BAR; PG8_SCHED;
            PG8_STAGE(PG8_SB(1, 1), b3 + hstep, voffB);
            PG8_WAIT_V(6); PG8_BAR; PG8_MMA(1, 1, At, B1); PG8_BAR;
            }
        }
        if constexpr (DT == 2) { asm volatile("s_nop 15\n\ts_nop 15" ::: "memory"); __builtin_amdgcn_sched_barrier(0); }
        if constexpr (ALIGN_EPI) { if (wr == 0) PG8_BAR; }
        if constexpr (!Epi::AFTER_DRAIN) { E(acc, cur, wr, wc, fr, fq); S.done(cur); }
        if (!has_next) break;
#pragma unroll
        for (int a = 0; a < 2; ++a)
#pragma unroll
            for (int b = 0; b < 2; ++b)
#pragma unroll
                for (int m = 0; m < 4; ++m)
#pragma unroll
                    for (int n = 0; n < 2; ++n) acc[a][b][m][n] = (f32x4){0.f, 0.f, 0.f, 0.f};
        cur = nxt; cA = nA; cB = nB; ++ui;
        if constexpr (ALIGN_EPI) { if (wr == 1) PG8_BAR; }
    }
    PG8_WAIT_V(0);
    if constexpr (!ALIGN_EPI) { if (wr == 0) PG8_BAR; }
    PG8_BAR;
    if constexpr (Epi::AFTER_DRAIN) { E.fused(acc, cur, wr, wc, fr, fq, lds, wid, lane); S.done(cur); }
#undef PG8_SA
#undef PG8_SB
#undef PG8_STAGE
#undef PG8_LD8
#undef PG8_LDA
#undef PG8_LDB
#undef PG8_MMA
#undef PG8_WAIT_V
#undef PG8_WAIT_L
#undef PG8_BAR
#undef PG8_SCHED
}
}

namespace att {
typedef unsigned short bf16_t;
typedef short bf16x8 __attribute__((ext_vector_type(8)));
typedef short s16x4 __attribute__((ext_vector_type(4)));
typedef _Float16 f16x8 __attribute__((ext_vector_type(8)));
typedef short v4i16_t __attribute__((ext_vector_type(4)));
typedef float f32x16 __attribute__((ext_vector_type(16)));
typedef float f32x32 __attribute__((ext_vector_type(32)));
typedef float f32x4 __attribute__((ext_vector_type(4)));
typedef float f32x2_t __attribute__((ext_vector_type(2)));
typedef __bf16 bf16x2_t __attribute__((ext_vector_type(2)));
typedef unsigned u32x4 __attribute__((ext_vector_type(4)));
#define ALAS __attribute__((address_space(3)))
typedef ALAS unsigned char* lptr;
constexpr int SEQ = 2048;
constexpr int LK = 0, LV = 32768, VSLOT = 8320, VDH = 4160, LBM = 66048, LWS = 74240, LOST = 76288, LBYTES = 109056;
constexpr float LOG2E = 1.4426950408889634f;
constexpr float THR = 8.0f;

__device__ __forceinline__ int crow(int r, int hi) { return (r & 3) + 8 * (r >> 2) + 4 * hi; }
__device__ __forceinline__ unsigned cvtpk_s(float lo, float hi) { f32x2_t v = {lo, hi}; bf16x2_t b = __builtin_convertvector(v, bf16x2_t); return __builtin_bit_cast(unsigned, b); }
__device__ __forceinline__ s16x4 vtr(lptr p) { return __builtin_bit_cast(s16x4, __builtin_amdgcn_ds_read_tr16_b64_v4i16((ALAS v4i16_t*)p)); }
__device__ __forceinline__ float bf_round(float f) { unsigned u = __float_as_uint(f); u = (u + 0x7fffu + ((u >> 16) & 1u)) & 0xffff0000u; return __uint_as_float(u); }
__device__ __forceinline__ unsigned fkey(float f) { const unsigned u = __float_as_uint(f); return u ^ ((unsigned)((int)u >> 31) | 0x80000000u); }
__device__ __forceinline__ int half_sum(int v) {
    v += __builtin_amdgcn_update_dpp(0, v, 0xB1, 0xF, 0xF, true);
    v += __builtin_amdgcn_update_dpp(0, v, 0x4E, 0xF, 0xF, true);
    v += __builtin_amdgcn_update_dpp(0, v, 0x141, 0xF, 0xF, true);
    v += __builtin_amdgcn_update_dpp(0, v, 0x140, 0xF, 0xF, true);
    auto rr = __builtin_amdgcn_permlane16_swap((unsigned)v, (unsigned)v, false, false);
    return (int)rr[0] + (int)rr[1];
}
__device__ __forceinline__ float relu1(float x) { const int i = __float_as_int(x); return __int_as_float(i > 0 ? i : 0); }
__device__ __forceinline__ void cnt4(int& c0, int& c1, float k0, float k1, float k2, float k3, float cand) {
    asm volatile("v_cmp_le_f32_e32 vcc, %6, %2\n\tv_addc_co_u32_e32 %0, vcc, 0, %0, vcc\n\tv_cmp_le_f32_e32 vcc, %6, %3\n\tv_addc_co_u32_e32 %1, vcc, 0, %1, vcc\n\t"
                 "v_cmp_le_f32_e32 vcc, %6, %4\n\tv_addc_co_u32_e32 %0, vcc, 0, %0, vcc\n\tv_cmp_le_f32_e32 vcc, %6, %5\n\tv_addc_co_u32_e32 %1, vcc, 0, %1, vcc"
                 : "+v"(c0), "+v"(c1) : "v"(k0), "v"(k1), "v"(k2), "v"(k3), "v"(cand) : "vcc");
}
__device__ __forceinline__ float dppf(float v, int ctl) { return ctl == 0 ? __uint_as_float(__builtin_amdgcn_update_dpp(0u, __float_as_uint(v), 0xB1, 0xF, 0xF, true)) : ctl == 1 ? __uint_as_float(__builtin_amdgcn_update_dpp(0u, __float_as_uint(v), 0x4E, 0xF, 0xF, true))
                                                        : ctl == 2 ? __uint_as_float(__builtin_amdgcn_update_dpp(0u, __float_as_uint(v), 0x141, 0xF, 0xF, true)) : __uint_as_float(__builtin_amdgcn_update_dpp(0u, __float_as_uint(v), 0x140, 0xF, 0xF, true)); }
__device__ __forceinline__ float half_max(float v) { v = __builtin_fmaxf(v, dppf(v, 0)); v = __builtin_fmaxf(v, dppf(v, 1)); v = __builtin_fmaxf(v, dppf(v, 2)); v = __builtin_fmaxf(v, dppf(v, 3));
    auto rr = __builtin_amdgcn_permlane16_swap(__float_as_uint(v), __float_as_uint(v), false, false); return __builtin_fmaxf(__uint_as_float(rr[0]), __uint_as_float(rr[1])); }
__device__ __forceinline__ float half_min(float v) { v = __builtin_fminf(v, dppf(v, 0)); v = __builtin_fminf(v, dppf(v, 1)); v = __builtin_fminf(v, dppf(v, 2)); v = __builtin_fminf(v, dppf(v, 3));
    auto rr = __builtin_amdgcn_permlane16_swap(__float_as_uint(v), __float_as_uint(v), false, false); return __builtin_fminf(__uint_as_float(rr[0]), __uint_as_float(rr[1])); }
#define MX3(a, b, c) __builtin_fmaxf(__builtin_fmaxf((a), (b)), (c))
__device__ __forceinline__ float rowmax(const f32x16& p0, const f32x16& p1) {
    float a = MX3(p0[0], p0[1], p1[0]), b = MX3(p0[2], p0[3], p1[1]); a = MX3(a, p1[2], p1[3]);
#pragma unroll
    for (int r = 4; r < 16; r += 4) { a = MX3(a, p0[r], p0[r + 1]); b = MX3(b, p0[r + 2], p0[r + 3]); a = MX3(a, p1[r], p1[r + 1]); b = MX3(b, p1[r + 2], p1[r + 3]); }
    float m = __builtin_fmaxf(a, b); auto rr = __builtin_amdgcn_permlane32_swap(__float_as_uint(m), __float_as_uint(m), false, false);
    return __builtin_fmaxf(__uint_as_float(rr[0]), __uint_as_float(rr[1])); }

struct Tensors { const bf16_t* Q; const bf16_t* K; const bf16_t* V; const bf16_t* QI; const bf16_t* KI; const float* WI; unsigned char* AP; float qk2; };

__device__ __forceinline__ u32x4 tile_ld(const bf16_t* base, long row0, int tid) { const unsigned voff = (unsigned)((tid >> 3) * 128 + (tid & 7) * 16); return *(const u32x4*)((const char*)(base + row0 * 64) + voff); }
__device__ __forceinline__ void kimg_st(lptr lds, int slot, int tid, u32x4 v) { const int row = tid >> 3, ch = tid & 7; *(ALAS u32x4*)(lds + LK + slot * 8192 + row * 128 + ((ch ^ ((row >> 1) & 7)) << 4)) = v; }
__device__ __forceinline__ void kimg_dma(lptr lds, int slot, int wid, int lane, const bf16_t* base, long row0) {
    const int row = 8 * wid + (lane >> 3), ch = (lane & 7) ^ ((row >> 1) & 7);
    __builtin_amdgcn_global_load_lds((const unsigned*)((const char*)(base + row0 * 64) + row * 128 + ch * 16), (ALAS unsigned*)(lds + LK + slot * 8192 + wid * 1024), 16, 0, 0);
}
__device__ __forceinline__ int kfrag_off(int r32, int hi, int d0) { return r32 * 128 + (((2 * d0 + hi) ^ ((r32 >> 1) & 7)) << 4); }
__device__ __forceinline__ void vimg_st(lptr lds, int slot, int tid, u32x4 v) { *(ALAS u32x4*)(lds + LV + slot * VSLOT + ((tid & 7) >> 2) * VDH + (tid >> 3) * 64 + (tid & 3) * 16) = v; }

struct UnitPF { bf16x8 qi[4]; f32x4 wv[4]; };
__device__ __forceinline__ void unit_prefetch(UnitPF& pf, int b, int qb, const Tensors& T, const int wave_s, lptr lds, const bool dma) {
    int tid = threadIdx.x; asm volatile("" : "+v"(tid));
    const int lane = tid & 63, r32 = lane & 31, hi = lane >> 5; const int wid = __builtin_amdgcn_readfirstlane(threadIdx.x >> 6);
    const int t0 = qb * 32, NT = (qb >> 1) + 1; const long rowbase = (long)b * SEQ; const long tq_row = rowbase + t0 + 4 * wid + (r32 >> 3);
#pragma unroll
    for (int d0 = 0; d0 < 4; ++d0) pf.qi[d0] = *(const bf16x8*)(T.QI + tq_row * 512 + (r32 & 7) * 64 + d0 * 16 + hi * 8);
#pragma unroll
    for (int g = 0; g < 4; ++g) pf.wv[g] = *(const f32x4*)(T.WI + (rowbase + t0 + 4 * wid + g) * 8 + 4 * hi);
    if (dma) {
#pragma unroll
        for (int t = 0; t < 4; ++t) if (t < NT) kimg_dma(lds, t, wid, lane, T.KI, rowbase + 64 * t);
    }
}
__device__ __forceinline__ void attn_unit(int b, int qb, const Tensors& T, lptr lds, UnitPF& pf, bool has_next, int nb, int nqb, const int wave_s) {
    int tid_ = threadIdx.x; asm volatile("" : "+v"(tid_));
    const int tid = tid_, lane = tid & 63, r32 = lane & 31, hi = lane >> 5; const int wid = __builtin_amdgcn_readfirstlane(threadIdx.x >> 6);
    const int t0 = qb * 32, NT = (qb >> 1) + 1;
    const long rowbase = (long)b * SEQ;
    const int g_row = r32 >> 3, h_row = r32 & 7;
    const long tq_row = rowbase + t0 + 4 * wid + g_row;

    f32x32 keyv[2][2];
#define KEY(j, n, pr) keyv[n][pr][j]
#ifndef REP_IDX
#define REP_IDX 1
#endif
#ifndef REP_SEL
#define REP_SEL 1
#endif
#ifndef REP_ATT
#define REP_ATT 1
#endif
#pragma unroll 1
    for (int rep_i = 0; rep_i < REP_IDX; ++rep_i) {
        bf16x8 qi[4]; f32x4 wv[4];
#pragma unroll
        for (int d0 = 0; d0 < 4; ++d0) { qi[d0] = pf.qi[d0]; wv[d0] = pf.wv[d0]; }
        const int lanev = r32 - hi;
        __syncthreads();
        int kfo0 = kfrag_off(r32, hi, 0); asm volatile("" : "+v"(kfo0));
        bf16x8 F[8];
#pragma unroll
        for (int q = 0; q < 8; ++q) F[q] = *(const ALAS bf16x8*)(lds + LK + (kfo0 ^ ((q >> 1) << 5)) + (q & 1) * 4096);
#pragma unroll
        for (int n = 0; n < 2; ++n) { keyv[n][0] = (f32x32)(__builtin_nanf("")); keyv[n][1] = (f32x32)(__builtin_nanf("")); }
#pragma unroll 1
        for (int jb = 0; jb < NT; jb += 2) {
#pragma unroll
            for (int u = 0; u < 2; ++u) {
                const int j = jb + u;
                if (u == 0 || j < NT) {
                    if (u == 0) {
                        if (j + 4 < NT) kimg_dma(lds, (j + 4) % 6, wid, lane, T.KI, rowbase + 64 * (j + 4));
                        if (j + 5 < NT) kimg_dma(lds, (j + 5) % 6, wid, lane, T.KI, rowbase + 64 * (j + 5));
                    }
                    f32x16 acc0 = {}, acc1 = {};
#pragma unroll
                    for (int d0 = 0; d0 < 4; ++d0) {
                        acc0 = __builtin_amdgcn_mfma_f32_32x32x16_f16(__builtin_bit_cast(f16x8, qi[d0]), __builtin_bit_cast(f16x8, F[2 * d0]), acc0, 0, 0, 0);
                        acc1 = __builtin_amdgcn_mfma_f32_32x32x16_f16(__builtin_bit_cast(f16x8, qi[d0]), __builtin_bit_cast(f16x8, F[2 * d0 + 1]), acc1, 0, 0, 0);
                    }
                    __builtin_amdgcn_sched_barrier(0);
                    if (j + 1 < NT) {
                        const int so = ((j + 1) % 6) * 8192;
#pragma unroll
                        for (int q = 0; q < 8; ++q) F[q] = *(const ALAS bf16x8*)(lds + LK + so + (kfo0 ^ ((q >> 1) << 5)) + (q & 1) * 4096);
                    }
                    __builtin_amdgcn_sched_barrier(0);
#pragma unroll
                    for (int n = 0; n < 2; ++n) {
                        const f32x16& acc = n ? acc1 : acc0;
                        float part[4];
#pragma unroll
                        for (int g = 0; g < 4; ++g) {
                            float s = wv[g][0] * relu1(acc[4 * g]);
                            s = __builtin_fmaf(wv[g][1], relu1(acc[4 * g + 1]), s);
                            s = __builtin_fmaf(wv[g][2], relu1(acc[4 * g + 2]), s);
                            s = __builtin_fmaf(wv[g][3], relu1(acc[4 * g + 3]), s);
                            part[g] = s;
                        }
#pragma unroll
                        for (int pr = 0; pr < 2; ++pr) {
                            auto rr = __builtin_amdgcn_permlane32_swap(__float_as_uint(part[2 * pr]), __float_as_uint(part[2 * pr + 1]), false, false);
                            const float v = __uint_as_float(rr[0]) + __uint_as_float(rr[1]);
                            const int urel = t0 + 4 * wid + 2 * pr - 64 * j - 32 * n;
                            KEY(j, n, pr) = (lanev <= urel) ? v : __builtin_nanf("");
                        }
                    }
                    if (u == 1) __syncthreads();
                }
            }
        }
        __syncthreads();
    }
    int tidL = tid; asm volatile("" : "+v"(tidL));
    const int lane3 = tidL & 63, r32c = lane3 & 31, hic = lane3 >> 5;
    const long tq_row3 = rowbase + t0 + 4 * wid + (r32c >> 3);
    bf16x8 qr[4];
#pragma unroll
    for (int d0 = 0; d0 < 4; ++d0) qr[d0] = *(const bf16x8*)(T.Q + tq_row3 * 512 + (r32c & 7) * 64 + d0 * 16 + hic * 8);
    u32x4 sk = tile_ld(T.K, rowbase + 64 * (NT - 1), tidL), sv = tile_ld(T.V, rowbase + 64 * (NT - 1), tidL);
    u32x4 sk2 = tile_ld(T.K, rowbase + 64 * (NT > 1 ? NT - 2 : 0), tidL), sv2 = tile_ld(T.V, rowbase + 64 * (NT > 1 ? NT - 2 : 0), tidL);
    u32x4 skA = tile_ld(T.K, rowbase + 64 * (NT > 2 ? NT - 3 : 0), tidL), svA = tile_ld(T.V, rowbase + 64 * (NT > 2 ? NT - 3 : 0), tidL);
    u32x4 skB = tile_ld(T.K, rowbase + 64 * (NT > 3 ? NT - 4 : 0), tidL), svB = tile_ld(T.V, rowbase + 64 * (NT > 3 ? NT - 4 : 0), tidL);
    ALAS unsigned* bm = (ALAS unsigned*)(lds + LBM) + wid * 256;
#pragma unroll 1
    for (int rep_s = 0; rep_s < REP_SEL; ++rep_s) {
        float Tk[2], lo[2], hi2[2], fl[2], fh[2]; bool done[2], conv[2], strad[2]; int nq[2], side[2];
#pragma unroll
        for (int pr = 0; pr < 2; ++pr) {
            nq[pr] = t0 + 4 * wid + 2 * pr + hi + 1;
            Tk[pr] = -__builtin_inff(); done[pr] = (nq[pr] <= 256); conv[pr] = done[pr]; lo[pr] = 0.f; hi2[pr] = 0.f; strad[pr] = false;
            fl[pr] = __builtin_amdgcn_logf((float)nq[pr]) - 8.0028150f; fh[pr] = -9.0028150f; side[pr] = 0;
        }
        if (!__all(done[0] && done[1])) {
#pragma unroll
            for (int pr = 0; pr < 2; ++pr) {
                float vmax = -__builtin_inff(), vmin = __builtin_inff();
#pragma unroll
                for (int jg = 0; jg < 8; ++jg) if (4 * jg < NT) {
#pragma unroll
                    for (int q = 0; q < 4; ++q)
#pragma unroll
                        for (int n = 0; n < 2; ++n) { vmax = __builtin_fmaxf(vmax, KEY(4 * jg + q, n, pr)); vmin = __builtin_fminf(vmin, KEY(4 * jg + q, n, pr)); }
                }
                lo[pr] = half_min(vmin); float h = half_max(vmax);
                { const int hb = __float_as_int(h); h = (h == 0.f) ? 1.4e-45f : __int_as_float(hb + (hb >= 0 ? 1 : -1)); }
                hi2[pr] = h;
                strad[pr] = (lo[pr] < 0.f) & (h > 0.f);
            }
#pragma unroll 1
            for (int it = 0; it < 96; ++it) {
                float mid[2];
#pragma unroll
                for (int pr = 0; pr < 2; ++pr) {
                    float m = lo[pr] + (hi2[pr] - lo[pr]) * (fl[pr] * __builtin_amdgcn_rcpf(fl[pr] - fh[pr]));
                    const float mb = 0.5f * lo[pr] + 0.5f * hi2[pr];
                    const bool in1 = (m > lo[pr]) & (m < hi2[pr]);
                    m = ((it >= 14) | !in1) ? mb : m;
                    if (it == 0) m = strad[pr] ? ((hi2[pr] > 1.4e-45f) ? 1.4e-45f : 0.f) : m;
                    if (it == 1) m = (strad[pr] & (hi2[pr] == 1.4e-45f) & (lo[pr] < 0.f)) ? 0.f : m;
                    const bool in2 = (m > lo[pr]) & (m < hi2[pr]);
                    conv[pr] = conv[pr] | !in2 | done[pr];
                    mid[pr] = m;
                }
                if (__all(conv[0] & conv[1])) break;
                int c0a = 0, c0b = 0, c1a = 0, c1b = 0;
#pragma unroll
                for (int jg = 0; jg < 8; ++jg) if (4 * jg < NT) {
                    cnt4(c0a, c0b, KEY(4 * jg, 0, 0), KEY(4 * jg, 1, 0), KEY(4 * jg + 1, 0, 0), KEY(4 * jg + 1, 1, 0), mid[0]);
                    cnt4(c1a, c1b, KEY(4 * jg, 0, 1), KEY(4 * jg, 1, 1), KEY(4 * jg + 1, 0, 1), KEY(4 * jg + 1, 1, 1), mid[1]);
                    cnt4(c0a, c0b, KEY(4 * jg + 2, 0, 0), KEY(4 * jg + 2, 1, 0), KEY(4 * jg + 3, 0, 0), KEY(4 * jg + 3, 1, 0), mid[0]);
                    cnt4(c1a, c1b, KEY(4 * jg + 2, 0, 1), KEY(4 * jg + 2, 1, 1), KEY(4 * jg + 3, 0, 1), KEY(4 * jg + 3, 1, 1), mid[1]);
                }
                int c[2]; c[0] = half_sum(c0a + c0b); c[1] = half_sum(c1a + c1b);
#pragma unroll
                for (int pr = 0; pr < 2; ++pr) {
                    const bool ge = (c[pr] >= 256), ul = !conv[pr] & ge, uh = !conv[pr] & !ge;
                    const float fc = __builtin_amdgcn_logf((float)c[pr] + (ge ? 0.f : 0.5f)) - 8.0028150f;
                    const float fhn = ul ? ((side[pr] > 0) ? 0.5f * fh[pr] : fh[pr]) : (uh ? fc : fh[pr]), fln = uh ? ((side[pr] < 0) ? 0.5f * fl[pr] : fl[pr]) : (ul ? fc : fl[pr]);
                    fh[pr] = fhn; fl[pr] = fln; side[pr] = ul ? 1 : (uh ? -1 : side[pr]);
                    lo[pr] = ul ? mid[pr] : lo[pr]; hi2[pr] = uh ? mid[pr] : hi2[pr]; done[pr] = done[pr] | (ul & (c[pr] == 256));
                }
            }
#pragma unroll
            for (int pr = 0; pr < 2; ++pr) { Tk[pr] = lo[pr]; if (nq[pr] <= 256) { Tk[pr] = -__builtin_inff(); done[pr] = true; } }
        }
#pragma unroll
        for (int pr = 0; pr < 2; ++pr) {
        if (__all(done[pr])) {
#pragma unroll
            for (int jh = 0; jh < 2; ++jh) if (16 * jh < NT) {
                unsigned wx = 0u;
#pragma unroll
                for (int j = 16 * jh; j < 16 * jh + 16; ++j) if (j < NT) {
#pragma unroll
                    for (int n = 0; n < 2; ++n) {
                        const unsigned long long pb = __ballot(KEY(j, n, pr) >= Tk[pr]);
                        asm volatile("s_nop 1\n\tv_writelane_b32 %0, %1, %3\n\tv_writelane_b32 %0, %2, %4" : "+v"(wx) : "s"((unsigned)pb), "s"((unsigned)(pb >> 32)), "i"(2 * (j & 15) + n), "i"(32 + 2 * (j & 15) + n));
                    }
                }
                bm[(32 * jh + r32) * 4 + 2 * pr + hi] = wx;
            }
        } else {
        int gt = 0;
#pragma unroll
        for (int j = 0; j < 32; ++j) if (j < NT) { gt += (KEY(j, 0, pr) > Tk[pr]) ? 1 : 0; gt += (KEY(j, 1, pr) > Tk[pr]) ? 1 : 0; }
        gt = half_sum(gt);
        const int need = 256 - gt; int seen = 0;
#pragma unroll
        for (int j = 0; j < 32; ++j) if (j < NT) {
#pragma unroll
            for (int n = 0; n < 2; ++n) {
                const float k = KEY(j, n, pr); const bool eq = (k == Tk[pr]);
                const unsigned long long bal = __ballot(eq);
                const unsigned mine = hi ? (unsigned)(bal >> 32) : (unsigned)bal;
                const int before = __popc(mine & ((1u << r32) - 1u));
                const bool pick = (k > Tk[pr]) || (eq && (seen + before < need));
                const unsigned long long pb = __ballot(pick);
                if (r32 == 0) bm[(2 * j + n) * 4 + 2 * pr + hi] = hi ? (unsigned)(pb >> 32) : (unsigned)pb;
                seen += __popc(mine);
            }
        }
        }
        }
    }
    const int laneA = mk_lane() & 63, r32a = laneA & 31, hia = laneA >> 5, tidA = wid * 64 + laneA;
    const int h_c = r32a & 7, g_c = r32a >> 3;
    bf16x8 qx;
    {
        const float c1 = bf_round(LOG2E), c2 = bf_round(LOG2E - c1), c3 = bf_round((LOG2E - c1) - c2), sc = __builtin_amdgcn_exp2f(-(float)(h_c + 1));
        const unsigned a1 = __float_as_uint(c1 * sc) >> 16, a2 = __float_as_uint(c2 * sc) >> 16, a3 = __float_as_uint(c3 * sc) >> 16, one = 0x3F80u;
        u32x4 w;
        w.x = hia ? ((g_c == 0 ? one : 0u) | ((g_c == 1 ? one : 0u) << 16)) : (a1 | (a2 << 16));
        w.y = hia ? ((g_c == 2 ? one : 0u) | ((g_c == 3 ? one : 0u) << 16)) : (a3 | (a1 << 16));
        w.z = hia ? 0u : (a2 | (a3 << 16)); w.w = 0u;
        qx = __builtin_bit_cast(bf16x8, w);
    }
    unsigned spk[2];
#pragma unroll
    for (int n = 0; n < 2; ++n) { const unsigned s = __float_as_uint((float)(32 * n + r32a)) >> 16; spk[n] = s | (s << 16); }
    const unsigned hmc = 0u - (unsigned)hia; unsigned spkz[2];
#pragma unroll
    for (int n = 0; n < 2; ++n) spkz[n] = (spk[n] & ~hmc) | (0x3F803F80u & hmc);
    const unsigned kww = 0x3F80u & hmc;
    const unsigned nhm = ~hmc, Klo = hmc & 0x0000C680u, Khi = hmc & 0xC6800000u;
    unsigned spkh0[2];
#pragma unroll
    for (int n = 0; n < 2; ++n) spkh0[n] = spk[n] & 0xffff0000u & nhm;
    ALAS float* wsf = (ALAS float*)(lds + LWS) + wid * 64;
    const ALAS u32x4* bmw = (const ALAS u32x4*)((ALAS unsigned*)(lds + LBM) + wid * 256);
    float mhat = 0.f; f32x16 o[2]; o[0] = f32x16{}; o[1] = f32x16{};
    const bool fastok = (T.qk2 < 100.f); bool need = true;
    f32x16 ol = f32x16{};
    const bf16x8 ones8 = __builtin_bit_cast(bf16x8, (u32x4){0x3F803F80u, 0x3F803F80u, 0x3F803F80u, 0x3F803F80u});
#pragma unroll 1
    for (int rep_a = 0; rep_a < REP_ATT; ++rep_a) {
        mhat = 0.f; ol = f32x16{}; o[0] = f32x16{}; o[1] = f32x16{}; need = true;
        kimg_st(lds, 0, tidA, sk); vimg_st(lds, 0, tidA, sv);
        if (NT > 1) { kimg_st(lds, 1, tidA, sk2); vimg_st(lds, 1, tidA, sv2); }
        __syncthreads();
#pragma unroll 1
        for (int jb = 0; jb < NT; jb += 2) {
#pragma unroll
          for (int u = 0; u < 2; ++u) {
            const int jj = jb + u;
            if (u == 0 || jj < NT) {
            const int j = NT - 1 - jj, slot = jj & 3;
            if (u == 0) {
                if (jj + 2 < NT) { kimg_st(lds, (jj + 2) & 3, tidA, skA); vimg_st(lds, (jj + 2) & 3, tidA, svA); }
                if (jj + 3 < NT) { kimg_st(lds, (jj + 3) & 3, tidA, skB); vimg_st(lds, (jj + 3) & 3, tidA, svB); }
                int tl = tidA; asm volatile("" : "+v"(tl));
                if (jj + 4 < NT) { skA = tile_ld(T.K, rowbase + 64 * (j - 4), tl); svA = tile_ld(T.V, rowbase + 64 * (j - 4), tl); }
                if (jj + 5 < NT) { skB = tile_ld(T.K, rowbase + 64 * (j - 5), tl); svB = tile_ld(T.V, rowbase + 64 * (j - 5), tl); }
            }
            const unsigned pp = __float_as_uint((float)(-64 * jj)) >> 16, ppk = pp | (pp << 16);
            const unsigned ppk0 = ppk & nhm, pp0 = pp & nhm;
            bf16x8 kx[2];
#pragma unroll
            for (int n = 0; n < 2; ++n) {
                const u32x4 W = bmw[2 * j + n];
                const unsigned m0 = (unsigned)__builtin_amdgcn_sbfe((int)W.x, (unsigned)r32a, 1u), m1 = (unsigned)__builtin_amdgcn_sbfe((int)W.y, (unsigned)r32a, 1u);
                const unsigned m2 = (unsigned)__builtin_amdgcn_sbfe((int)W.z, (unsigned)r32a, 1u), m3 = (unsigned)__builtin_amdgcn_sbfe((int)W.w, (unsigned)r32a, 1u);
                u32x4 w;
                w.x = (~m1 & Khi) | ((~m0 & Klo) | ppk0); w.y = (~m3 & Khi) | ((~m2 & Klo) | (pp0 | spkh0[n])); w.z = spkz[n]; w.w = kww;
                kx[n] = __builtin_bit_cast(bf16x8, w);
            }
            f32x16 p0 = f32x16{}, p1 = f32x16{};
#pragma unroll
            for (int d0 = 0; d0 < 4; ++d0) {
                const bf16x8 k0 = *(const ALAS bf16x8*)(lds + LK + slot * 8192 + kfrag_off(r32a, hia, d0));
                const bf16x8 k1 = *(const ALAS bf16x8*)(lds + LK + slot * 8192 + kfrag_off(r32a, hia, d0) + 4096);
                p0 = __builtin_amdgcn_mfma_f32_32x32x16_bf16(k0, qr[d0], p0, 0, 0, 0);
                p1 = __builtin_amdgcn_mfma_f32_32x32x16_bf16(k1, qr[d0], p1, 0, 0, 0);
            }
            p0 = __builtin_amdgcn_mfma_f32_32x32x16_bf16(kx[0], qx, p0, 0, 0, 0);
            p1 = __builtin_amdgcn_mfma_f32_32x32x16_bf16(kx[1], qx, p1, 0, 0, 0);
            if (need) {
            const float rm = rowmax(p0, p1);
            const bool first = (jj == 0);
            const float dl = first ? __builtin_fmaxf(rm, -2048.f) : (rm > THR ? rm : 0.f);
            if (first || __any(dl != 0.f)) {
                const float f = first ? 1.f : __builtin_amdgcn_exp2f(-dl);
                mhat += dl;
#pragma unroll
                for (int r = 0; r < 16; ++r) { p0[r] -= dl; p1[r] -= dl; }
                { const unsigned x0 = __float_as_uint(-mhat), t1 = x0 & 0xffff0000u; const float r1 = __uint_as_float(x0) - __uint_as_float(t1); const unsigned t2 = __float_as_uint(r1) & 0xffff0000u;
                  const float r2 = r1 - __uint_as_float(t2); const unsigned t3 = __float_as_uint(r2) & 0xffff0000u;
                  u32x4 w = __builtin_bit_cast(u32x4, qx); w.z = hia ? ((t1 >> 16) | t2) : w.z; w.w = hia ? (t3 >> 16) : w.w; qx = __builtin_bit_cast(bf16x8, w); }
                if (hia == 0) wsf[r32a] = f;
                asm volatile("s_waitcnt lgkmcnt(0)" ::: "memory");
#pragma unroll
                for (int r = 0; r < 16; ++r) { const float fr_ = wsf[crow(r, hia)]; o[0][r] *= fr_; o[1][r] *= fr_; ol[r] *= fr_; }
            }
            need = !fastok || __any(mhat <= -2047.f);
            }
            const lptr vb = lds + LV + slot * VSLOT + ((laneA >> 4) & 1) * 32 + (laneA & 3) * 8 + (4 * hia + ((laneA & 15) >> 2)) * 64;
#pragma unroll
            for (int half = 0; half < 2; ++half) {
                f32x16& ph = half ? p1 : p0;
#pragma unroll
                for (int r = 0; r < 16; ++r) ph[r] = __builtin_amdgcn_exp2f(ph[r]);
                u32x4 pw[2];
#pragma unroll
                for (int q = 0; q < 4; ++q) { pw[0][q] = cvtpk_s(ph[2 * q], ph[2 * q + 1]); pw[1][q] = cvtpk_s(ph[8 + 2 * q], ph[8 + 2 * q + 1]); }
#pragma unroll
                for (int kk = 0; kk < 2; ++kk) {
                    const int ks = 2 * half + kk;
#pragma unroll
                    for (int d0 = 0; d0 < 2; ++d0) {
                        const s16x4 lo = vtr(vb + d0 * VDH + ks * 1024), hh = vtr(vb + d0 * VDH + ks * 1024 + 512);
                        const bf16x8 vf = (bf16x8){lo[0], lo[1], lo[2], lo[3], hh[0], hh[1], hh[2], hh[3]};
                        o[d0] = __builtin_amdgcn_mfma_f32_32x32x16_bf16(__builtin_bit_cast(bf16x8, pw[kk]), vf, o[d0], 0, 0, 0);
                    }
                    ol = __builtin_amdgcn_mfma_f32_32x32x16_bf16(__builtin_bit_cast(bf16x8, pw[kk]), ones8, ol, 0, 0, 0);
                }
                if (half == 0) __builtin_amdgcn_sched_barrier(0);
            }
            if (u == 1) __syncthreads();
            }
          }
        }
        __syncthreads();
    }
    unit_prefetch(pf, has_next ? nb : b, has_next ? nqb : qb, T, wave_s, lds, has_next);
    ALAS unsigned char* stg = lds + LOST + wid * 4096;
#pragma unroll
    for (int r = 0; r < 16; ++r) {
        const int orow = crow(r, hia); const float rl = __builtin_amdgcn_rcpf(ol[r]);
#pragma unroll
        for (int d0 = 0; d0 < 2; ++d0) { const float ov = o[d0][r] * rl; stg[orow * 64 + d0 * 32 + r32a] = (unsigned char)(__builtin_amdgcn_cvt_pk_fp8_f32(ov, ov, 0u, false) & 0xffu); }
    }
    asm volatile("s_waitcnt lgkmcnt(0)" ::: "memory");
    int laneE = laneA; asm volatile("" : "+v"(laneE));
#pragma unroll
    for (int i = 0; i < 2; ++i) {
        const int row = i * 16 + (laneE >> 2), ch = laneE & 3;
        const u32x4 v = *(const ALAS u32x4*)(stg + row * 64 + ch * 16);
        *(u32x4*)(T.AP + (rowbase + t0 + 4 * wid + (row >> 3)) * 1024 + (row & 7) * 64 + ch * 16) = v;
    }
    __syncthreads();
}
#undef KEY
#undef MX3
}

constexpr int NWAVES = 8;
constexpr int D = 1024, NB = 16, SEQ = 2048, TOK = NB * SEQ, FF = 2816, DIN = 3784, N1 = 3840, N5 = 5632;
constexpr int OQ = 0, OKK = 512, OV = 576, OQI = 640, OKI = 1152, OWI = 1216, OU = 1224, OG = 1736;
constexpr float EPS = 1e-6f;
constexpr size_t MiB = 1u << 20;
constexpr size_t WS_CTL = 0, CTL_ZERO_BYTES = 64 * 1024;
constexpr size_t WS_W1T = 2 * MiB, WS_W3T = 10 * MiB, WS_W4T = 12 * MiB, WS_W5T = 14 * MiB, WS_W6T = 26 * MiB, WS_WP = 32 * MiB;
constexpr size_t WS_RSTD = 34 * MiB, WS_WI = 35 * MiB, WS_SSQ = 36 * MiB, WS_K = 38 * MiB, WS_V = 42 * MiB, WS_KI = 46 * MiB;
constexpr size_t WS_R = 52 * MiB, WS_SP = 116 * MiB, WS_AP = 180 * MiB, WS_XB = 244 * MiB, WS_Q = 308 * MiB, WS_QI = 340 * MiB, WS_U = 372 * MiB, WS_H2 = 436 * MiB, WS_END = 500 * MiB;
constexpr size_t WS_MG = WS_U;
constexpr size_t WS_ACT = WS_R;
constexpr size_t WS_XF8 = WS_AP;
constexpr size_t WS_W1T8 = WS_W1T + 4 * MiB;
constexpr size_t WS_H2F8 = WS_AP;
static_assert(WS_ACT + (size_t)TOK * pg8::ACT_PITCH <= WS_AP && pg8::ACT_PITCH * 4096 >= (8u << 20), "act overlay / gate images");
constexpr int CW_BAR = 1024;
constexpr int RING_BYTES = 131072, LDSCTL_OFF = RING_BYTES, MISC_OFF = LDSCTL_OFF + 320, LDS_BYTES = 147456;
static_assert(att::LBYTES <= RING_BYTES, "attention scratch inside the ring region");

#define LAS __attribute__((address_space(3)))
#define GAS __attribute__((address_space(1)))
typedef unsigned short bf16;
typedef unsigned v4u __attribute__((ext_vector_type(4)));
typedef float f32x4 __attribute__((ext_vector_type(4)));
#define LDS_WAIT() asm volatile("s_waitcnt lgkmcnt(0)" ::: "memory")
__device__ __forceinline__ unsigned pk2(float lo, float hi) { return pg8::cvt_pk_bf16(lo, hi); }
__device__ __forceinline__ float wave_sum(float v) {
#pragma unroll
    for (int o = 1; o < 64; o <<= 1) v += __shfl_xor(v, o);
    return v;
}

#define XB_TMO      128
#define XB_XCNT(j)  (256  + 64 * (j))
#define XB_XSUB(j)  (1280 + 64 * (j))
#define XB_XGEN(j)  (2304 + 64 * (j))
#define XB_TOP      3328
#define XB_TOPGEN   3392
#define XCD_BAR_WORDS 3456
#define XB_GM(g)    (3520 + 64 * (g))
#define XB_SPIN_CAP (1u << 18)

__device__ __forceinline__ unsigned xb_ld(unsigned* p)              { return __hip_atomic_load(p, __ATOMIC_RELAXED, __HIP_MEMORY_SCOPE_AGENT); }
__device__ __forceinline__ unsigned xb_add(unsigned* p, unsigned v) { return __hip_atomic_fetch_add(p, v, __ATOMIC_RELAXED, __HIP_MEMORY_SCOPE_AGENT); }
__device__ __forceinline__ unsigned xb_xcc_id() { return (unsigned)__builtin_amdgcn_s_getreg((3 << 11) | 20) & 0xFu; }
#define XB_SPIN(cond, bar) do { unsigned _sp = 0; while (cond) { __builtin_amdgcn_s_sleep(1); \
    if ((++_sp & 255u) == 0u) { if (xb_ld(&(bar)[XB_TMO])) break; if (_sp > XB_SPIN_CAP) { atomicAdd(&(bar)[XB_TMO], 1u); break; } } } } while (0)

struct XcdBarrier {
    unsigned* bar; unsigned x;
    int lead;
    volatile LAS unsigned* st;
};

__device__ __forceinline__ XcdBarrier xcd_barrier_post(unsigned* bar, volatile LAS unsigned* st, const int wave_s) {
    XcdBarrier b; b.bar = bar; b.x = xb_xcc_id(); b.st = st; b.lead = (wave_s == 0) ? 1 : 0;
    if (b.lead && mk_lane() == 0) { (void)__hip_atomic_fetch_or(&bar[XB_GM(blockIdx.x & 7u)], 1u << b.x, __ATOMIC_RELAXED, __HIP_MEMORY_SCOPE_AGENT); (void)xb_add(&bar[XB_XCNT(b.x)], 1u); }
    return b;
}
__device__ __forceinline__ void xcd_barrier_complete(unsigned* bar, unsigned x, unsigned& nloc, unsigned& nx) {
    const unsigned G = gridDim.x * gridDim.y * gridDim.z;
    unsigned sum, cnt, mine, sp = 0u;
    for (;;) {
        sum = 0u; cnt = 0u; mine = 0u;
#pragma unroll
        for (unsigned j = 0; j < 16; ++j) { const unsigned c = xb_ld(&bar[XB_XCNT(j)]); sum += c; cnt += (c > 0u) ? 1u : 0u; mine = (j == x) ? c : mine; }
        if (sum == G) break;
        __builtin_amdgcn_s_sleep(1);
        if ((++sp & 255u) == 0u) { if (xb_ld(&bar[XB_TMO])) break; if (sp > XB_SPIN_CAP) { atomicAdd(&bar[XB_TMO], 1u); break; } }
    }
    nloc = mine > 0u ? mine : 1u; nx = cnt > 0u ? cnt : 1u;
}

__device__ __forceinline__ void xcd_barrier(const XcdBarrier& b, const bool want_local) {
    asm volatile("s_waitcnt vmcnt(0)" ::: "memory");
    __syncthreads();
    if (b.lead && mk_lane() == 0) {
        unsigned* bar = b.bar;
        __builtin_amdgcn_s_waitcnt(0);
        unsigned nloc = b.st[0], nx = b.st[1];
        if (nloc == 0u) { xcd_barrier_complete(bar, b.x, nloc, nx); b.st[0] = nloc; b.st[1] = nx; }
        const unsigned old = xb_add(&bar[XB_XSUB(b.x)], 1u);
        const unsigned gen = old / nloc;
        const bool local = want_local && (b.st[2] == 1u);
        if (old + 1u == (gen + 1u) * nloc && local) {
            __builtin_amdgcn_fence(__ATOMIC_ACQUIRE, "agent");
            xb_add(&bar[XB_XGEN(b.x)], 1u);
            asm volatile("s_waitcnt vmcnt(0)" ::: "memory");
        } else if (old + 1u == (gen + 1u) * nloc) {
            __builtin_amdgcn_fence(__ATOMIC_RELEASE, "agent");
            asm volatile("s_waitcnt vmcnt(0)" ::: "memory");
            const unsigned og = xb_add(&bar[XB_TOP], 1u);
            const unsigned tg = og / nx;
            if (og + 1u == (tg + 1u) * nx) xb_add(&bar[XB_TOPGEN], 1u);
            else XB_SPIN(xb_ld(&bar[XB_TOPGEN]) == tg, bar);
            __builtin_amdgcn_fence(__ATOMIC_ACQUIRE, "agent");
            xb_add(&bar[XB_XGEN(b.x)], 1u);
            asm volatile("s_waitcnt vmcnt(0)" ::: "memory");
        } else {
            XB_SPIN(xb_ld(&bar[XB_XGEN(b.x)]) == gen, bar);
            __builtin_amdgcn_fence(__ATOMIC_ACQUIRE, "agent");
            asm volatile("s_waitcnt vmcnt(0)" ::: "memory");
        }
        if (b.st[2] == 0u) {
            unsigned all = 0u; bool ok = (gridDim.x == 256u);
#pragma unroll
            for (unsigned g = 0; g < 8; ++g) { const unsigned m = xb_ld(&bar[XB_GM(g)]); ok = ok && (m != 0u) && ((m & (m - 1u)) == 0u) && ((all & m) == 0u); all |= m; }
            b.st[2] = ok ? 1u : 2u;
        }
    }
    __syncthreads();
}

struct Args { const float* in[14]; float* out; unsigned char* ws; int ph_lo, ph_hi; };

template <int FMT>
__device__ __forceinline__ void tr_item(const float* W, int ldw, int k0, int c0, int nvalid, const float* gain, float scale, void* WTv, int ldt, int drow0, int dk0, LAS float* scr, int lane) {
    const int j = lane & 31;
    float tv[32];
#pragma unroll
    for (int i = 0; i < 32; ++i) { const int kk = 2 * i + (lane >> 5); tv[i] = (j < nvalid) ? W[(size_t)(k0 + kk) * ldw + c0 + j] : 0.f; }
#pragma unroll
    for (int i = 0; i < 32; ++i) { const int kk = 2 * i + (lane >> 5); float v = tv[i] * scale; if (gain) v *= gain[k0 + kk]; scr[kk * 33 + j] = v; }
    LDS_WAIT(); asm volatile("" ::: "memory");
    if (FMT == 2) {
        unsigned char* WT = (unsigned char*)WTv; const int c = lane & 3;
#pragma unroll
        for (int jj = 0; jj < 2; ++jj) { const int n = (lane >> 2) + 16 * jj; const LAS float* s = scr + (16 * c) * 33 + n;
            v4u o; o.x = pg8::pk4_fp8(s[0 * 33], s[1 * 33], s[2 * 33], s[3 * 33]); o.y = pg8::pk4_fp8(s[4 * 33], s[5 * 33], s[6 * 33], s[7 * 33]);
            o.z = pg8::pk4_fp8(s[8 * 33], s[9 * 33], s[10 * 33], s[11 * 33]); o.w = pg8::pk4_fp8(s[12 * 33], s[13 * 33], s[14 * 33], s[15 * 33]);
            *(v4u*)(WT + (size_t)(drow0 + n) * ldt + dk0 + k0 + 16 * c) = o; }
    } else {
        bf16* WT = (bf16*)WTv; const int c = lane & 7;
#pragma unroll
        for (int jj = 0; jj < 4; ++jj) { const int n = (lane >> 3) + 8 * jj; const LAS float* s = scr + (8 * c) * 33 + n;
            v4u o;
            if (FMT == 1) { o.x = pg8::cvt_pk_f16(s[0 * 33], s[1 * 33]); o.y = pg8::cvt_pk_f16(s[2 * 33], s[3 * 33]); o.z = pg8::cvt_pk_f16(s[4 * 33], s[5 * 33]); o.w = pg8::cvt_pk_f16(s[6 * 33], s[7 * 33]); }
            else { o.x = pk2(s[0 * 33], s[1 * 33]); o.y = pk2(s[2 * 33], s[3 * 33]); o.z = pk2(s[4 * 33], s[5 * 33]); o.w = pk2(s[6 * 33], s[7 * 33]); }
            *(v4u*)(WT + (size_t)(drow0 + n) * ldt + dk0 + k0 + 8 * c) = o; }
    }
    LDS_WAIT(); asm volatile("" ::: "memory");
}
__device__ __forceinline__ void w1_map(int rg, int& c0, int& nvalid) {
    const int n0 = rg * 32, pn = n0 >> 8, c = n0 & 255, bj = c >> 7, wc = (c & 127) >> 5; nvalid = 32;
    if (pn < 2) c0 = OQ + (pn * 4 + wc) * 64 + 32 * bj;
    else if (pn == 2) { if (wc == 0) c0 = OKK + 32 * bj; else if (wc == 1) c0 = OV + 32 * bj; else if (wc == 2) c0 = OKI + 32 * bj; else { c0 = OWI; nvalid = bj == 0 ? 8 : 0; } }
    else if (pn < 5) c0 = OQI + ((pn - 3) * 4 + wc) * 64 + 32 * bj;
    else if (pn < 7) c0 = OU + (pn - 5) * 256 + c;
    else c0 = OG + bj * 1024 + (pn - 7) * 128 + (c & 127);
}

__device__ __forceinline__ unsigned unit_tab(int s) {
    unsigned r = 0x0c132c2fu;
    r = (s == 1) ? 0x031d293au : r;
    r = (s == 2) ? 0x0e1c2628u : r;
    r = (s == 3) ? 0x12212224u : r;
    r = (s == 4) ? 0x090d2e36u : r;
    r = (s == 5) ? 0x041e2b35u : r;
    r = (s == 6) ? 0x0b10253bu : r;
    r = (s == 7) ? 0x14161f30u : r;
    r = (s == 8) ? 0x07202338u : r;
    r = (s == 9) ? 0x02173139u : r;
    r = (s == 10) ? 0x08191b3eu : r;
    r = (s == 11) ? 0x0111333fu : r;
    r = (s == 12) ? 0x00183237u : r;
    r = (s == 13) ? 0x060a343du : r;
    r = (s == 14) ? 0x0f1a272au : r;
    r = (s == 15) ? 0x05152d3cu : r;
    return r;
}

template <int W>
__device__ __forceinline__ void pool_win(const bf16* Ub, unsigned char* AP, int tb, int tin, int c0) {
    unsigned long long rows[W + 15];
#pragma unroll
    for (int r = 0; r < W + 15; ++r) { const int rel = r - (W - 1); rows[r] = (tin + rel >= 0) ? *(const unsigned long long*)((const unsigned char*)Ub + (size_t)(tb + rel) * 512 + c0) : 0ull; }
    float sum[8];
#pragma unroll
    for (int e = 0; e < 8; ++e) sum[e] = 0.f;
#pragma unroll
    for (int r = 0; r < W - 1; ++r) { f32x4 a, b_; pg8::unpack8_fp8(rows[r], a, b_);
#pragma unroll
        for (int e = 0; e < 4; ++e) { sum[e] += a[e]; sum[4 + e] += b_[e]; } }
#pragma unroll
    for (int tt = 0; tt < 16; ++tt) {
        const int t = tin + tt; f32x4 a, b_; pg8::unpack8_fp8(rows[W - 1 + tt], a, b_);
#pragma unroll
        for (int e = 0; e < 4; ++e) { sum[e] += a[e]; sum[4 + e] += b_[e]; }
        if (tt > 0) { f32x4 a2, b2; pg8::unpack8_fp8(rows[tt - 1], a2, b2);
#pragma unroll
            for (int e = 0; e < 4; ++e) { sum[e] -= a2[e]; sum[4 + e] -= b2[e]; } }
        const float inv = 1.0f / (float)((t + 1 < W) ? t + 1 : W);
        f32x4 d0, d1;
#pragma unroll
        for (int e = 0; e < 4; ++e) { d0[e] = sum[e] * inv - a[e]; d1[e] = sum[4 + e] * inv - b_[e]; }
        *(unsigned long long*)(AP + (size_t)(tb + tt) * 1024 + 512 + c0) = pg8::pack8_fp8(d0, d1);
    }
}

__global__ void __launch_bounds__(NWAVES * 64, 2) mk_fwd(Args args) {
    extern __shared__ __attribute__((aligned(16))) unsigned char lds_raw[];
    LAS unsigned char* lds = (LAS unsigned char*)lds_raw;
    volatile LAS unsigned* MISC = (volatile LAS unsigned*)(lds + MISC_OFF);
    const int wave = __builtin_amdgcn_readfirstlane(threadIdx.x >> 6);
    const int G = gridDim.x; const int bx = blockIdx.x; const int vcu = (G % 8 == 0) ? (bx % 8) * (G / 8) + bx / 8 : bx;
    unsigned char* ws = args.ws;
    for (int u = wave * 64 + mk_lane(); u < (LDS_BYTES - LDSCTL_OFF) / 4; u += NWAVES * 64) ((LAS unsigned*)(lds + LDSCTL_OFF))[u] = 0u;
    __syncthreads();
    XcdBarrier bar; bar.bar = (unsigned*)(ws + WS_CTL) + CW_BAR; bar.x = 0; bar.st = nullptr; bar.lead = 0;
    if (!MK_PER_PHASE) bar = xcd_barrier_post((unsigned*)(ws + WS_CTL) + CW_BAR, MISC + 8, wave);
#define GRID_BAR() do { if (!MK_PER_PHASE) xcd_barrier(bar, false); } while (0)
#define GRID_BAR_L() do { if (!MK_PER_PHASE) xcd_barrier(bar, true); } while (0)
    const int lo = args.ph_lo, hi_ = args.ph_hi;
#define IN(k) (lo <= (k) && (k) < hi_)
#define BOTH(k) (IN(k) && IN((k) + 1))
    const int gw = vcu * NWAVES + wave, NGW = G * NWAVES;

    if (IN(0)) {
        const float* x = args.in[0]; const float* norm_mix = args.in[1]; const float* w_in = args.in[2]; const float* w_pg = args.in[5]; const float* pool_scale = args.in[6];
        const float* w_ba = args.in[7]; const float* w_bp = args.in[8]; const float* w_out = args.in[9]; const float* norm_ffn = args.in[10]; const float* w_g = args.in[11]; const float* w_u = args.in[12]; const float* w_d = args.in[13];
        bf16* W1T = (bf16*)(ws + WS_W1T); unsigned char* W3T = ws + WS_W3T; unsigned char* W4T = ws + WS_W4T; unsigned char* W5T = ws + WS_W5T; unsigned char* W6T = ws + WS_W6T;
        float* RSTD = (float*)(ws + WS_RSTD); bf16* XB = (bf16*)(ws + WS_XB); unsigned char* W1T8 = ws + WS_W1T8; unsigned char* XF8 = ws + WS_XF8;
        const int lane = mk_lane();
        LAS float* scr = (LAS float*)(lds + wave * 16384);
        constexpr int I1 = (N1 / 32) * (D / 64), I3 = (D / 32) * (512 / 64), I4 = (D / 32) * (D / 64), I5 = (N5 / 32) * (D / 64), I6 = (D / 32) * (FF / 64);
        constexpr int NITEMS = I1 + I3 + I4 + I5 + I6;
        for (int it = gw; it < NITEMS; it += NGW) {
            int r = it;
            if (r < I1) { const int rg = r / (D / 64), kb = r % (D / 64); int c0, nv; w1_map(rg, c0, nv); if (rg < 40) tr_item<1>(w_in, DIN, 64 * kb, c0, nv, norm_mix, 1.0f, W1T, D, rg * 32, 0, scr, lane); else tr_item<2>(w_in, DIN, 64 * kb, c0, nv, norm_mix, pg8::K_WSC, W1T8, D, rg * 32 - 1280, 0, scr, lane); continue; } r -= I1;
            if (r < I3) { const int rg = r / 8, kb = r % 8; tr_item<2>(w_ba, D, 64 * kb, rg * 32, 32, nullptr, pg8::K_WSC, W3T, D, rg * 32, 0, scr, lane); continue; } r -= I3;
            if (r < I4) { const int rg = r / 16, kb = r % 16; tr_item<2>(w_out, D, 64 * kb, rg * 32, 32, nullptr, pg8::K_WSC, W4T, D, rg * 32, 0, scr, lane); continue; } r -= I4;
            if (r < I5) { const int rg = r / 16, kb = r % 16; const int n0 = rg * 32, pn = n0 >> 8, c = n0 & 255; const float* src = (c >> 7) ? w_u : w_g;
                          tr_item<MK_FP8 ? 2 : 0>(src, FF, 64 * kb, pn * 128 + (c & 127), 32, norm_ffn, MK_FP8 ? pg8::K_WSC : 1.0f, W5T, D, rg * 32, 0, scr, lane); continue; } r -= I5;
            { const int rg = r / (FF / 64), kb = r % (FF / 64); tr_item<MK_FP8 ? 2 : 0>(w_d, D, 64 * kb, rg * 32, 32, nullptr, MK_FP8 ? pg8::K_WSC : 1.0f, W6T, FF, rg * 32, 0, scr, lane); }
        }
        for (int it = gw; it < 32 * 64; it += NGW) {
            const int i0 = (it >> 6) * 16, n0 = (it & 63) * 16, g = i0 >> 7, nl = lane & 15, q = lane >> 4;
#pragma unroll
            for (int k = 0; k < 8; ++k) { const int e = 4 * (lane + 64 * k), r = e >> 7, j = e & 127;
                const f32x4 a = *(const f32x4*)(w_pg + (size_t)i0 * 128 + e), c = *(const f32x4*)(pool_scale + g * 128 + j);
#pragma unroll
                for (int t = 0; t < 4; ++t) scr[(j + t) * 16 + r] = a[t] * c[t]; }
            float s0 = 0.f, s1 = 0.f, s2 = 0.f, s3 = 0.f;
            const float* bcol = w_bp + (size_t)(g * 128) * D + n0 + nl;
#pragma unroll
            for (int hb = 0; hb < 2; ++hb) {
                float bv[64];
#pragma unroll
                for (int j = 0; j < 64; ++j) bv[j] = bcol[(size_t)(hb * 64 + j) * D];
                LDS_WAIT(); asm volatile("" ::: "memory");
#pragma unroll
                for (int j = 0; j < 64; ++j) { const f32x4 a = *(const LAS f32x4*)(scr + (hb * 64 + j) * 16 + 4 * q);
                    s0 = __builtin_fmaf(a[0], bv[j], s0); s1 = __builtin_fmaf(a[1], bv[j], s1); s2 = __builtin_fmaf(a[2], bv[j], s2); s3 = __builtin_fmaf(a[3], bv[j], s3); }
            }
            LAS unsigned* ob = (LAS unsigned*)(scr + 2048);
            ob[nl * 4 + q] = pg8::pk4_fp8(s0 * pg8::K_WSC, s1 * pg8::K_WSC, s2 * pg8::K_WSC, s3 * pg8::K_WSC);
            LDS_WAIT(); asm volatile("" ::: "memory");
            if (lane < 16) *(v4u*)(W3T + (size_t)(n0 + lane) * D + 512 + i0) = *(const LAS v4u*)(ob + lane * 4);
            LDS_WAIT(); asm volatile("" ::: "memory");
        }
        const int xm_first = (G == 256) ? ((vcu >> 5) * 4096 + 4 * ((vcu & 31) * 8 + wave)) : gw * 4, xm_step = (G == 256) ? 1024 : NGW * 4, xm_end = (G == 256) ? ((vcu >> 5) * 4096 + 4096) : TOK;
        for (int m0 = xm_first; m0 < xm_end; m0 += xm_step) {
            const int m = m0 + (lane >> 4), sub = lane & 15;
            const f32x4* xr = (const f32x4*)(x + (size_t)m * D) + sub; f32x4 v[16]; float s = 0.f;
#pragma unroll
            for (int j = 0; j < 16; ++j) v[j] = xr[16 * j];
#pragma unroll
            for (int j = 0; j < 16; ++j) s += (v[j].x * v[j].x + v[j].y * v[j].y) + (v[j].z * v[j].z + v[j].w * v[j].w);
            s += __shfl_xor(s, 1); s += __shfl_xor(s, 2); s += __shfl_xor(s, 4); s += __shfl_xor(s, 8);
            if (sub == 0) RSTD[m] = 1.0f / sqrtf(s * (1.0f / D) + EPS);
            unsigned long long* o8 = (unsigned long long*)(XB + (size_t)m * D) + sub;
#pragma unroll
            for (int j = 0; j < 16; ++j) o8[16 * j] = (unsigned long long)pg8::cvt_pk_f16(v[j].x, v[j].y) | ((unsigned long long)pg8::cvt_pk_f16(v[j].z, v[j].w) << 32);
            unsigned* o4 = (unsigned*)(XF8 + (size_t)m * D) + sub;
#pragma unroll
            for (int j = 0; j < 16; ++j) o4[16 * j] = pg8::pk4_fp8(v[j].x, v[j].y, v[j].z, v[j].w);
        }
        if (BOTH(0)) GRID_BAR();
    }
    if (IN(1)) {
        const float* q_norm = args.in[3]; const float* k_norm = args.in[4];
        bf16* W1T = (bf16*)(ws + WS_W1T); float* RSTD = (float*)(ws + WS_RSTD); float* WIb = (float*)(ws + WS_WI); bf16* XB = (bf16*)(ws + WS_XB);
        bf16* Kb = (bf16*)(ws + WS_K); bf16* Vb = (bf16*)(ws + WS_V); bf16* KIb = (bf16*)(ws + WS_KI); bf16* Rb = (bf16*)(ws + WS_R); bf16* SPb = (bf16*)(ws + WS_R) + 1024;
        bf16* Qb = (bf16*)(ws + WS_Q); bf16* QIb = (bf16*)(ws + WS_QI); bf16* Ub = (bf16*)(ws + WS_U);
        const bool p1swap = (G == 256) && ((bx & 1) != 0);
#pragma unroll 1
        for (int pass = 0; pass < 2; ++pass) {
            if ((pass == 0) != p1swap) {
                pg8::Gemm g{XB, W1T, TOK, 1280, D}; pg8::ListOrder S; S.init(TOK, 1280, G, bx); S.mode = 0;
                pg8::Epi1 E{RSTD, q_norm, k_norm, Qb, Kb, Vb, QIb, KIb, Ub, Rb, SPb, WIb, 0, 1.0f};
                pg8::gemm_phase<pg8::Epi1, pg8::ListOrder, true, true, 1>(lds, g, S, E, wave);
            } else {
                unsigned char* W1T8 = ws + WS_W1T8; unsigned char* XF8 = ws + WS_XF8;
                pg8::Gemm g{(const bf16*)XF8, (const bf16*)W1T8, TOK, 2560, D}; pg8::ListOrder S; S.init(TOK, 2560, G, bx); S.mode = 1;
                pg8::Epi1 E{RSTD, q_norm, k_norm, Qb, Kb, Vb, QIb, KIb, Ub, Rb, SPb, WIb, 5, pg8::K_WSCI};
                pg8::gemm_phase<pg8::Epi1, pg8::ListOrder, true, true, 2>(lds, g, S, E, wave);
            }
        }
        if (BOTH(1)) GRID_BAR_L();
    }
    if (IN(2)) {
        float* WIb = (float*)(ws + WS_WI);
        bf16* Kb = (bf16*)(ws + WS_K); bf16* Vb = (bf16*)(ws + WS_V); bf16* KIb = (bf16*)(ws + WS_KI); unsigned char* AP = ws + WS_AP;
        bf16* Qb = (bf16*)(ws + WS_Q); bf16* QIb = (bf16*)(ws + WS_QI); bf16* Ub = (bf16*)(ws + WS_U);
        const int ptask0 = (G == 256) ? (((vcu >> 4) * 32 + (((vcu & 15) * 8 + wave) >> 2)) * 4 + (wave & 3)) : gw, ptstep = (G == 256) ? TOK : NGW;
        for (int task = ptask0; task < TOK / 16; task += ptstep) {
            const int ln = mk_lane(); const int g = task & 3, tb = (task >> 2) * 64 + (ln >> 4) * 16, tin = tb & (SEQ - 1), c0 = g * 128 + (ln & 15) * 8;
            if (g == 0) pool_win<2>(Ub, AP, tb, tin, c0); else if (g == 1) pool_win<4>(Ub, AP, tb, tin, c0); else if (g == 2) pool_win<8>(Ub, AP, tb, tin, c0); else pool_win<16>(Ub, AP, tb, tin, c0);
        }
        __syncthreads();
        float qk2_;
        { const float* q_norm = args.in[3]; const float* k_norm = args.in[4]; const int lq = mk_lane() & 63; float gq = __builtin_fabsf(q_norm[lq]), gk = __builtin_fabsf(k_norm[lq]);
#pragma unroll
          for (int o_ = 1; o_ < 64; o_ <<= 1) { gq = __builtin_fmaxf(gq, __shfl_xor(gq, o_)); gk = __builtin_fmaxf(gk, __shfl_xor(gk, o_)); }
          qk2_ = __builtin_bit_cast(float, __builtin_amdgcn_readfirstlane(__builtin_bit_cast(int, 2.0f * 11.6f * gq * gk))); }
        const att::Tensors AT{Qb, Kb, Vb, QIb, KIb, WIb, AP, qk2_};
        const int nun = (G == 256) ? 4 : (NB * 64 - vcu + G - 1) / G;
#define UNIT_OF(i, b_, q_) do { if (G == 256) { const int s_ = vcu & 15; b_ = vcu >> 4; q_ = (int)((unit_tab(s_) >> (8 * (i))) & 0xffu); } \
                                else { const int un_ = vcu + (i) * G; b_ = un_ >> 6; q_ = un_ & 63; } } while (0)
        att::UnitPF pf;
        if (nun > 0) { int b0, q0; UNIT_OF(0, b0, q0); att::unit_prefetch(pf, b0, q0, AT, wave, lds, true); }
#pragma unroll 1
        for (int i = 0; i < nun; ++i) {
            int b, qb, nb = 0, nqb = 0; UNIT_OF(i, b, qb);
            const bool has_next = (i + 1 < nun); if (has_next) UNIT_OF(i + 1, nb, nqb);
            att::attn_unit(b, qb, AT, lds, pf, has_next, nb, nqb, wave);
        }
#undef UNIT_OF
        if (BOTH(2)) GRID_BAR_L();
    }
    if (IN(3)) {
        unsigned char* W3T = ws + WS_W3T; bf16* Rb = (bf16*)(ws + WS_R); bf16* SPb = (bf16*)(ws + WS_R) + 1024; unsigned char* AP = ws + WS_AP; unsigned char* MG = ws + WS_MG;
        pg8::Gemm g{(const bf16*)AP, (const bf16*)W3T, TOK, D, D}; pg8::StaticOrder S; S.init(TOK, D, G, bx);
        pg8::Epi3 E{(const unsigned char*)Rb, (const unsigned char*)Rb + pg8::GATE_SP_OFF, MG};
        pg8::gemm_phase<pg8::Epi3, pg8::StaticOrder, true, true, 2>(lds, g, S, E, wave);
        if (BOTH(3)) GRID_BAR_L();
    }
    if (IN(4)) {
        bf16* XB = (bf16*)(ws + WS_XB); unsigned char* W4T = ws + WS_W4T; unsigned char* MG = ws + WS_MG; bf16* H2 = (bf16*)(ws + WS_H2); unsigned char* H2F8 = ws + WS_H2F8; float* SSQ = (float*)(ws + WS_SSQ);
        pg8::Gemm g{(const bf16*)MG, (const bf16*)W4T, TOK, D, D}; pg8::StaticOrder S; S.init(TOK, D, G, bx);
        pg8::Epi4 E{XB, H2, H2F8, SSQ};
        pg8::gemm_phase<pg8::Epi4, pg8::StaticOrder, true, true, 2>(lds, g, S, E, wave);
        if (BOTH(4)) GRID_BAR_L();
    }
    if (IN(5)) {
        unsigned char* W5T = ws + WS_W5T; unsigned char* H2F8 = ws + WS_H2F8; float* SSQ = (float*)(ws + WS_SSQ); unsigned char* ACT = ws + WS_ACT;
        bf16* H2 = (bf16*)(ws + WS_H2);
        pg8::Gemm g{MK_FP8 ? (const bf16*)H2F8 : (const bf16*)H2, (const bf16*)W5T, TOK, N5, D}; pg8::StaticOrder S; S.init(TOK, N5, G, bx);
        pg8::Epi5 E{SSQ, ACT};
        pg8::gemm_phase<pg8::Epi5, pg8::StaticOrder, true, true, MK_FP8 ? 2 : 0>(lds, g, S, E, wave);
        if (BOTH(5)) GRID_BAR_L();
    }
    if (IN(6)) {
        float* out = args.out; unsigned char* W6T = ws + WS_W6T; unsigned char* ACT = ws + WS_ACT; bf16* H2 = (bf16*)(ws + WS_H2);
        pg8::Gemm g{(const bf16*)ACT, (const bf16*)W6T, TOK, D, FF, (int)pg8::ACT_PITCH}; pg8::StaticOrder S; S.init(TOK, D, G, bx);
        pg8::Epi6 E{H2, out};
        pg8::gemm_phase<pg8::Epi6, pg8::StaticOrder, true, true, MK_FP8 ? 2 : 0>(lds, g, S, E, wave);
    }
#undef IN
#undef BOTH
#undef GRID_BAR
#undef GRID_BAR_L
}

extern "C" void kernel_launch(void* const* d_in, const int* in_sizes, int n_in, void* d_out, int out_size, void* d_ws, size_t ws_size, hipStream_t stream) {
    static int grid = 0;
    if (grid == 0) {
        if (n_in != 14 || in_sizes[0] != TOK * D || out_size != TOK * D || ws_size < WS_END) { fprintf(stderr, "kernel_launch: unexpected shapes (n_in %d, in0 %d, out %d, ws %zu)\n", n_in, n_in > 0 ? in_sizes[0] : -1, out_size, ws_size); grid = -1; return; }
        int dev = 0, cus = 0, per_cu = 0;
        if (hipGetDevice(&dev) != hipSuccess || hipDeviceGetAttribute(&cus, hipDeviceAttributeMultiprocessorCount, dev) != hipSuccess) { grid = -1; return; }
        if (hipFuncSetAttribute((const void*)mk_fwd, hipFuncAttributeMaxDynamicSharedMemorySize, LDS_BYTES) != hipSuccess) { fprintf(stderr, "kernel_launch: hipFuncSetAttribute failed\n"); grid = -1; return; }
        if (hipOccupancyMaxActiveBlocksPerMultiprocessor(&per_cu, (const void*)mk_fwd, NWAVES * 64, LDS_BYTES) != hipSuccess || per_cu < 1) fprintf(stderr, "kernel_launch: occupancy query says %d\n", per_cu);
        (void)hipGetLastError();
        grid = cus;
    }
    if (grid < 0) return;
    (void)hipMemsetAsync((char*)d_ws + WS_CTL, 0, CTL_ZERO_BYTES, stream);
    Args a{};
    for (int i = 0; i < 14; ++i) a.in[i] = (const float*)d_in[i];
    a.out = (float*)d_out; a.ws = (unsigned char*)d_ws;
#if MK_PER_PHASE
    for (int p = 0; p < 7; ++p) { a.ph_lo = p; a.ph_hi = p + 1; hipLaunchKernelGGL(mk_fwd, dim3(grid), dim3(NWAVES * 64), LDS_BYTES, stream, a);
#ifdef MK_REPEAT
        if (p == MK_REPEAT) hipLaunchKernelGGL(mk_fwd, dim3(grid), dim3(NWAVES * 64), LDS_BYTES, stream, a);
#endif
    }
#else
    a.ph_lo = 0; a.ph_hi = 7; hipLaunchKernelGGL(mk_fwd, dim3(grid), dim3(NWAVES * 64), LDS_BYTES, stream, a);
#endif
}
```
